# Optimizing an MI355X kernel written in HIP

```python
import jax, jax.numpy as jnp
from jax import lax
import numpy as np

D_MODEL = 1024
BATCH = 16
SEQ = 256
DEPTH = 4
DEC_BATCH = 4
DEC_SEQ = 1024
PAST_LEN = 256

GRID_W = 64
N_MIXERS = 2
N_GLA = (DEPTH + 1) // 2
N_ATT = DEPTH // 2
GLA_HEADS = 4
GLA_DK = D_MODEL // 2 // GLA_HEADS
GLA_DV = D_MODEL // GLA_HEADS
GLA_RANK = 16
GLA_TAU = 16.0
GLA_CHUNK = 64
GLA_QD = GLA_HEADS * GLA_DK
GLA_VD = GLA_HEADS * GLA_DV
GLA_IN = 2 * GLA_QD + 2 * GLA_VD
HEAD_DIM = 128
ATT_HEADS = D_MODEL // HEAD_DIM
ATT_KV_HEADS = ATT_HEADS // 4
ATT_QD = ATT_HEADS * HEAD_DIM
ATT_KD = ATT_KV_HEADS * HEAD_DIM
ATT_IN = 2 * ATT_QD + 2 * ATT_KD
Q_BLOCK = 128
ROPE_THETA = 10000.0
EPS = 1e-6

kernel_name = "hybrid_gla_gqa_diffusion_step"


def rms_norm(x, g):
    xf = x.astype(jnp.float32)
    y = xf * lax.rsqrt(jnp.mean(xf * xf, axis=-1, keepdims=True) + EPS)
    return (y * g.astype(jnp.float32)).astype(x.dtype)


def rope_2d(x):
    T = x.shape[1]
    rows = T // GRID_W
    row = jnp.repeat(jnp.arange(rows), GRID_W)
    col = jnp.tile(jnp.arange(GRID_W), rows)
    half = HEAD_DIM // 2
    nf = half // 2
    freqs = ROPE_THETA ** (-jnp.arange(nf, dtype=jnp.float32) / nf)

    def rot(seg, pos):
        ang = pos.astype(jnp.float32)[:, None] * freqs[None, :]
        cos = jnp.cos(ang)[None, :, None, :]
        sin = jnp.sin(ang)[None, :, None, :]
        a, b = seg[..., :nf], seg[..., nf:]
        return jnp.concatenate([a * cos - b * sin, b * cos + a * sin], axis=-1)

    xf = x.astype(jnp.float32)
    out = jnp.concatenate([rot(xf[..., :half], row), rot(xf[..., half:], col)], axis=-1)
    return out.astype(x.dtype)


def to_chunks(a):
    B, T, H, d = a.shape
    return a.reshape(B, T // GLA_CHUNK, GLA_CHUNK, H, d).transpose(1, 0, 3, 2, 4)


def gla_chunked(q, k, v, logg, s0):
    B, T, H, _ = q.shape
    qc, kc, vc, gc = (to_chunks(a.astype(jnp.float32)) for a in (q, k, v, logg))
    mask = jnp.tril(jnp.ones((GLA_CHUNK, GLA_CHUNK), dtype=bool))

    def step(S, inp):
        qi, ki, vi, gi = inp
        b = jnp.cumsum(gi, axis=2)
        b_last = b[:, :, -1:, :]
        qe = qi * jnp.exp(b)
        ke = ki * jnp.exp(-b)
        a = jnp.where(mask, jnp.einsum("bhtk,bhsk->bhts", qe, ke), 0.0)
        o = jnp.einsum("bhts,bhsv->bhtv", a, vi) + jnp.einsum("bhtk,bhkv->bhtv", qe, S)
        S = jnp.exp(b_last[:, :, 0, :])[..., None] * S + jnp.einsum(
            "bhsk,bhsv->bhkv", ki * jnp.exp(b_last - b), vi)
        return S, o

    S, o = lax.scan(step, s0.astype(jnp.float32), (qc, kc, vc, gc))
    o = o.transpose(1, 0, 3, 2, 4).reshape(B, T, H, -1)
    return o, S


def gla_mixer(h, w_in, wa1, wa2, ba, onorm, w_out, s0):
    B, T, _ = h.shape
    proj = h @ w_in
    q, k, v, gate = jnp.split(proj, [GLA_QD, 2 * GLA_QD, 2 * GLA_QD + GLA_VD], axis=-1)
    q = q.reshape(B, T, GLA_HEADS, GLA_DK) * (GLA_DK ** -0.5)
    k = k.reshape(B, T, GLA_HEADS, GLA_DK)
    v = v.reshape(B, T, GLA_HEADS, GLA_DV)

    def decay(d):
        z = ((h @ wa1[d]) @ wa2[d] + ba[d]).astype(jnp.float32)
        return (jax.nn.log_sigmoid(z) / GLA_TAU).reshape(B, T, GLA_HEADS, GLA_DK)

    flip = lambda a: a[:, ::-1]
    o_f, s_f = gla_chunked(q, k, v, decay(0), s0[:, 0])
    o_b, s_b = gla_chunked(flip(q), flip(k), flip(v), flip(decay(1)), s0[:, 1])
    o = rms_norm(o_f + flip(o_b), onorm).reshape(B, T, GLA_VD).astype(h.dtype)
    y = (o * jax.nn.silu(gate)) @ w_out
    return y, jnp.stack([s_f, s_b], axis=1).astype(h.dtype)


def attn_project(h, w_in, qn, kn):
    B, T, _ = h.shape
    proj = h @ w_in
    q, k, v, gate = jnp.split(proj, [ATT_QD, ATT_QD + ATT_KD, ATT_QD + 2 * ATT_KD], axis=-1)
    q = rms_norm(q.reshape(B, T, ATT_HEADS, HEAD_DIM), qn)
    k = rms_norm(k.reshape(B, T, ATT_KV_HEADS, HEAD_DIM), kn)
    v = v.reshape(B, T, ATT_KV_HEADS, HEAD_DIM)
    return q, k, v, gate


def attend_blocks(q, keys, vals):
    B, T = q.shape[0], q.shape[1]
    G = ATT_HEADS // ATT_KV_HEADS
    nb = T // Q_BLOCK
    qb = q.reshape(B, nb, Q_BLOCK, ATT_KV_HEADS, G, HEAD_DIM).transpose(1, 0, 2, 3, 4, 5)
    scale = HEAD_DIM ** -0.5

    def one(qblk):
        s = jnp.einsum("bqhgd,bkhd->bhgqk", qblk, keys).astype(jnp.float32) * scale
        p = jax.nn.softmax(s, axis=-1).astype(vals.dtype)
        return jnp.einsum("bhgqk,bkhd->bqhgd", p, vals)

    o = lax.map(one, qb)
    return o.transpose(1, 0, 2, 3, 4, 5).reshape(B, T, ATT_QD)


def split_mod(mod):
    return jnp.split(mod, 3, axis=-1)


def setup_inputs(seed: int = 0) -> dict:
    key = jax.random.key(seed)
    ks = jax.random.split(key, 24)
    f32 = jnp.float32
    nrm = lambda k, shape, s: jax.random.normal(k, shape, f32) * s
    return {
        "x_prompt": nrm(ks[0], (BATCH, SEQ, D_MODEL), 1.0),
        "x_sample": nrm(ks[1], (DEC_BATCH, DEC_SEQ, D_MODEL), 1.0),
        "state_gla": nrm(ks[2], (DEC_BATCH, N_GLA, 2, GLA_HEADS, GLA_DK, GLA_DV), 1.0),
        "cache_k": nrm(ks[3], (DEC_BATCH, N_ATT, PAST_LEN, ATT_KV_HEADS, HEAD_DIM), 1.0),
        "cache_v": nrm(ks[4], (DEC_BATCH, N_ATT, PAST_LEN, ATT_KV_HEADS, HEAD_DIM), 1.0),
        "c": nrm(ks[5], (DEC_BATCH, D_MODEL), 1.0),
        "c_ctx": nrm(ks[6], (D_MODEL,), 1.0),
        "norm_g": 1.0 + nrm(ks[7], (DEPTH, D_MODEL), 0.1),
        "w_ada": nrm(ks[8], (DEPTH, D_MODEL, 3 * D_MODEL), 0.5 * D_MODEL ** -0.5),
        "b_ada": nrm(ks[9], (DEPTH, 3 * D_MODEL), 0.02),
        "gla_w_in": nrm(ks[10], (N_GLA, D_MODEL, GLA_IN), D_MODEL ** -0.5),
        "gla_wa1": nrm(ks[11], (N_GLA, 2, D_MODEL, GLA_RANK), D_MODEL ** -0.5),
        "gla_wa2": nrm(ks[12], (N_GLA, 2, GLA_RANK, GLA_QD), GLA_RANK ** -0.5),
        "gla_ba": nrm(ks[13], (N_GLA, 2, GLA_QD), 0.1),
        "gla_onorm": 1.0 + nrm(ks[14], (N_GLA, GLA_DV), 0.1),
        "gla_w_out": nrm(ks[15], (N_GLA, GLA_VD, D_MODEL), GLA_VD ** -0.5),
        "att_w_in": nrm(ks[16], (N_ATT, D_MODEL, ATT_IN), D_MODEL ** -0.5),
        "att_qnorm": 1.0 + nrm(ks[17], (N_ATT, HEAD_DIM), 0.1),
        "att_knorm": 1.0 + nrm(ks[18], (N_ATT, HEAD_DIM), 0.1),
        "att_w_out": nrm(ks[19], (N_ATT, ATT_QD, D_MODEL), ATT_QD ** -0.5),
    }


def reference(x_prompt, x_sample, state_gla, cache_k, cache_v, c, c_ctx, norm_g, w_ada, b_ada,
              gla_w_in, gla_wa1, gla_wa2, gla_ba, gla_onorm, gla_w_out,
              att_w_in, att_qnorm, att_knorm, att_w_out):
    xp, xs = x_prompt, x_sample
    Bp = xp.shape[0]
    gla_states, ctx_keys, ctx_vals = [], [], []
    for l in range(DEPTH):
        i = l // N_MIXERS
        mod_p = (jax.nn.silu(c_ctx) @ w_ada[l] + b_ada[l])[None, None, :]
        mod_s = (jax.nn.silu(c) @ w_ada[l] + b_ada[l])[:, None, :]
        sh_p, sc_p, gt_p = split_mod(mod_p)
        sh_s, sc_s, gt_s = split_mod(mod_s)
        hp = rms_norm(xp, norm_g[l]) * (1.0 + sc_p) + sh_p
        hs = rms_norm(xs, norm_g[l]) * (1.0 + sc_s) + sh_s
        if l % N_MIXERS == 0:
            s_zero = jnp.zeros((Bp, 2, GLA_HEADS, GLA_DK, GLA_DV), xp.dtype)
            out_p, st = gla_mixer(hp, gla_w_in[i], gla_wa1[i], gla_wa2[i], gla_ba[i],
                                  gla_onorm[i], gla_w_out[i], s_zero)
            out_s, _ = gla_mixer(hs, gla_w_in[i], gla_wa1[i], gla_wa2[i], gla_ba[i],
                                 gla_onorm[i], gla_w_out[i], state_gla[:, i])
            gla_states.append(st)
        else:
            qp, kp, vp, gp = attn_project(hp, att_w_in[i], att_qnorm[i], att_knorm[i])
            out_p = (attend_blocks(qp, kp, vp) * jax.nn.silu(gp)) @ att_w_out[i]
            ctx_keys.append(kp)
            ctx_vals.append(vp)
            qs, ks_, vs, gs = attn_project(hs, att_w_in[i], att_qnorm[i], att_knorm[i])
            qs = rope_2d(qs)
            ks_ = rope_2d(ks_)
            keys = jnp.concatenate([ks_, cache_k[:, i].astype(ks_.dtype)], axis=1)
            vals = jnp.concatenate([vs, cache_v[:, i].astype(vs.dtype)], axis=1)
            out_s = (attend_blocks(qs, keys, vals) * jax.nn.silu(gs)) @ att_w_out[i]
        xp = xp + gt_p * out_p
        xs = xs + gt_s * out_s
    state_gla_new = jnp.stack(gla_states, axis=1)
    cache_k_new = jnp.stack(ctx_keys, axis=1)
    cache_v_new = jnp.stack(ctx_vals, axis=1)
    return (xp, xs, state_gla_new, cache_k_new, cache_v_new)
```

```cpp
#include <hip/hip_runtime.h>
#include <hip/hip_cooperative_groups.h>
#include <stdint.h>
#include <stdio.h>
namespace cg = cooperative_groups;

typedef unsigned short bfr;
using bf16x8 = __attribute__((ext_vector_type(8))) short;
using bf16x4 = __attribute__((ext_vector_type(4))) short;
using f32x16 = __attribute__((ext_vector_type(16))) float;
using f32x4 = __attribute__((ext_vector_type(4))) float;
#define DI __device__ __forceinline__
#define MFMA32(a, b, c) __builtin_amdgcn_mfma_f32_32x32x16_bf16((a), (b), (c), 0, 0, 0)

constexpr int NTOK = 8192;
constexpr int DM = 1024;
constexpr int NPT = 4096;
constexpr float EPSN = 1e-6f;
constexpr int GLA_NPAD = 3200;
constexpr int ATT_N = 2560;

constexpr size_t OFF_WT_GLA_IN = 0;
constexpr size_t OFF_WT_GLA_OUT = OFF_WT_GLA_IN + 2ull * GLA_NPAD * 1024 * 2;
constexpr size_t OFF_WT_ATT_IN = OFF_WT_GLA_OUT + 2ull * 1024 * 1024 * 2;
constexpr size_t OFF_WT_ATT_OUT = OFF_WT_ATT_IN + 2ull * ATT_N * 1024 * 2;
constexpr size_t OFF_MOD = OFF_WT_ATT_OUT + 2ull * 1024 * 1024 * 2;
constexpr size_t OFF_ROPE = OFF_MOD + 4ull * 5 * 3072 * 4;
constexpr size_t OFF_H = OFF_ROPE + 2ull * 64 * 32 * 4;
constexpr size_t OFF_PROJ = OFF_H + (size_t)NTOK * 1024 * 2;
constexpr size_t OFF_TBUF = OFF_PROJ + (size_t)NTOK * 3072 * 2;
constexpr size_t OFF_QE = OFF_TBUF + (size_t)NTOK * 32 * 4;
constexpr size_t OFF_KDT = OFF_QE + 2ull * NTOK * 512 * 2;
constexpr size_t OFF_ABUF = OFF_KDT + 2ull * NTOK * 512 * 2;
constexpr size_t OFF_ELAST = OFF_ABUF + 1024ull * 64 * 64 * 2;
constexpr size_t OFF_O = OFF_ELAST + 1024ull * 128 * 4;
constexpr size_t OFF_U = OFF_O + 2ull * NTOK * 1024 * 2;
constexpr size_t OFF_KS = OFF_U + (size_t)NTOK * 1024 * 2;
constexpr size_t OFF_VST = OFF_KS + 2ull * 4 * 1280 * 256 * 2;
constexpr size_t WS_END = OFF_VST + 2ull * 4 * 1280 * 256 * 2;
constexpr size_t PJ_GQ = 0;
constexpr size_t PJ_GK = (size_t)NTOK * 512 * 2;
constexpr size_t PJ_GG = (size_t)NTOK * 1024 * 2;
constexpr size_t PJ_GVT = (size_t)NTOK * 2048 * 2;
constexpr size_t PJ_AQ = 0;
constexpr size_t PJ_AG = (size_t)NTOK * 1024 * 2;
constexpr size_t PJ_AKP = (size_t)NTOK * 2048 * 2;
constexpr size_t PJ_AVPT = PJ_AKP + 4096ull * 256 * 2;

constexpr size_t OUT_STATE = 2ull * 4096 * 1024;
constexpr size_t OUT_CK = OUT_STATE + 16ull * 2 * 2 * 4 * 128 * 256;
constexpr size_t OUT_CV = OUT_CK + 16ull * 2 * 256 * 2 * 128;

constexpr int SMEM_BYTES = 73728;

struct Params {
  const float* in[20];
  float* out;
  unsigned char* ws;
};
enum { I_XP = 0, I_XS, I_STATE, I_CK, I_CV, I_C, I_CCTX, I_NORMG, I_WADA, I_BADA, I_GWIN, I_GWA1, I_GWA2, I_GBA,
       I_GONORM, I_GWOUT, I_AWIN, I_AQN, I_AKN, I_AWOUT };

DI bfr f2bf(float x) {
  unsigned u = __float_as_uint(x);
  u += 0x7fffu + ((u >> 16) & 1u);
  return (bfr)(u >> 16);
}
DI float bf2f(bfr b) { return __uint_as_float(((unsigned)b) << 16); }
DI unsigned pack2(float a, float b) { return (unsigned)f2bf(a) | ((unsigned)f2bf(b) << 16); }
DI int crow(int reg, int h) { return (reg & 3) + 8 * (reg >> 2) + 4 * h; }
DI float siluf(float x) { return x / (1.f + __expf(-x)); }
DI int modrow(int row) { return row < NPT ? 0 : 1 + ((row - NPT) >> 10); }
DI const float* xrow_ptr(const Params& p, int l, int row) {
  if (l == 0) return row < NPT ? p.in[I_XP] + (size_t)row * DM : p.in[I_XS] + (size_t)(row - NPT) * DM;
  return p.out + (size_t)row * DM;
}
DI float wave_sum(float v) {
#pragma unroll
  for (int o = 32; o >= 1; o >>= 1) v += __shfl_xor(v, o);
  return v;
}
DI float half_sum(float v) {
#pragma unroll
  for (int o = 16; o >= 1; o >>= 1) v += __shfl_xor(v, o);
  return v;
}

DI void transpose_tile(const float* __restrict__ src, int src_ld, int k0, int n0, int ncols, bfr* __restrict__ dst,
                       size_t dst_ld, unsigned char* smem) {
  float* tile = (float*)smem;
  const int tid = threadIdx.x;
  const int c4 = (tid & 15) * 4, kr = tid >> 4;
#pragma unroll
  for (int j = 0; j < 4; ++j) {
    int k = kr + 16 * j;
    if (c4 < ncols) {
      float4 v = *(const float4*)(src + (size_t)(k0 + k) * src_ld + n0 + c4);
      tile[k * 65 + c4] = v.x; tile[k * 65 + c4 + 1] = v.y; tile[k * 65 + c4 + 2] = v.z; tile[k * 65 + c4 + 3] = v.w;
    }
  }
  __syncthreads();
  const int n = tid >> 2, kq = (tid & 3) * 16;
  if (n < ncols) {
    unsigned pk[8];
#pragma unroll
    for (int j = 0; j < 8; ++j) pk[j] = pack2(tile[(kq + 2 * j) * 65 + n], tile[(kq + 2 * j + 1) * 65 + n]);
    uint4* d = (uint4*)(dst + (size_t)(n0 + n) * dst_ld + k0 + kq);
    d[0] = make_uint4(pk[0], pk[1], pk[2], pk[3]);
    d[1] = make_uint4(pk[4], pk[5], pk[6], pk[7]);
  }
  __syncthreads();
}

DI void mod_unit(const Params& p, int unit, unsigned char* smem) {
  const int l = unit / 96, n0 = (unit % 96) * 32;
  float* sil = (float*)smem;
  float* red = sil + 5 * 1024;
  const int tid = threadIdx.x;
  for (int e = tid; e < 5 * 1024; e += 256) {
    int r = e >> 10, k = e & 1023;
    float cv = r == 0 ? p.in[I_CCTX][k] : p.in[I_C][(r - 1) * 1024 + k];
    sil[e] = cv / (1.f + expf(-cv));
  }
  __syncthreads();
  const int kg = tid >> 5, cn = tid & 31;
  const float* w = p.in[I_WADA] + (size_t)l * 1024 * 3072 + n0 + cn;
  float a0 = 0, a1 = 0, a2 = 0, a3 = 0, a4 = 0;
#pragma unroll 8
  for (int kk = 0; kk < 128; ++kk) {
    int k = kg * 128 + kk;
    float wv = w[(size_t)k * 3072];
    a0 += sil[k] * wv; a1 += sil[1024 + k] * wv; a2 += sil[2048 + k] * wv; a3 += sil[3072 + k] * wv; a4 += sil[4096 + k] * wv;
  }
  red[(kg * 5 + 0) * 32 + cn] = a0; red[(kg * 5 + 1) * 32 + cn] = a1; red[(kg * 5 + 2) * 32 + cn] = a2;
  red[(kg * 5 + 3) * 32 + cn] = a3; red[(kg * 5 + 4) * 32 + cn] = a4;
  __syncthreads();
  if (tid < 160) {
    int r = tid >> 5;
    float s = p.in[I_BADA][l * 3072 + n0 + cn];
#pragma unroll
    for (int g = 0; g < 8; ++g) s += red[(g * 5 + r) * 32 + cn];
    ((float*)(p.ws + OFF_MOD))[(l * 5 + r) * 3072 + n0 + cn] = s;
  }
  __syncthreads();
}

DI void phase0(const Params& p, unsigned char* smem) {
  constexpr int U_MOD = 384;
  constexpr int U_GIN = 2 * 16 * 48;
  constexpr int U_GA1 = 2 * 2 * 16;
  constexpr int U_GZ = 2;
  constexpr int U_GOUT = 2 * 16 * 16;
  constexpr int U_AIN = 2 * 16 * 40;
  constexpr int U_AOUT = 2 * 16 * 16;
  constexpr int U_ROPE = 1;
  constexpr int U_CK = 64;
  constexpr int U_CV = 4 * 2 * 16;
  constexpr int U_TOTAL = U_MOD + U_GIN + U_GA1 + U_GZ + U_GOUT + U_AIN + U_AOUT + U_ROPE + U_CK + U_CV;
  bfr* wt_gin = (bfr*)(p.ws + OFF_WT_GLA_IN);
  bfr* wt_gout = (bfr*)(p.ws + OFF_WT_GLA_OUT);
  bfr* wt_ain = (bfr*)(p.ws + OFF_WT_ATT_IN);
  bfr* wt_aout = (bfr*)(p.ws + OFF_WT_ATT_OUT);
  const int tid = threadIdx.x;
  for (int unit = blockIdx.x; unit < U_TOTAL; unit += gridDim.x) {
    int u = unit;
    if (u < U_MOD) { mod_unit(p, u, smem); continue; }
    u -= U_MOD;
    if (u < U_GIN) {
      int i = u / 768, r = u % 768, kt = r / 48, nt = r % 48;
      transpose_tile(p.in[I_GWIN] + (size_t)i * 1024 * 3072, 3072, kt * 64, nt * 64, 64,
                     wt_gin + (size_t)i * GLA_NPAD * 1024, 1024, smem);
      continue;
    }
    u -= U_GIN;
    if (u < U_GA1) {
      int id = u / 16, kt = u % 16;
      int i = id >> 1, d = id & 1;
      transpose_tile(p.in[I_GWA1] + (size_t)id * 1024 * 16, 16, kt * 64, 0, 16,
                     wt_gin + ((size_t)i * GLA_NPAD + 3072 + d * 16) * 1024, 1024, smem);
      continue;
    }
    u -= U_GA1;
    if (u < U_GZ) {
      uint4* z = (uint4*)(wt_gin + ((size_t)u * GLA_NPAD + 3104) * 1024);
      for (int e = tid; e < 96 * 1024 / 8; e += 256) z[e] = make_uint4(0, 0, 0, 0);
      continue;
    }
    u -= U_GZ;
    if (u < U_GOUT) {
      int i = u / 256, r = u % 256, kt = r / 16, nt = r % 16;
      transpose_tile(p.in[I_GWOUT] + (size_t)i * 1024 * 1024, 1024, kt * 64, nt * 64, 64,
                     wt_gout + (size_t)i * 1024 * 1024, 1024, smem);
      continue;
    }
    u -= U_GOUT;
    if (u < U_AIN) {
      int i = u / 640, r = u % 640, kt = r / 40, nt = r % 40;
      transpose_tile(p.in[I_AWIN] + (size_t)i * 1024 * ATT_N, ATT_N, kt * 64, nt * 64, 64,
                     wt_ain + (size_t)i * ATT_N * 1024, 1024, smem);
      continue;
    }
    u -= U_AIN;
    if (u < U_AOUT) {
      int i = u / 256, r = u % 256, kt = r / 16, nt = r % 16;
      transpose_tile(p.in[I_AWOUT] + (size_t)i * 1024 * 1024, 1024, kt * 64, nt * 64, 64,
                     wt_aout + (size_t)i * 1024 * 1024, 1024, smem);
      continue;
    }
    u -= U_AOUT;
    if (u < U_ROPE) {
      float* rc = (float*)(p.ws + OFF_ROPE);
      float* rs = rc + 64 * 32;
      for (int e = tid; e < 2048; e += 256) {
        int pos = e >> 5, f = e & 31;
        float fr = powf(10000.0f, -(float)f / 32.0f);
        float ang = (float)pos * fr;
        rc[e] = cosf(ang);
        rs[e] = sinf(ang);
      }
      continue;
    }
    u -= U_ROPE;
    if (u < U_CK) {
      bfr* ks = (bfr*)(p.ws + OFF_KS);
      for (int e = tid; e < 2048; e += 256) {
        size_t idx = (size_t)u * 8192 + (size_t)e * 4;
        int c = idx & 255, t = (idx >> 8) & 255, i = (idx >> 16) & 1, b = (int)(idx >> 17);
        float4 v = *(const float4*)(p.in[I_CK] + idx);
        uint2 o = make_uint2(pack2(v.x, v.y), pack2(v.z, v.w));
        *(uint2*)(ks + ((size_t)(i * 4 + b) * 1280 + 1024 + t) * 256 + c) = o;
      }
      continue;
    }
    u -= U_CK;
    {
      int bi = u / 16, r = u % 16, kt = r / 4, nt = r % 4;
      int b = bi >> 1, i = bi & 1;
      transpose_tile(p.in[I_CV] + (size_t)bi * 256 * 256, 256, kt * 64, nt * 64, 64,
                     (bfr*)(p.ws + OFF_VST) + (size_t)(i * 4 + b) * 256 * 1280 + 1024, 1280, smem);
    }
  }
}

DI void phase_norm(const Params& p, int l) {
  const int lane = threadIdx.x & 63;
  const int gw = blockIdx.x * 4 + (threadIdx.x >> 6), nw = gridDim.x * 4;
  const float* g = p.in[I_NORMG] + l * DM;
  const float* mod = (const float*)(p.ws + OFF_MOD) + (size_t)l * 5 * 3072;
  bfr* h = (bfr*)(p.ws + OFF_H);
  for (int row = gw; row < NTOK; row += nw) {
    const float* x = xrow_ptr(p, l, row);
    float4 v[4];
    float ss = 0.f;
#pragma unroll
    for (int j = 0; j < 4; ++j) {
      v[j] = *(const float4*)(x + lane * 4 + 256 * j);
      ss += v[j].x * v[j].x + v[j].y * v[j].y + v[j].z * v[j].z + v[j].w * v[j].w;
    }
    ss = wave_sum(ss);
    const float rstd = rsqrtf(ss * (1.f / 1024.f) + EPSN);
    const float* mr = mod + modrow(row) * 3072;
#pragma unroll
    for (int j = 0; j < 4; ++j) {
      int c = lane * 4 + 256 * j;
      float4 gg = *(const float4*)(g + c);
      float4 sh = *(const float4*)(mr + c);
      float4 sc = *(const float4*)(mr + 1024 + c);
      float o0 = v[j].x * rstd * gg.x * (1.f + sc.x) + sh.x;
      float o1 = v[j].y * rstd * gg.y * (1.f + sc.y) + sh.y;
      float o2 = v[j].z * rstd * gg.z * (1.f + sc.z) + sh.z;
      float o3 = v[j].w * rstd * gg.w * (1.f + sc.w) + sh.w;
      *(uint2*)(h + (size_t)row * DM + c) = make_uint2(pack2(o0, o1), pack2(o2, o3));
    }
  }
}

DI void gemm_core(const bfr* __restrict__ A, const bfr* __restrict__ Bt, int K, int m0, int n0, unsigned char* smem,
                  f32x16 (&acc)[2][2]) {
  bfr* sA = (bfr*)smem;
  bfr* sB = sA + 2 * 128 * 72;
  const int tid = threadIdx.x, lane = tid & 63, w = tid >> 6, wm = w >> 1, wn = w & 1, r = lane & 31, hh = lane >> 5;
  const int lrow = tid >> 3, lch = (tid & 7) * 8;
  const bfr* gA = A + (size_t)(m0 + lrow) * K + lch;
  const bfr* gB = Bt + (size_t)(n0 + lrow) * K + lch;
#pragma unroll
  for (int a = 0; a < 2; ++a)
#pragma unroll
    for (int b = 0; b < 2; ++b)
#pragma unroll
      for (int i = 0; i < 16; ++i) acc[a][b][i] = 0.f;
  uint4 ra[4], rb[4];
#pragma unroll
  for (int j = 0; j < 4; ++j) {
    ra[j] = *(const uint4*)(gA + (size_t)(32 * j) * K);
    rb[j] = *(const uint4*)(gB + (size_t)(32 * j) * K);
  }
#pragma unroll
  for (int j = 0; j < 4; ++j) {
    *(uint4*)(sA + (lrow + 32 * j) * 72 + lch) = ra[j];
    *(uint4*)(sB + (lrow + 32 * j) * 72 + lch) = rb[j];
  }
  __syncthreads();
  const int KT = K >> 6;
  for (int kt = 0; kt < KT; ++kt) {
    const int cur = kt & 1;
    if (kt + 1 < KT) {
#pragma unroll
      for (int j = 0; j < 4; ++j) {
        ra[j] = *(const uint4*)(gA + (size_t)(32 * j) * K + (kt + 1) * 64);
        rb[j] = *(const uint4*)(gB + (size_t)(32 * j) * K + (kt + 1) * 64);
      }
    }
    const bfr* cA = sA + cur * 128 * 72;
    const bfr* cB = sB + cur * 128 * 72;
#pragma unroll
    for (int kk = 0; kk < 4; ++kk) {
      bf16x8 a[2], b[2];
#pragma unroll
      for (int mb = 0; mb < 2; ++mb) a[mb] = *(const bf16x8*)(cA + (64 * wm + 32 * mb + r) * 72 + 16 * kk + 8 * hh);
#pragma unroll
      for (int nb = 0; nb < 2; ++nb) b[nb] = *(const bf16x8*)(cB + (64 * wn + 32 * nb + r) * 72 + 16 * kk + 8 * hh);
#pragma unroll
      for (int mb = 0; mb < 2; ++mb)
#pragma unroll
        for (int nb = 0; nb < 2; ++nb) acc[mb][nb] = MFMA32(a[mb], b[nb], acc[mb][nb]);
    }
    if (kt + 1 < KT) {
      bfr* nA = sA + (cur ^ 1) * 128 * 72;
      bfr* nB = sB + (cur ^ 1) * 128 * 72;
#pragma unroll
      for (int j = 0; j < 4; ++j) {
        *(uint4*)(nA + (lrow + 32 * j) * 72 + lch) = ra[j];
        *(uint4*)(nB + (lrow + 32 * j) * 72 + lch) = rb[j];
      }
    }
    __syncthreads();
  }
}
DI void stage_acc(const f32x16 (&acc)[2][2], float* sC) {
  const int lane = threadIdx.x & 63, w = threadIdx.x >> 6, wm = w >> 1, wn = w & 1, r = lane & 31, hh = lane >> 5;
#pragma unroll
  for (int mb = 0; mb < 2; ++mb)
#pragma unroll
    for (int nb = 0; nb < 2; ++nb)
#pragma unroll
      for (int i = 0; i < 16; ++i) sC[(64 * wm + 32 * mb + crow(i, hh)) * 132 + 64 * wn + 32 * nb + r] = acc[mb][nb][i];
}
DI void stage_acc_t(const f32x16 (&acc)[2][2], float* sC) {
  const int lane = threadIdx.x & 63, w = threadIdx.x >> 6, wm = w >> 1, wn = w & 1, r = lane & 31, hh = lane >> 5;
#pragma unroll
  for (int mb = 0; mb < 2; ++mb)
#pragma unroll
    for (int nb = 0; nb < 2; ++nb)
#pragma unroll
      for (int g = 0; g < 4; ++g) {
        float4 v = make_float4(acc[mb][nb][4 * g], acc[mb][nb][4 * g + 1], acc[mb][nb][4 * g + 2], acc[mb][nb][4 * g + 3]);
        *(float4*)(sC + (64 * wn + 32 * nb + r) * 132 + 64 * wm + 32 * mb + 8 * g + 4 * hh) = v;
      }
}

DI void phase_gla_in(const Params& p, int gi, unsigned char* smem) {
  const bfr* A = (const bfr*)(p.ws + OFF_H);
  const bfr* Bt = (const bfr*)(p.ws + OFF_WT_GLA_IN) + (size_t)gi * GLA_NPAD * 1024;
  bfr* gq = (bfr*)(p.ws + OFF_PROJ + PJ_GQ);
  bfr* gk = (bfr*)(p.ws + OFF_PROJ + PJ_GK);
  bfr* gg = (bfr*)(p.ws + OFF_PROJ + PJ_GG);
  bfr* gvt = (bfr*)(p.ws + OFF_PROJ + PJ_GVT);
  float* tb = (float*)(p.ws + OFF_TBUF);
  float* sC = (float*)smem;
  const int tid = threadIdx.x;
  constexpr int NT = 25, MT = 64;
  for (int tile = blockIdx.x; tile < NT * MT; tile += gridDim.x) {
    const int mt = tile / NT, nt = tile % NT, m0 = mt * 128, n0 = nt * 128;
    f32x16 acc[2][2];
    gemm_core(A, Bt, 1024, m0, n0, smem, acc);
    if (nt >= 8 && nt < 16) {
      stage_acc_t(acc, sC);
      __syncthreads();
#pragma unroll 4
      for (int it = 0; it < 16; ++it) {
        int idx = it * 256 + tid, col = idx >> 5, r4 = (idx & 31) * 4;
        float4 v = *(const float4*)(sC + col * 132 + r4);
        *(uint2*)(gvt + (size_t)((nt - 8) * 128 + col) * NTOK + m0 + r4) = make_uint2(pack2(v.x, v.y), pack2(v.z, v.w));
      }
    } else {
      stage_acc(acc, sC);
      __syncthreads();
#pragma unroll 4
      for (int it = 0; it < 16; ++it) {
        int idx = it * 256 + tid, row = idx >> 5, c4 = (idx & 31) * 4;
        float4 v = *(const float4*)(sC + row * 132 + c4);
        size_t grow = m0 + row;
        if (nt < 4) {
          const float s = 0.08838834764831845f;
          *(uint2*)(gq + grow * 512 + n0 + c4) = make_uint2(pack2(v.x * s, v.y * s), pack2(v.z * s, v.w * s));
        } else if (nt < 8) {
          *(uint2*)(gk + grow * 512 + (n0 - 512) + c4) = make_uint2(pack2(v.x, v.y), pack2(v.z, v.w));
        } else if (nt < 24) {
          *(uint2*)(gg + grow * 1024 + (n0 - 2048) + c4) =
              make_uint2(pack2(siluf(v.x), siluf(v.y)), pack2(siluf(v.z), siluf(v.w)));
        } else {
          if (c4 < 32) *(float4*)(tb + grow * 32 + c4) = v;
        }
      }
    }
    __syncthreads();
  }
}

DI void phase_gla_prep(const Params& p, int gi, unsigned char* smem) {
  const bfr* gq = (const bfr*)(p.ws + OFF_PROJ + PJ_GQ);
  const bfr* gk = (const bfr*)(p.ws + OFF_PROJ + PJ_GK);
  const float* tb = (const float*)(p.ws + OFF_TBUF);
  bfr* qe_o = (bfr*)(p.ws + OFF_QE);
  bfr* kdt_o = (bfr*)(p.ws + OFF_KDT);
  bfr* a_o = (bfr*)(p.ws + OFF_ABUF);
  float* el_o = (float*)(p.ws + OFF_ELAST);
  bfr* sQ = (bfr*)smem;
  bfr* sK = sQ + 64 * 136;
  float* tl = (float*)(sK + 64 * 136);
  float* tot = tl + 64 * 16;
  const int tid = threadIdx.x, lane = tid & 63, w = tid >> 6, r = lane & 31, hh = lane >> 5;
  const int dk = tid & 127, half = tid >> 7;
  for (int u = blockIdx.x; u < 1024; u += gridDim.x) {
    const int d = u >> 9, cgi = (u >> 2) & 127, hd = u & 3;
    const int token0 = cgi * 64;
    {
      int s = tid >> 2, j4 = (tid & 3) * 4;
      *(float4*)(tl + s * 16 + j4) = *(const float4*)(tb + (size_t)(token0 + s) * 32 + d * 16 + j4);
    }
#pragma unroll
    for (int j = 0; j < 4; ++j) {
      int id = j * 256 + tid, row = id >> 4, ch = (id & 15) * 8;
      *(uint4*)(sQ + row * 136 + ch) = *(const uint4*)(gq + (size_t)(token0 + row) * 512 + hd * 128 + ch);
      *(uint4*)(sK + row * 136 + ch) = *(const uint4*)(gk + (size_t)(token0 + row) * 512 + hd * 128 + ch);
    }
    float w2[16];
    const float* wa2 = p.in[I_GWA2] + (size_t)(gi * 2 + d) * 16 * 512 + hd * 128 + dk;
#pragma unroll
    for (int j = 0; j < 16; ++j) w2[j] = wa2[j * 512];
    const float bias = p.in[I_GBA][(gi * 2 + d) * 512 + hd * 128 + dk];
    __syncthreads();
    float pc[32];
    float cum = 0.f;
#pragma unroll
    for (int sl = 0; sl < 32; ++sl) {
      const float* tr = tl + (half * 32 + sl) * 16;
      float z = bias;
#pragma unroll
      for (int j4 = 0; j4 < 4; ++j4) {
        float4 tv = *(const float4*)(tr + j4 * 4);
        z += tv.x * w2[j4 * 4] + tv.y * w2[j4 * 4 + 1] + tv.z * w2[j4 * 4 + 2] + tv.w * w2[j4 * 4 + 3];
      }
      float lg = (fminf(z, 0.f) - log1pf(expf(-fabsf(z)))) * (1.f / 16.f);
      cum += lg;
      pc[sl] = cum;
    }
    tot[half * 128 + dk] = cum;
    __syncthreads();
    const float t0 = tot[dk], t1 = tot[128 + dk];
    const float total = t0 + t1;
    const float base = half ? t0 : 0.f;
    const float etot = expf(total);
    if (half == 0) el_o[(size_t)u * 128 + dk] = etot;
    unsigned kdp[16];
    float kd_prev = 0.f;
#pragma unroll
    for (int sl = 0; sl < 32; ++sl) {
      const int s = half * 32 + sl;
      const float pin = base + pc[sl];
      const float pex = base + (sl == 0 ? 0.f : pc[sl == 0 ? 0 : sl - 1]);
      const float b = d ? (total - pex) : pin;
      const float qv = bf2f(sQ[s * 136 + dk]), kv = bf2f(sK[s * 136 + dk]);
      const float eb = expf(b), enb = 1.f / eb;
      const float qe = qv * eb, ke = kv * enb, kd = kv * (etot * enb);
      sQ[s * 136 + dk] = f2bf(qe);
      sK[s * 136 + dk] = f2bf(ke);
      if (sl & 1) kdp[sl >> 1] = pack2(kd_prev, kd); else kd_prev = kd;
    }
    {
      uint4* dst = (uint4*)(kdt_o + ((size_t)u * 128 + dk) * 64 + half * 32);
      dst[0] = make_uint4(kdp[0], kdp[1], kdp[2], kdp[3]);
      dst[1] = make_uint4(kdp[4], kdp[5], kdp[6], kdp[7]);
      dst[2] = make_uint4(kdp[8], kdp[9], kdp[10], kdp[11]);
      dst[3] = make_uint4(kdp[12], kdp[13], kdp[14], kdp[15]);
    }
    __syncthreads();
#pragma unroll
    for (int j = 0; j < 4; ++j) {
      int id = j * 256 + tid, row = id >> 4, ch = (id & 15) * 8;
      *(uint4*)(qe_o + ((size_t)u * 64 + row) * 128 + ch) = *(const uint4*)(sQ + row * 136 + ch);
    }
    const int sb = w >> 1, tbk = w & 1;
    f32x16 acc;
#pragma unroll
    for (int i = 0; i < 16; ++i) acc[i] = 0.f;
#pragma unroll
    for (int kk = 0; kk < 8; ++kk) {
      bf16x8 a = *(const bf16x8*)(sK + (32 * sb + r) * 136 + 16 * kk + 8 * hh);
      bf16x8 b = *(const bf16x8*)(sQ + (32 * tbk + r) * 136 + 16 * kk + 8 * hh);
      acc = MFMA32(a, b, acc);
    }
    const int t = 32 * tbk + r;
#pragma unroll
    for (int g = 0; g < 4; ++g) {
      const int s4 = 32 * sb + 8 * g + 4 * hh;
      float v[4];
#pragma unroll
      for (int j = 0; j < 4; ++j) {
        const int s = s4 + j;
        const bool keep = d ? (s >= t) : (s <= t);
        v[j] = keep ? acc[4 * g + j] : 0.f;
      }
      *(uint2*)(a_o + ((size_t)u * 64 + t) * 64 + s4) = make_uint2(pack2(v[0], v[1]), pack2(v[2], v[3]));
    }
    __syncthreads();
  }
}

DI void gla_scan_unit(const Params& p, int gi, bool sample, int b, int rem, unsigned char* smem) {
  const int hd = rem >> 3, d = (rem >> 2) & 1, sp = rem & 3;
  const int nch = sample ? 16 : 4;
  const int cg0 = sample ? 64 + b * 16 : b * 4;
  const bfr* qe_i = (const bfr*)(p.ws + OFF_QE);
  const bfr* kdt_i = (const bfr*)(p.ws + OFF_KDT);
  const bfr* a_i = (const bfr*)(p.ws + OFF_ABUF);
  const float* el_i = (const float*)(p.ws + OFF_ELAST);
  const bfr* gvt = (const bfr*)(p.ws + OFF_PROJ + PJ_GVT);
  bfr* o_o = (bfr*)(p.ws + OFF_O) + (size_t)d * NTOK * 1024;
  bfr* sSt = (bfr*)smem;
  bfr* sQ = sSt + 64 * 136;
  bfr* sA = sQ + 64 * 136;
  bfr* sV = sA + 64 * 72;
  bfr* sKd = sV + 64 * 72;
  const int tid = threadIdx.x, lane = tid & 63, w = tid >> 6, r = lane & 31, hh = lane >> 5;
  f32x16 S[2];
  if (sample) {
    const float* st = p.in[I_STATE] + ((((size_t)(b * 2 + gi) * 2 + d) * 4 + hd) * 128) * 256 + sp * 64;
#pragma unroll
    for (int nb = 0; nb < 2; ++nb)
#pragma unroll
      for (int i = 0; i < 16; ++i) S[nb][i] = st[(size_t)(32 * w + crow(i, hh)) * 256 + 32 * nb + r];
  } else {
#pragma unroll
    for (int nb = 0; nb < 2; ++nb)
#pragma unroll
      for (int i = 0; i < 16; ++i) S[nb][i] = 0.f;
  }
  for (int c = 0; c < nch; ++c) {
    const int cl = d ? nch - 1 - c : c;
    const int cgi = cg0 + cl;
    const int u = (d * 128 + cgi) * 4 + hd;
    const int token0 = cgi * 64;
#pragma unroll
    for (int j = 0; j < 4; ++j) {
      int id = j * 256 + tid, row = id >> 4, ch = (id & 15) * 8;
      *(uint4*)(sQ + row * 136 + ch) = *(const uint4*)(qe_i + ((size_t)u * 64 + row) * 128 + ch);
    }
#pragma unroll
    for (int j = 0; j < 2; ++j) {
      int id = j * 256 + tid, row = id >> 3, ch = (id & 7) * 8;
      *(uint4*)(sA + row * 72 + ch) = *(const uint4*)(a_i + ((size_t)u * 64 + row) * 64 + ch);
      *(uint4*)(sV + row * 72 + ch) = *(const uint4*)(gvt + (size_t)(hd * 256 + sp * 64 + row) * NTOK + token0 + ch);
    }
#pragma unroll
    for (int j = 0; j < 4; ++j) {
      int id = j * 256 + tid, row = id >> 3, ch = (id & 7) * 8;
      *(uint4*)(sKd + row * 72 + ch) = *(const uint4*)(kdt_i + ((size_t)u * 128 + row) * 64 + ch);
    }
    float4 el[4];
#pragma unroll
    for (int g = 0; g < 4; ++g) el[g] = *(const float4*)(el_i + (size_t)u * 128 + 32 * w + 8 * g + 4 * hh);
#pragma unroll
    for (int nb = 0; nb < 2; ++nb)
#pragma unroll
      for (int g = 0; g < 4; ++g)
        *(uint2*)(sSt + (32 * nb + r) * 136 + 32 * w + 8 * g + 4 * hh) =
            make_uint2(pack2(S[nb][4 * g], S[nb][4 * g + 1]), pack2(S[nb][4 * g + 2], S[nb][4 * g + 3]));
    __syncthreads();
    {
      const int tbk = w >> 1, nbo = w & 1;
      f32x16 oa;
#pragma unroll
      for (int i = 0; i < 16; ++i) oa[i] = 0.f;
#pragma unroll
      for (int kk = 0; kk < 8; ++kk) {
        bf16x8 a = *(const bf16x8*)(sQ + (32 * tbk + r) * 136 + 16 * kk + 8 * hh);
        bf16x8 bb = *(const bf16x8*)(sSt + (32 * nbo + r) * 136 + 16 * kk + 8 * hh);
        oa = MFMA32(a, bb, oa);
      }
#pragma unroll
      for (int kk = 0; kk < 4; ++kk) {
        bf16x8 a = *(const bf16x8*)(sA + (32 * tbk + r) * 72 + 16 * kk + 8 * hh);
        bf16x8 bb = *(const bf16x8*)(sV + (32 * nbo + r) * 72 + 16 * kk + 8 * hh);
        oa = MFMA32(a, bb, oa);
      }
#pragma unroll
      for (int i = 0; i < 16; ++i)
        o_o[(size_t)(token0 + 32 * tbk + crow(i, hh)) * 1024 + hd * 256 + sp * 64 + 32 * nbo + r] = f2bf(oa[i]);
    }
#pragma unroll
    for (int nb = 0; nb < 2; ++nb)
#pragma unroll
      for (int g = 0; g < 4; ++g) {
        S[nb][4 * g] *= el[g].x; S[nb][4 * g + 1] *= el[g].y; S[nb][4 * g + 2] *= el[g].z; S[nb][4 * g + 3] *= el[g].w;
      }
#pragma unroll
    for (int kk = 0; kk < 4; ++kk) {
      bf16x8 a = *(const bf16x8*)(sKd + (32 * w + r) * 72 + 16 * kk + 8 * hh);
#pragma unroll
      for (int nb = 0; nb < 2; ++nb) {
        bf16x8 bb = *(const bf16x8*)(sV + (32 * nb + r) * 72 + 16 * kk + 8 * hh);
        S[nb] = MFMA32(a, bb, S[nb]);
      }
    }
    __syncthreads();
  }
  if (!sample) {
    float* so = p.out + OUT_STATE + ((((size_t)(b * 2 + gi) * 2 + d) * 4 + hd) * 128) * 256 + sp * 64;
#pragma unroll
    for (int nb = 0; nb < 2; ++nb)
#pragma unroll
      for (int i = 0; i < 16; ++i) so[(size_t)(32 * w + crow(i, hh)) * 256 + 32 * nb + r] = S[nb][i];
  }
}
DI void phase_gla_scan(const Params& p, int gi, unsigned char* smem) {
  const int nb = gridDim.x, bid = blockIdx.x;
  int idx, step;
  if (nb >= 256) { idx = bid; step = bid < 128 ? 640 : nb - 128; }
  else { idx = bid; step = nb; }
  for (; idx < 640; idx += step) {
    const bool sample = idx < 128;
    const int q = sample ? idx : idx - 128;
    gla_scan_unit(p, gi, sample, q >> 5, q & 31, smem);
  }
}

DI void phase_gla_post(const Params& p, int gi) {
  const int lane = threadIdx.x & 63;
  const int gw = blockIdx.x * 4 + (threadIdx.x >> 6), nw = gridDim.x * 4;
  const bfr* o0 = (const bfr*)(p.ws + OFF_O);
  const bfr* o1 = o0 + (size_t)NTOK * 1024;
  const bfr* gg = (const bfr*)(p.ws + OFF_PROJ + PJ_GG);
  bfr* uo = (bfr*)(p.ws + OFF_U);
  const float4 on = *(const float4*)(p.in[I_GONORM] + gi * 256 + lane * 4);
  for (int row = gw; row < NTOK; row += nw) {
#pragma unroll
    for (int hd = 0; hd < 4; ++hd) {
      size_t idx = (size_t)row * 1024 + hd * 256 + lane * 4;
      uint2 a = *(const uint2*)(o0 + idx), b = *(const uint2*)(o1 + idx), g = *(const uint2*)(gg + idx);
      float v0 = bf2f(a.x & 0xffff) + bf2f(b.x & 0xffff), v1 = bf2f(a.x >> 16) + bf2f(b.x >> 16);
      float v2 = bf2f(a.y & 0xffff) + bf2f(b.y & 0xffff), v3 = bf2f(a.y >> 16) + bf2f(b.y >> 16);
      float ss = wave_sum(v0 * v0 + v1 * v1 + v2 * v2 + v3 * v3);
      float rstd = rsqrtf(ss * (1.f / 256.f) + EPSN);
      float r0 = v0 * rstd * on.x * bf2f(g.x & 0xffff), r1 = v1 * rstd * on.y * bf2f(g.x >> 16);
      float r2 = v2 * rstd * on.z * bf2f(g.y & 0xffff), r3 = v3 * rstd * on.w * bf2f(g.y >> 16);
      *(uint2*)(uo + idx) = make_uint2(pack2(r0, r1), pack2(r2, r3));
    }
  }
}

DI void phase_out_proj(const Params& p, int l, const bfr* Bt, unsigned char* smem) {
  const bfr* A = (const bfr*)(p.ws + OFF_U);
  const float* mod = (const float*)(p.ws + OFF_MOD) + (size_t)l * 5 * 3072;
  float* sC = (float*)smem;
  const int tid = threadIdx.x;
  for (int tile = blockIdx.x; tile < 8 * 64; tile += gridDim.x) {
    const int mt = tile >> 3, nt = tile & 7, m0 = mt * 128, n0 = nt * 128;
    f32x16 acc[2][2];
    gemm_core(A, Bt, 1024, m0, n0, smem, acc);
    stage_acc(acc, sC);
    __syncthreads();
#pragma unroll 4
    for (int it = 0; it < 16; ++it) {
      int idx = it * 256 + tid, row = idx >> 5, c4 = (idx & 31) * 4;
      float4 v = *(const float4*)(sC + row * 132 + c4);
      int grow = m0 + row, col = n0 + c4;
      float4 xo = *(const float4*)(xrow_ptr(p, l, grow) + col);
      float4 gt = *(const float4*)(mod + modrow(grow) * 3072 + 2048 + col);
      float4 o = make_float4(xo.x + gt.x * v.x, xo.y + gt.y * v.y, xo.z + gt.z * v.z, xo.w + gt.w * v.w);
      *(float4*)(p.out + (size_t)grow * DM + col) = o;
    }
    __syncthreads();
  }
}

DI void phase_att_in(const Params& p, int ai, unsigned char* smem) {
  const bfr* A = (const bfr*)(p.ws + OFF_H);
  const bfr* Bt = (const bfr*)(p.ws + OFF_WT_ATT_IN) + (size_t)ai * ATT_N * 1024;
  bfr* aq = (bfr*)(p.ws + OFF_PROJ + PJ_AQ);
  bfr* ag = (bfr*)(p.ws + OFF_PROJ + PJ_AG);
  bfr* akp = (bfr*)(p.ws + OFF_PROJ + PJ_AKP);
  bfr* avpt = (bfr*)(p.ws + OFF_PROJ + PJ_AVPT);
  bfr* ks = (bfr*)(p.ws + OFF_KS);
  bfr* vst = (bfr*)(p.ws + OFF_VST);
  const float* rc = (const float*)(p.ws + OFF_ROPE);
  const float* rs = rc + 64 * 32;
  const float* qn = p.in[I_AQN] + ai * 128;
  const float* kn = p.in[I_AKN] + ai * 128;
  float* sC = (float*)smem;
  const int tid = threadIdx.x;
  constexpr int NT = 20, MT = 64;
  for (int tile = blockIdx.x; tile < NT * MT; tile += gridDim.x) {
    const int mt = tile / NT, nt = tile % NT, m0 = mt * 128, n0 = nt * 128;
    const bool samp = m0 >= NPT;
    f32x16 acc[2][2];
    gemm_core(A, Bt, 1024, m0, n0, smem, acc);
    if (nt == 10 || nt == 11) {
      const int hk = nt - 10;
      stage_acc_t(acc, sC);
      __syncthreads();
      bfr* dst; size_t ldt;
      if (!samp) { int b = m0 >> 8, t0 = m0 & 255; dst = avpt + (size_t)((b * 2 + hk) * 128) * 256 + t0; ldt = 256; }
      else { int b = (m0 - NPT) >> 10, t0 = (m0 - NPT) & 1023; dst = vst + (size_t)(((ai * 4 + b) * 2 + hk) * 128) * 1280 + t0; ldt = 1280; }
#pragma unroll 4
      for (int it = 0; it < 16; ++it) {
        int idx = it * 256 + tid, col = idx >> 5, r4 = (idx & 31) * 4;
        float4 v = *(const float4*)(sC + col * 132 + r4);
        *(uint2*)(dst + (size_t)col * ldt + r4) = make_uint2(pack2(v.x, v.y), pack2(v.z, v.w));
      }
      if (!samp) {
        __syncthreads();
        stage_acc(acc, sC);
        __syncthreads();
        const int b = m0 >> 8, t0 = m0 & 255;
#pragma unroll 4
        for (int it = 0; it < 16; ++it) {
          int idx = it * 256 + tid, row = idx >> 5, c4 = (idx & 31) * 4;
          float4 v = *(const float4*)(sC + row * 132 + c4);
          *(float4*)(p.out + OUT_CV + ((((size_t)b * 2 + ai) * 256 + t0 + row) * 2 + hk) * 128 + c4) = v;
        }
      }
    } else {
      stage_acc(acc, sC);
      __syncthreads();
#pragma unroll 2
      for (int it = 0; it < 16; ++it) {
        int idx = it * 256 + tid, row = idx >> 5, c4 = (idx & 31) * 4;
        float4 v = *(const float4*)(sC + row * 132 + c4);
        const int grow = m0 + row;
        if (nt >= 12) {
          *(uint2*)(ag + (size_t)grow * 1024 + (n0 - 1536) + c4) =
              make_uint2(pack2(siluf(v.x), siluf(v.y)), pack2(siluf(v.z), siluf(v.w)));
        } else {
          float ss = half_sum(v.x * v.x + v.y * v.y + v.z * v.z + v.w * v.w);
          const float rstd = rsqrtf(ss * (1.f / 128.f) + EPSN);
          const float* wn = nt < 8 ? qn : kn;
          float4 wv = *(const float4*)(wn + c4);
          float4 xn = make_float4(v.x * rstd * wv.x, v.y * rstd * wv.y, v.z * rstd * wv.z, v.w * rstd * wv.w);
          float4 o = xn;
          if (samp) {
            const int cp = c4 ^ 32;
            float4 pv = *(const float4*)(sC + row * 132 + cp);
            float4 pw = *(const float4*)(wn + cp);
            float4 pn = make_float4(pv.x * rstd * pw.x, pv.y * rstd * pw.y, pv.z * rstd * pw.z, pv.w * rstd * pw.w);
            const int t = (grow - NPT) & 1023;
            const int pos = (c4 < 64) ? (t >> 6) : (t & 63);
            float4 cs = *(const float4*)(rc + pos * 32 + (c4 & 31));
            float4 sn = *(const float4*)(rs + pos * 32 + (c4 & 31));
            const float sg = (c4 & 32) ? 1.f : -1.f;
            o = make_float4(xn.x * cs.x + sg * pn.x * sn.x, xn.y * cs.y + sg * pn.y * sn.y,
                            xn.z * cs.z + sg * pn.z * sn.z, xn.w * cs.w + sg * pn.w * sn.w);
          }
          if (nt < 8) {
            const float s = 0.08838834764831845f * 1.4426950408889634f;
            *(uint2*)(aq + (size_t)grow * 1024 + n0 + c4) = make_uint2(pack2(o.x * s, o.y * s), pack2(o.z * s, o.w * s));
          } else {
            const int hk = nt - 8;
            uint2 ob = make_uint2(pack2(o.x, o.y), pack2(o.z, o.w));
            if (!samp) {
              const int b = grow >> 8, t = grow & 255;
              *(float4*)(p.out + OUT_CK + ((((size_t)b * 2 + ai) * 256 + t) * 2 + hk) * 128 + c4) = o;
              *(uint2*)(akp + (size_t)grow * 256 + hk * 128 + c4) = ob;
            } else {
              const int b = (grow - NPT) >> 10, t = (grow - NPT) & 1023;
              *(uint2*)(ks + ((size_t)(ai * 4 + b) * 1280 + t) * 256 + hk * 128 + c4) = ob;
            }
          }
        }
      }
    }
    __syncthreads();
  }
}

DI void attn_unit(const Params& p, int ai, bool sample, int unit, unsigned char* smem) {
  int b, hkv, qb, ntile, tokq0;
  const bfr* Kb; const bfr* Vb; size_t ldt;
  if (sample) {
    b = unit >> 6; hkv = (unit >> 5) & 1; qb = unit & 31; ntile = 20;
    tokq0 = NPT + b * 1024 + qb * 32;
    Kb = (const bfr*)(p.ws + OFF_KS) + (size_t)(ai * 4 + b) * 1280 * 256 + hkv * 128;
    Vb = (const bfr*)(p.ws + OFF_VST) + (size_t)(((ai * 4 + b) * 2 + hkv) * 128) * 1280; ldt = 1280;
  } else {
    b = unit >> 4; hkv = (unit >> 3) & 1; qb = unit & 7; ntile = 4;
    tokq0 = b * 256 + qb * 32;
    Kb = (const bfr*)(p.ws + OFF_PROJ + PJ_AKP) + (size_t)(b * 256) * 256 + hkv * 128;
    Vb = (const bfr*)(p.ws + OFF_PROJ + PJ_AVPT) + (size_t)((b * 2 + hkv) * 128) * 256; ldt = 256;
  }
  const bfr* aq = (const bfr*)(p.ws + OFF_PROJ + PJ_AQ);
  const bfr* ag = (const bfr*)(p.ws + OFF_PROJ + PJ_AG);
  bfr* uo = (bfr*)(p.ws + OFF_U);
  const int tid = threadIdx.x, lane = tid & 63, w = tid >> 6, r = lane & 31, hh = lane >> 5;
  const int hq = hkv * 4 + w;
  bfr* sK = (bfr*)smem;
  bfr* sV = sK + 2 * 64 * 136;
  bf16x8 qf[8];
#pragma unroll
  for (int kk = 0; kk < 8; ++kk) qf[kk] = *(const bf16x8*)(aq + (size_t)(tokq0 + r) * 1024 + hq * 128 + 16 * kk + 8 * hh);
  f32x16 oacc[4];
#pragma unroll
  for (int a = 0; a < 4; ++a)
#pragma unroll
    for (int i = 0; i < 16; ++i) oacc[a][i] = 0.f;
  float m_run = -INFINITY, l_run = 0.f;
  uint4 rk[4], rv[4];
  const int krow = tid >> 4, kch = (tid & 15) * 8;
  const int vrow = tid >> 3, vch = (tid & 7) * 8;
#pragma unroll
  for (int j = 0; j < 4; ++j) {
    rk[j] = *(const uint4*)(Kb + (size_t)(krow + 16 * j) * 256 + kch);
    rv[j] = *(const uint4*)(Vb + (size_t)(vrow + 32 * j) * ldt + vch);
  }
#pragma unroll
  for (int j = 0; j < 4; ++j) {
    *(uint4*)(sK + (krow + 16 * j) * 136 + kch) = rk[j];
    *(uint4*)(sV + (vrow + 32 * j) * 72 + vch) = rv[j];
  }
  __syncthreads();
  for (int kt = 0; kt < ntile; ++kt) {
    const int cur = kt & 1;
    {
      const int key0 = (kt + 1 < ntile ? kt + 1 : kt) * 64;
#pragma unroll
      for (int j = 0; j < 4; ++j) {
        rk[j] = *(const uint4*)(Kb + (size_t)(key0 + krow + 16 * j) * 256 + kch);
        rv[j] = *(const uint4*)(Vb + (size_t)(vrow + 32 * j) * ldt + key0 + vch);
      }
    }
    const bfr* cK = sK + cur * 64 * 136;
    const bfr* cV = sV + cur * 128 * 72;
    f32x16 sacc[2];
#pragma unroll
    for (int kb = 0; kb < 2; ++kb) {
#pragma unroll
      for (int i = 0; i < 16; ++i) sacc[kb][i] = 0.f;
#pragma unroll
      for (int kk = 0; kk < 8; ++kk) {
        bf16x8 a = *(const bf16x8*)(cK + (32 * kb + r) * 136 + 16 * kk + 8 * hh);
        sacc[kb] = MFMA32(a, qf[kk], sacc[kb]);
      }
    }
    float mt = sacc[0][0];
#pragma unroll
    for (int kb = 0; kb < 2; ++kb)
#pragma unroll
      for (int i = 0; i < 16; ++i) mt = fmaxf(mt, sacc[kb][i]);
    mt = fmaxf(mt, __shfl_xor(mt, 32));
    const float m_new = fmaxf(m_run, mt);
    const float alpha = exp2f(m_run - m_new);
    m_run = m_new;
    float ls = 0.f;
#pragma unroll
    for (int kb = 0; kb < 2; ++kb)
#pragma unroll
      for (int i = 0; i < 16; ++i) { float pv = exp2f(sacc[kb][i] - m_new); sacc[kb][i] = pv; ls += pv; }
    l_run = l_run * alpha + ls;
#pragma unroll
    for (int a = 0; a < 4; ++a)
#pragma unroll
      for (int i = 0; i < 16; ++i) oacc[a][i] *= alpha;
#pragma unroll
    for (int kb = 0; kb < 2; ++kb)
#pragma unroll
      for (int s2 = 0; s2 < 2; ++s2) {
        unsigned pk[4];
#pragma unroll
        for (int j = 0; j < 4; ++j) pk[j] = pack2(sacc[kb][8 * s2 + 2 * j], sacc[kb][8 * s2 + 2 * j + 1]);
        bf16x8 pb = __builtin_bit_cast(bf16x8, make_uint4(pk[0], pk[1], pk[2], pk[3]));
#pragma unroll
        for (int dvb = 0; dvb < 4; ++dvb) {
          const bfr* vp = cV + (32 * dvb + r) * 72 + 32 * kb + 16 * s2 + 4 * hh;
          uint2 lo = *(const uint2*)vp, hi = *(const uint2*)(vp + 8);
          bf16x8 av = __builtin_bit_cast(bf16x8, make_uint4(lo.x, lo.y, hi.x, hi.y));
          oacc[dvb] = MFMA32(av, pb, oacc[dvb]);
        }
      }
    {
      bfr* nK = sK + (cur ^ 1) * 64 * 136;
      bfr* nV = sV + (cur ^ 1) * 128 * 72;
#pragma unroll
      for (int j = 0; j < 4; ++j) {
        *(uint4*)(nK + (krow + 16 * j) * 136 + kch) = rk[j];
        *(uint4*)(nV + (vrow + 32 * j) * 72 + vch) = rv[j];
      }
    }
    __syncthreads();
  }
  const float lt = l_run + __shfl_xor(l_run, 32);
  const float inv = 1.f / lt;
#pragma unroll
  for (int dvb = 0; dvb < 4; ++dvb)
#pragma unroll
    for (int g = 0; g < 4; ++g) {
      size_t idx = (size_t)(tokq0 + r) * 1024 + hq * 128 + 32 * dvb + 8 * g + 4 * hh;
      uint2 gv = *(const uint2*)(ag + idx);
      float o0 = oacc[dvb][4 * g] * inv * bf2f(gv.x & 0xffff), o1 = oacc[dvb][4 * g + 1] * inv * bf2f(gv.x >> 16);
      float o2 = oacc[dvb][4 * g + 2] * inv * bf2f(gv.y & 0xffff), o3 = oacc[dvb][4 * g + 3] * inv * bf2f(gv.y >> 16);
      *(uint2*)(uo + idx) = make_uint2(pack2(o0, o1), pack2(o2, o3));
    }
}
DI void phase_attn(const Params& p, int ai, unsigned char* smem) {
  const int nb = gridDim.x, bid = blockIdx.x;
  int idx, step;
  if (nb >= 512) { idx = bid; step = bid < 256 ? 512 : nb - 256; }
  else { idx = bid; step = nb; }
  for (; idx < 512; idx += step) {
    const bool sample = idx < 256;
    attn_unit(p, ai, sample, sample ? idx : idx - 256, smem);
  }
}

__global__ void __launch_bounds__(256, 2) fwd_megakernel(Params p) {
  __shared__ __attribute__((aligned(16))) unsigned char smem[SMEM_BYTES];
  cg::grid_group grid = cg::this_grid();
  phase0(p, smem);
  grid.sync();
  phase_norm(p, 0); grid.sync();
  phase_gla_in(p, 0, smem); grid.sync();
  phase_gla_prep(p, 0, smem); grid.sync();
  phase_gla_scan(p, 0, smem); grid.sync();
  phase_gla_post(p, 0); grid.sync();
  phase_out_proj(p, 0, (const bfr*)(p.ws + OFF_WT_GLA_OUT), smem); grid.sync();
  phase_norm(p, 1); grid.sync();
  phase_att_in(p, 0, smem); grid.sync();
  phase_attn(p, 0, smem); grid.sync();
  phase_out_proj(p, 1, (const bfr*)(p.ws + OFF_WT_ATT_OUT), smem); grid.sync();
  phase_norm(p, 2); grid.sync();
  phase_gla_in(p, 1, smem); grid.sync();
  phase_gla_prep(p, 1, smem); grid.sync();
  phase_gla_scan(p, 1, smem); grid.sync();
  phase_gla_post(p, 1); grid.sync();
  phase_out_proj(p, 2, (const bfr*)(p.ws + OFF_WT_GLA_OUT) + (size_t)1024 * 1024, smem); grid.sync();
  phase_norm(p, 3); grid.sync();
  phase_att_in(p, 1, smem); grid.sync();
  phase_attn(p, 1, smem); grid.sync();
  phase_out_proj(p, 3, (const bfr*)(p.ws + OFF_WT_ATT_OUT) + (size_t)1024 * 1024, smem);
}

extern "C" void kernel_launch(void* const* d_in, const int* in_sizes, int n_in, void* d_out, int out_size, void* d_ws,
                              size_t ws_size, hipStream_t stream) {
  static int grid_blocks = 0;
  if (!grid_blocks) {
    int dev = 0, cus = 0, per_cu = 0;
    hipGetDevice(&dev);
    hipDeviceGetAttribute(&cus, hipDeviceAttributeMultiprocessorCount, dev);
    hipOccupancyMaxActiveBlocksPerMultiprocessor(&per_cu, fwd_megakernel, 256, 0);
    if (per_cu > 2) per_cu = 2;
    if (per_cu < 1) per_cu = 1;
    grid_blocks = cus * per_cu;
  }
  Params p{};
  for (int i = 0; i < 20; ++i) p.in[i] = (const float*)d_in[i];
  p.out = (float*)d_out;
  p.ws = (unsigned char*)d_ws;
  void* args[] = {&p};
  hipError_t e = hipLaunchCooperativeKernel((void*)fwd_megakernel, dim3(grid_blocks), dim3(256), args, 0, stream);
  if (e != hipSuccess) fprintf(stderr, "cooperative launch failed: %s (grid %d)\n", hipGetErrorString(e), grid_blocks);
}
```

```cpp
#include <hip/hip_runtime.h>
#include <hip/hip_cooperative_groups.h>
#include <stdint.h>
#include <stdio.h>
namespace cg = cooperative_groups;

typedef unsigned short bfr;
using bf16x8 = __attribute__((ext_vector_type(8))) short;
using bf16x4 = __attribute__((ext_vector_type(4))) short;
using f32x16 = __attribute__((ext_vector_type(16))) float;
using f32x4 = __attribute__((ext_vector_type(4))) float;
#define DI __device__ __forceinline__
#define MFMA32(a, b, c) __builtin_amdgcn_mfma_f32_32x32x16_bf16((a), (b), (c), 0, 0, 0)

constexpr int NTOK = 8192;
constexpr int DM = 1024;
constexpr int NPT = 4096;
constexpr float EPSN = 1e-6f;
constexpr int GLA_NPAD = 3200;
constexpr int ATT_N = 2560;

constexpr size_t OFF_WT_GLA_IN = 0;
constexpr size_t OFF_WT_GLA_OUT = OFF_WT_GLA_IN + 2ull * GLA_NPAD * 1024 * 2;
constexpr size_t OFF_WT_ATT_IN = OFF_WT_GLA_OUT + 2ull * 1024 * 1024 * 2;
constexpr size_t OFF_WT_ATT_OUT = OFF_WT_ATT_IN + 2ull * ATT_N * 1024 * 2;
constexpr size_t OFF_MOD = OFF_WT_ATT_OUT + 2ull * 1024 * 1024 * 2;
constexpr size_t OFF_ROPE = OFF_MOD + 4ull * 5 * 3072 * 4;
constexpr size_t OFF_H = OFF_ROPE + 2ull * 64 * 32 * 4;
constexpr size_t OFF_PROJ = OFF_H + (size_t)NTOK * 1024 * 2;
constexpr size_t OFF_TBUF = OFF_PROJ + (size_t)NTOK * 3072 * 2;
constexpr size_t OFF_QE = OFF_TBUF + (size_t)NTOK * 32 * 4;
constexpr size_t OFF_KDT = OFF_QE + 2ull * NTOK * 512 * 2;
constexpr size_t OFF_ABUF = OFF_KDT + 2ull * NTOK * 512 * 2;
constexpr size_t OFF_ELAST = OFF_ABUF + 1024ull * 64 * 64 * 2;
constexpr size_t OFF_O = OFF_ELAST + 1024ull * 128 * 4;
constexpr size_t OFF_U = OFF_O + 2ull * NTOK * 1024 * 2;
constexpr size_t OFF_KS = OFF_U + (size_t)NTOK * 1024 * 2;
constexpr size_t OFF_VST = OFF_KS + 2ull * 4 * 1280 * 256 * 2;
constexpr size_t OFF_BAR = OFF_VST + 2ull * 4 * 1280 * 256 * 2;
constexpr size_t WS_END = OFF_BAR + 3456 * 4;
constexpr size_t PJ_GQ = 0;
constexpr size_t PJ_GK = (size_t)NTOK * 512 * 2;
constexpr size_t PJ_GG = (size_t)NTOK * 1024 * 2;
constexpr size_t PJ_GVT = (size_t)NTOK * 2048 * 2;
constexpr size_t PJ_AQ = 0;
constexpr size_t PJ_AG = (size_t)NTOK * 1024 * 2;
constexpr size_t PJ_AKP = (size_t)NTOK * 2048 * 2;
constexpr size_t PJ_AVPT = PJ_AKP + 4096ull * 256 * 2;

constexpr size_t OUT_STATE = 2ull * 4096 * 1024;
constexpr size_t OUT_CK = OUT_STATE + 16ull * 2 * 2 * 4 * 128 * 256;
constexpr size_t OUT_CV = OUT_CK + 16ull * 2 * 256 * 2 * 128;

constexpr int SMEM_BYTES = 73728;

struct Params {
  const float* in[20];
  float* out;
  unsigned char* ws;
  int never;
  int pad;
};
enum { I_XP = 0, I_XS, I_STATE, I_CK, I_CV, I_C, I_CCTX, I_NORMG, I_WADA, I_BADA, I_GWIN, I_GWA1, I_GWA2, I_GBA,
       I_GONORM, I_GWOUT, I_AWIN, I_AQN, I_AKN, I_AWOUT };

DI bfr f2bf(float x) {
  unsigned u = __float_as_uint(x);
  u += 0x7fffu + ((u >> 16) & 1u);
  return (bfr)(u >> 16);
}
DI float bf2f(bfr b) { return __uint_as_float(((unsigned)b) << 16); }
DI unsigned pack2(float a, float b) { return (unsigned)f2bf(a) | ((unsigned)f2bf(b) << 16); }
DI int crow(int reg, int h) { return (reg & 3) + 8 * (reg >> 2) + 4 * h; }
DI float siluf(float x) { return x / (1.f + __expf(-x)); }
DI int modrow(int row) { return row < NPT ? 0 : 1 + ((row - NPT) >> 10); }
DI const float* xrow_ptr(const Params& p, int l, int row) {
  if (l == 0) return row < NPT ? p.in[I_XP] + (size_t)row * DM : p.in[I_XS] + (size_t)(row - NPT) * DM;
  return p.out + (size_t)row * DM;
}
DI float wave_sum(float v) {
#pragma unroll
  for (int o = 32; o >= 1; o >>= 1) v += __shfl_xor(v, o);
  return v;
}
DI float half_sum(float v) {
#pragma unroll
  for (int o = 16; o >= 1; o >>= 1) v += __shfl_xor(v, o);
  return v;
}

DI void transpose_tile(const float* __restrict__ src, int src_ld, int k0, int n0, int ncols, bfr* __restrict__ dst,
                       size_t dst_ld, unsigned char* smem) {
  float* tile = (float*)smem;
  const int tid = threadIdx.x;
  const int c4 = (tid & 15) * 4, kr = tid >> 4;
#pragma unroll
  for (int j = 0; j < 4; ++j) {
    int k = kr + 16 * j;
    if (c4 < ncols) {
      float4 v = *(const float4*)(src + (size_t)(k0 + k) * src_ld + n0 + c4);
      tile[k * 65 + c4] = v.x; tile[k * 65 + c4 + 1] = v.y; tile[k * 65 + c4 + 2] = v.z; tile[k * 65 + c4 + 3] = v.w;
    }
  }
  __syncthreads();
  const int n = tid >> 2, kq = (tid & 3) * 16;
  if (n < ncols) {
    unsigned pk[8];
#pragma unroll
    for (int j = 0; j < 8; ++j) pk[j] = pack2(tile[(kq + 2 * j) * 65 + n], tile[(kq + 2 * j + 1) * 65 + n]);
    uint4* d = (uint4*)(dst + (size_t)(n0 + n) * dst_ld + k0 + kq);
    d[0] = make_uint4(pk[0], pk[1], pk[2], pk[3]);
    d[1] = make_uint4(pk[4], pk[5], pk[6], pk[7]);
  }
  __syncthreads();
}

DI void mod_unit(const Params& p, int unit, unsigned char* smem) {
  const int l = unit / 96, n0 = (unit % 96) * 32;
  float* sil = (float*)smem;
  float* red = sil + 5 * 1024;
  const int tid = threadIdx.x;
  for (int e = tid; e < 5 * 1024; e += 256) {
    int r = e >> 10, k = e & 1023;
    float cv = r == 0 ? p.in[I_CCTX][k] : p.in[I_C][(r - 1) * 1024 + k];
    sil[e] = cv / (1.f + expf(-cv));
  }
  __syncthreads();
  const int kg = tid >> 5, cn = tid & 31;
  const float* w = p.in[I_WADA] + (size_t)l * 1024 * 3072 + n0 + cn;
  float a0 = 0, a1 = 0, a2 = 0, a3 = 0, a4 = 0;
#pragma unroll 8
  for (int kk = 0; kk < 128; ++kk) {
    int k = kg * 128 + kk;
    float wv = w[(size_t)k * 3072];
    a0 += sil[k] * wv; a1 += sil[1024 + k] * wv; a2 += sil[2048 + k] * wv; a3 += sil[3072 + k] * wv; a4 += sil[4096 + k] * wv;
  }
  red[(kg * 5 + 0) * 32 + cn] = a0; red[(kg * 5 + 1) * 32 + cn] = a1; red[(kg * 5 + 2) * 32 + cn] = a2;
  red[(kg * 5 + 3) * 32 + cn] = a3; red[(kg * 5 + 4) * 32 + cn] = a4;
  __syncthreads();
  if (tid < 160) {
    int r = tid >> 5;
    float s = p.in[I_BADA][l * 3072 + n0 + cn];
#pragma unroll
    for (int g = 0; g < 8; ++g) s += red[(g * 5 + r) * 32 + cn];
    ((float*)(p.ws + OFF_MOD))[(l * 5 + r) * 3072 + n0 + cn] = s;
  }
  __syncthreads();
}

DI void phase0(const Params& p, unsigned char* smem) {
  constexpr int U_MOD = 384;
  constexpr int U_GIN = 2 * 16 * 48;
  constexpr int U_GA1 = 2 * 2 * 16;
  constexpr int U_GZ = 2;
  constexpr int U_GOUT = 2 * 16 * 16;
  constexpr int U_AIN = 2 * 16 * 40;
  constexpr int U_AOUT = 2 * 16 * 16;
  constexpr int U_ROPE = 1;
  constexpr int U_CK = 64;
  constexpr int U_CV = 4 * 2 * 16;
  constexpr int U_TOTAL = U_MOD + U_GIN + U_GA1 + U_GZ + U_GOUT + U_AIN + U_AOUT + U_ROPE + U_CK + U_CV;
  bfr* wt_gin = (bfr*)(p.ws + OFF_WT_GLA_IN);
  bfr* wt_gout = (bfr*)(p.ws + OFF_WT_GLA_OUT);
  bfr* wt_ain = (bfr*)(p.ws + OFF_WT_ATT_IN);
  bfr* wt_aout = (bfr*)(p.ws + OFF_WT_ATT_OUT);
  const int tid = threadIdx.x;
  for (int unit = blockIdx.x; unit < U_TOTAL; unit += gridDim.x) {
    int u = unit;
    if (u < U_MOD) { mod_unit(p, u, smem); continue; }
    u -= U_MOD;
    if (u < U_GIN) {
      int i = u / 768, r = u % 768, kt = r / 48, nt = r % 48;
      transpose_tile(p.in[I_GWIN] + (size_t)i * 1024 * 3072, 3072, kt * 64, nt * 64, 64,
                     wt_gin + (size_t)i * GLA_NPAD * 1024, 1024, smem);
      continue;
    }
    u -= U_GIN;
    if (u < U_GA1) {
      int id = u / 16, kt = u % 16;
      int i = id >> 1, d = id & 1;
      transpose_tile(p.in[I_GWA1] + (size_t)id * 1024 * 16, 16, kt * 64, 0, 16,
                     wt_gin + ((size_t)i * GLA_NPAD + 3072 + d * 16) * 1024, 1024, smem);
      continue;
    }
    u -= U_GA1;
    if (u < U_GZ) {
      uint4* z = (uint4*)(wt_gin + ((size_t)u * GLA_NPAD + 3104) * 1024);
      for (int e = tid; e < 96 * 1024 / 8; e += 256) z[e] = make_uint4(0, 0, 0, 0);
      continue;
    }
    u -= U_GZ;
    if (u < U_GOUT) {
      int i = u / 256, r = u % 256, kt = r / 16, nt = r % 16;
      transpose_tile(p.in[I_GWOUT] + (size_t)i * 1024 * 1024, 1024, kt * 64, nt * 64, 64,
                     wt_gout + (size_t)i * 1024 * 1024, 1024, smem);
      continue;
    }
    u -= U_GOUT;
    if (u < U_AIN) {
      int i = u / 640, r = u % 640, kt = r / 40, nt = r % 40;
      transpose_tile(p.in[I_AWIN] + (size_t)i * 1024 * ATT_N, ATT_N, kt * 64, nt * 64, 64,
                     wt_ain + (size_t)i * ATT_N * 1024, 1024, smem);
      continue;
    }
    u -= U_AIN;
    if (u < U_AOUT) {
      int i = u / 256, r = u % 256, kt = r / 16, nt = r % 16;
      transpose_tile(p.in[I_AWOUT] + (size_t)i * 1024 * 1024, 1024, kt * 64, nt * 64, 64,
                     wt_aout + (size_t)i * 1024 * 1024, 1024, smem);
      continue;
    }
    u -= U_AOUT;
    if (u < U_ROPE) {
      float* rc = (float*)(p.ws + OFF_ROPE);
      float* rs = rc + 64 * 32;
      for (int e = tid; e < 2048; e += 256) {
        int pos = e >> 5, f = e & 31;
        float fr = powf(10000.0f, -(float)f / 32.0f);
        float ang = (float)pos * fr;
        rc[e] = cosf(ang);
        rs[e] = sinf(ang);
      }
      continue;
    }
    u -= U_ROPE;
    if (u < U_CK) {
      bfr* ks = (bfr*)(p.ws + OFF_KS);
      for (int e = tid; e < 2048; e += 256) {
        size_t idx = (size_t)u * 8192 + (size_t)e * 4;
        int c = idx & 255, t = (idx >> 8) & 255, i = (idx >> 16) & 1, b = (int)(idx >> 17);
        float4 v = *(const float4*)(p.in[I_CK] + idx);
        uint2 o = make_uint2(pack2(v.x, v.y), pack2(v.z, v.w));
        *(uint2*)(ks + ((size_t)(i * 4 + b) * 1280 + 1024 + t) * 256 + c) = o;
      }
      continue;
    }
    u -= U_CK;
    {
      int bi = u / 16, r = u % 16, kt = r / 4, nt = r % 4;
      int b = bi >> 1, i = bi & 1;
      transpose_tile(p.in[I_CV] + (size_t)bi * 256 * 256, 256, kt * 64, nt * 64, 64,
                     (bfr*)(p.ws + OFF_VST) + (size_t)(i * 4 + b) * 256 * 1280 + 1024, 1280, smem);
    }
  }
}

DI void phase_norm(const Params& p, int l) {
  const int lane = threadIdx.x & 63;
  const int gw = blockIdx.x * 4 + (threadIdx.x >> 6), nw = gridDim.x * 4;
  const float* g = p.in[I_NORMG] + l * DM;
  const float* mod = (const float*)(p.ws + OFF_MOD) + (size_t)l * 5 * 3072;
  bfr* h = (bfr*)(p.ws + OFF_H);
  for (int row = gw; row < NTOK; row += nw) {
    const float* x = xrow_ptr(p, l, row);
    float4 v[4];
    float ss = 0.f;
#pragma unroll
    for (int j = 0; j < 4; ++j) {
      v[j] = *(const float4*)(x + lane * 4 + 256 * j);
      ss += v[j].x * v[j].x + v[j].y * v[j].y + v[j].z * v[j].z + v[j].w * v[j].w;
    }
    ss = wave_sum(ss);
    const float rstd = rsqrtf(ss * (1.f / 1024.f) + EPSN);
    const float* mr = mod + modrow(row) * 3072;
#pragma unroll
    for (int j = 0; j < 4; ++j) {
      int c = lane * 4 + 256 * j;
      float4 gg = *(const float4*)(g + c);
      float4 sh = *(const float4*)(mr + c);
      float4 sc = *(const float4*)(mr + 1024 + c);
      float o0 = v[j].x * rstd * gg.x * (1.f + sc.x) + sh.x;
      float o1 = v[j].y * rstd * gg.y * (1.f + sc.y) + sh.y;
      float o2 = v[j].z * rstd * gg.z * (1.f + sc.z) + sh.z;
      float o3 = v[j].w * rstd * gg.w * (1.f + sc.w) + sh.w;
      *(uint2*)(h + (size_t)row * DM + c) = make_uint2(pack2(o0, o1), pack2(o2, o3));
    }
  }
}

DI void gemm_core(const bfr* __restrict__ A, const bfr* __restrict__ Bt, int K, int m0, int n0, unsigned char* smem,
                  f32x16 (&acc)[2][2]) {
  bfr* sA = (bfr*)smem;
  bfr* sB = sA + 2 * 128 * 72;
  const int tid = threadIdx.x, lane = tid & 63, w = tid >> 6, wm = w >> 1, wn = w & 1, r = lane & 31, hh = lane >> 5;
  const int lrow = tid >> 3, lch = (tid & 7) * 8;
  const bfr* gA = A + (size_t)(m0 + lrow) * K + lch;
  const bfr* gB = Bt + (size_t)(n0 + lrow) * K + lch;
#pragma unroll
  for (int a = 0; a < 2; ++a)
#pragma unroll
    for (int b = 0; b < 2; ++b)
#pragma unroll
      for (int i = 0; i < 16; ++i) acc[a][b][i] = 0.f;
  uint4 ra[4], rb[4];
#pragma unroll
  for (int j = 0; j < 4; ++j) {
    ra[j] = *(const uint4*)(gA + (size_t)(32 * j) * K);
    rb[j] = *(const uint4*)(gB + (size_t)(32 * j) * K);
  }
#pragma unroll
  for (int j = 0; j < 4; ++j) {
    *(uint4*)(sA + (lrow + 32 * j) * 72 + lch) = ra[j];
    *(uint4*)(sB + (lrow + 32 * j) * 72 + lch) = rb[j];
  }
  __syncthreads();
  const int KT = K >> 6;
  for (int kt = 0; kt < KT; ++kt) {
    const int cur = kt & 1;
    if (kt + 1 < KT) {
#pragma unroll
      for (int j = 0; j < 4; ++j) {
        ra[j] = *(const uint4*)(gA + (size_t)(32 * j) * K + (kt + 1) * 64);
        rb[j] = *(const uint4*)(gB + (size_t)(32 * j) * K + (kt + 1) * 64);
      }
    }
    const bfr* cA = sA + cur * 128 * 72;
    const bfr* cB = sB + cur * 128 * 72;
#pragma unroll
    for (int kk = 0; kk < 4; ++kk) {
      bf16x8 a[2], b[2];
#pragma unroll
      for (int mb = 0; mb < 2; ++mb) a[mb] = *(const bf16x8*)(cA + (64 * wm + 32 * mb + r) * 72 + 16 * kk + 8 * hh);
#pragma unroll
      for (int nb = 0; nb < 2; ++nb) b[nb] = *(const bf16x8*)(cB + (64 * wn + 32 * nb + r) * 72 + 16 * kk + 8 * hh);
#pragma unroll
      for (int mb = 0; mb < 2; ++mb)
#pragma unroll
        for (int nb = 0; nb < 2; ++nb) acc[mb][nb] = MFMA32(a[mb], b[nb], acc[mb][nb]);
    }
    if (kt + 1 < KT) {
      bfr* nA = sA + (cur ^ 1) * 128 * 72;
      bfr* nB = sB + (cur ^ 1) * 128 * 72;
#pragma unroll
      for (int j = 0; j < 4; ++j) {
        *(uint4*)(nA + (lrow + 32 * j) * 72 + lch) = ra[j];
        *(uint4*)(nB + (lrow + 32 * j) * 72 + lch) = rb[j];
      }
    }
    __syncthreads();
  }
}
DI void stage_acc(const f32x16 (&acc)[2][2], float* sC) {
  const int lane = threadIdx.x & 63, w = threadIdx.x >> 6, wm = w >> 1, wn = w & 1, r = lane & 31, hh = lane >> 5;
#pragma unroll
  for (int mb = 0; mb < 2; ++mb)
#pragma unroll
    for (int nb = 0; nb < 2; ++nb)
#pragma unroll
      for (int i = 0; i < 16; ++i) sC[(64 * wm + 32 * mb + crow(i, hh)) * 132 + 64 * wn + 32 * nb + r] = acc[mb][nb][i];
}
DI void stage_acc_t(const f32x16 (&acc)[2][2], float* sC) {
  const int lane = threadIdx.x & 63, w = threadIdx.x >> 6, wm = w >> 1, wn = w & 1, r = lane & 31, hh = lane >> 5;
#pragma unroll
  for (int mb = 0; mb < 2; ++mb)
#pragma unroll
    for (int nb = 0; nb < 2; ++nb)
#pragma unroll
      for (int g = 0; g < 4; ++g) {
        float4 v = make_float4(acc[mb][nb][4 * g], acc[mb][nb][4 * g + 1], acc[mb][nb][4 * g + 2], acc[mb][nb][4 * g + 3]);
        *(float4*)(sC + (64 * wn + 32 * nb + r) * 132 + 64 * wm + 32 * mb + 8 * g + 4 * hh) = v;
      }
}

DI void phase_gla_in(const Params& p, int gi, unsigned char* smem) {
  const bfr* A = (const bfr*)(p.ws + OFF_H);
  const bfr* Bt = (const bfr*)(p.ws + OFF_WT_GLA_IN) + (size_t)gi * GLA_NPAD * 1024;
  bfr* gq = (bfr*)(p.ws + OFF_PROJ + PJ_GQ);
  bfr* gk = (bfr*)(p.ws + OFF_PROJ + PJ_GK);
  bfr* gg = (bfr*)(p.ws + OFF_PROJ + PJ_GG);
  bfr* gvt = (bfr*)(p.ws + OFF_PROJ + PJ_GVT);
  float* tb = (float*)(p.ws + OFF_TBUF);
  float* sC = (float*)smem;
  const int tid = threadIdx.x;
  constexpr int NT = 25, MT = 64;
  for (int tile = blockIdx.x; tile < NT * MT; tile += gridDim.x) {
    const int mt = tile / NT, nt = tile % NT, m0 = mt * 128, n0 = nt * 128;
    f32x16 acc[2][2];
    gemm_core(A, Bt, 1024, m0, n0, smem, acc);
    if (nt >= 8 && nt < 16) {
      stage_acc_t(acc, sC);
      __syncthreads();
#pragma unroll 4
      for (int it = 0; it < 16; ++it) {
        int idx = it * 256 + tid, col = idx >> 5, r4 = (idx & 31) * 4;
        float4 v = *(const float4*)(sC + col * 132 + r4);
        *(uint2*)(gvt + (size_t)((nt - 8) * 128 + col) * NTOK + m0 + r4) = make_uint2(pack2(v.x, v.y), pack2(v.z, v.w));
      }
    } else {
      stage_acc(acc, sC);
      __syncthreads();
#pragma unroll 4
      for (int it = 0; it < 16; ++it) {
        int idx = it * 256 + tid, row = idx >> 5, c4 = (idx & 31) * 4;
        float4 v = *(const float4*)(sC + row * 132 + c4);
        size_t grow = m0 + row;
        if (nt < 4) {
          const float s = 0.08838834764831845f;
          *(uint2*)(gq + grow * 512 + n0 + c4) = make_uint2(pack2(v.x * s, v.y * s), pack2(v.z * s, v.w * s));
        } else if (nt < 8) {
          *(uint2*)(gk + grow * 512 + (n0 - 512) + c4) = make_uint2(pack2(v.x, v.y), pack2(v.z, v.w));
        } else if (nt < 24) {
          *(uint2*)(gg + grow * 1024 + (n0 - 2048) + c4) =
              make_uint2(pack2(siluf(v.x), siluf(v.y)), pack2(siluf(v.z), siluf(v.w)));
        } else {
          if (c4 < 32) *(float4*)(tb + grow * 32 + c4) = v;
        }
      }
    }
    __syncthreads();
  }
}

DI void phase_gla_prep(const Params& p, int gi, unsigned char* smem) {
  const bfr* gq = (const bfr*)(p.ws + OFF_PROJ + PJ_GQ);
  const bfr* gk = (const bfr*)(p.ws + OFF_PROJ + PJ_GK);
  const float* tb = (const float*)(p.ws + OFF_TBUF);
  bfr* qe_o = (bfr*)(p.ws + OFF_QE);
  bfr* kdt_o = (bfr*)(p.ws + OFF_KDT);
  bfr* a_o = (bfr*)(p.ws + OFF_ABUF);
  float* el_o = (float*)(p.ws + OFF_ELAST);
  bfr* sQ = (bfr*)smem;
  bfr* sK = sQ + 64 * 136;
  float* tl = (float*)(sK + 64 * 136);
  float* tot = tl + 64 * 16;
  const int tid = threadIdx.x, lane = tid & 63, w = tid >> 6, r = lane & 31, hh = lane >> 5;
  const int dk = tid & 127, half = tid >> 7;
  for (int u = blockIdx.x; u < 1024; u += gridDim.x) {
    const int d = u >> 9, cgi = (u >> 2) & 127, hd = u & 3;
    const int token0 = cgi * 64;
    {
      int s = tid >> 2, j4 = (tid & 3) * 4;
      *(float4*)(tl + s * 16 + j4) = *(const float4*)(tb + (size_t)(token0 + s) * 32 + d * 16 + j4);
    }
#pragma unroll
    for (int j = 0; j < 4; ++j) {
      int id = j * 256 + tid, row = id >> 4, ch = (id & 15) * 8;
      *(uint4*)(sQ + row * 136 + ch) = *(const uint4*)(gq + (size_t)(token0 + row) * 512 + hd * 128 + ch);
      *(uint4*)(sK + row * 136 + ch) = *(const uint4*)(gk + (size_t)(token0 + row) * 512 + hd * 128 + ch);
    }
    float w2[16];
    const float* wa2 = p.in[I_GWA2] + (size_t)(gi * 2 + d) * 16 * 512 + hd * 128 + dk;
#pragma unroll
    for (int j = 0; j < 16; ++j) w2[j] = wa2[j * 512];
    const float bias = p.in[I_GBA][(gi * 2 + d) * 512 + hd * 128 + dk];
    __syncthreads();
    float pc[32];
    float cum = 0.f;
#pragma unroll
    for (int sl = 0; sl < 32; ++sl) {
      const float* tr = tl + (half * 32 + sl) * 16;
      float z = bias;
#pragma unroll
      for (int j4 = 0; j4 < 4; ++j4) {
        float4 tv = *(const float4*)(tr + j4 * 4);
        z += tv.x * w2[j4 * 4] + tv.y * w2[j4 * 4 + 1] + tv.z * w2[j4 * 4 + 2] + tv.w * w2[j4 * 4 + 3];
      }
      float lg = (fminf(z, 0.f) - log1pf(expf(-fabsf(z)))) * (1.f / 16.f);
      cum += lg;
      pc[sl] = cum;
    }
    tot[half * 128 + dk] = cum;
    __syncthreads();
    const float t0 = tot[dk], t1 = tot[128 + dk];
    const float total = t0 + t1;
    const float base = half ? t0 : 0.f;
    const float etot = expf(total);
    if (half == 0) el_o[(size_t)u * 128 + dk] = etot;
    unsigned kdp[16];
    float kd_prev = 0.f;
#pragma unroll
    for (int sl = 0; sl < 32; ++sl) {
      const int s = half * 32 + sl;
      const float pin = base + pc[sl];
      const float pex = base + (sl == 0 ? 0.f : pc[sl == 0 ? 0 : sl - 1]);
      const float b = d ? (total - pex) : pin;
      const float qv = bf2f(sQ[s * 136 + dk]), kv = bf2f(sK[s * 136 + dk]);
      const float eb = expf(b), enb = 1.f / eb;
      const float qe = qv * eb, ke = kv * enb, kd = kv * (etot * enb);
      sQ[s * 136 + dk] = f2bf(qe);
      sK[s * 136 + dk] = f2bf(ke);
      if (sl & 1) kdp[sl >> 1] = pack2(kd_prev, kd); else kd_prev = kd;
    }
    {
      uint4* dst = (uint4*)(kdt_o + ((size_t)u * 128 + dk) * 64 + half * 32);
      dst[0] = make_uint4(kdp[0], kdp[1], kdp[2], kdp[3]);
      dst[1] = make_uint4(kdp[4], kdp[5], kdp[6], kdp[7]);
      dst[2] = make_uint4(kdp[8], kdp[9], kdp[10], kdp[11]);
      dst[3] = make_uint4(kdp[12], kdp[13], kdp[14], kdp[15]);
    }
    __syncthreads();
#pragma unroll
    for (int j = 0; j < 4; ++j) {
      int id = j * 256 + tid, row = id >> 4, ch = (id & 15) * 8;
      *(uint4*)(qe_o + ((size_t)u * 64 + row) * 128 + ch) = *(const uint4*)(sQ + row * 136 + ch);
    }
    const int sb = w >> 1, tbk = w & 1;
    f32x16 acc;
#pragma unroll
    for (int i = 0; i < 16; ++i) acc[i] = 0.f;
#pragma unroll
    for (int kk = 0; kk < 8; ++kk) {
      bf16x8 a = *(const bf16x8*)(sK + (32 * sb + r) * 136 + 16 * kk + 8 * hh);
      bf16x8 b = *(const bf16x8*)(sQ + (32 * tbk + r) * 136 + 16 * kk + 8 * hh);
      acc = MFMA32(a, b, acc);
    }
    const int t = 32 * tbk + r;
#pragma unroll
    for (int g = 0; g < 4; ++g) {
      const int s4 = 32 * sb + 8 * g + 4 * hh;
      float v[4];
#pragma unroll
      for (int j = 0; j < 4; ++j) {
        const int s = s4 + j;
        const bool keep = d ? (s >= t) : (s <= t);
        v[j] = keep ? acc[4 * g + j] : 0.f;
      }
      *(uint2*)(a_o + ((size_t)u * 64 + t) * 64 + s4) = make_uint2(pack2(v[0], v[1]), pack2(v[2], v[3]));
    }
    __syncthreads();
  }
}

DI void gla_scan_unit(const Params& p, int gi, bool sample, int b, int rem, unsigned char* smem) {
  const int hd = rem >> 3, d = (rem >> 2) & 1, sp = rem & 3;
  const int nch = sample ? 16 : 4;
  const int cg0 = sample ? 64 + b * 16 : b * 4;
  const bfr* qe_i = (const bfr*)(p.ws + OFF_QE);
  const bfr* kdt_i = (const bfr*)(p.ws + OFF_KDT);
  const bfr* a_i = (const bfr*)(p.ws + OFF_ABUF);
  const float* el_i = (const float*)(p.ws + OFF_ELAST);
  const bfr* gvt = (const bfr*)(p.ws + OFF_PROJ + PJ_GVT);
  bfr* o_o = (bfr*)(p.ws + OFF_O) + (size_t)d * NTOK * 1024;
  bfr* sSt = (bfr*)smem;
  bfr* sQ = sSt + 64 * 136;
  bfr* sA = sQ + 64 * 136;
  bfr* sV = sA + 64 * 72;
  bfr* sKd = sV + 64 * 72;
  const int tid = threadIdx.x, lane = tid & 63, w = tid >> 6, r = lane & 31, hh = lane >> 5;
  f32x16 S[2];
  if (sample) {
    const float* st = p.in[I_STATE] + ((((size_t)(b * 2 + gi) * 2 + d) * 4 + hd) * 128) * 256 + sp * 64;
#pragma unroll
    for (int nb = 0; nb < 2; ++nb)
#pragma unroll
      for (int i = 0; i < 16; ++i) S[nb][i] = st[(size_t)(32 * w + crow(i, hh)) * 256 + 32 * nb + r];
  } else {
#pragma unroll
    for (int nb = 0; nb < 2; ++nb)
#pragma unroll
      for (int i = 0; i < 16; ++i) S[nb][i] = 0.f;
  }
  for (int c = 0; c < nch; ++c) {
    const int cl = d ? nch - 1 - c : c;
    const int cgi = cg0 + cl;
    const int u = (d * 128 + cgi) * 4 + hd;
    const int token0 = cgi * 64;
#pragma unroll
    for (int j = 0; j < 4; ++j) {
      int id = j * 256 + tid, row = id >> 4, ch = (id & 15) * 8;
      *(uint4*)(sQ + row * 136 + ch) = *(const uint4*)(qe_i + ((size_t)u * 64 + row) * 128 + ch);
    }
#pragma unroll
    for (int j = 0; j < 2; ++j) {
      int id = j * 256 + tid, row = id >> 3, ch = (id & 7) * 8;
      *(uint4*)(sA + row * 72 + ch) = *(const uint4*)(a_i + ((size_t)u * 64 + row) * 64 + ch);
      *(uint4*)(sV + row * 72 + ch) = *(const uint4*)(gvt + (size_t)(hd * 256 + sp * 64 + row) * NTOK + token0 + ch);
    }
#pragma unroll
    for (int j = 0; j < 4; ++j) {
      int id = j * 256 + tid, row = id >> 3, ch = (id & 7) * 8;
      *(uint4*)(sKd + row * 72 + ch) = *(const uint4*)(kdt_i + ((size_t)u * 128 + row) * 64 + ch);
    }
    float4 el[4];
#pragma unroll
    for (int g = 0; g < 4; ++g) el[g] = *(const float4*)(el_i + (size_t)u * 128 + 32 * w + 8 * g + 4 * hh);
#pragma unroll
    for (int nb = 0; nb < 2; ++nb)
#pragma unroll
      for (int g = 0; g < 4; ++g)
        *(uint2*)(sSt + (32 * nb + r) * 136 + 32 * w + 8 * g + 4 * hh) =
            make_uint2(pack2(S[nb][4 * g], S[nb][4 * g + 1]), pack2(S[nb][4 * g + 2], S[nb][4 * g + 3]));
    __syncthreads();
    {
      const int tbk = w >> 1, nbo = w & 1;
      f32x16 oa;
#pragma unroll
      for (int i = 0; i < 16; ++i) oa[i] = 0.f;
#pragma unroll
      for (int kk = 0; kk < 8; ++kk) {
        bf16x8 a = *(const bf16x8*)(sQ + (32 * tbk + r) * 136 + 16 * kk + 8 * hh);
        bf16x8 bb = *(const bf16x8*)(sSt + (32 * nbo + r) * 136 + 16 * kk + 8 * hh);
        oa = MFMA32(a, bb, oa);
      }
#pragma unroll
      for (int kk = 0; kk < 4; ++kk) {
        bf16x8 a = *(const bf16x8*)(sA + (32 * tbk + r) * 72 + 16 * kk + 8 * hh);
        bf16x8 bb = *(const bf16x8*)(sV + (32 * nbo + r) * 72 + 16 * kk + 8 * hh);
        oa = MFMA32(a, bb, oa);
      }
#pragma unroll
      for (int i = 0; i < 16; ++i)
        o_o[(size_t)(token0 + 32 * tbk + crow(i, hh)) * 1024 + hd * 256 + sp * 64 + 32 * nbo + r] = f2bf(oa[i]);
    }
#pragma unroll
    for (int nb = 0; nb < 2; ++nb)
#pragma unroll
      for (int g = 0; g < 4; ++g) {
        S[nb][4 * g] *= el[g].x; S[nb][4 * g + 1] *= el[g].y; S[nb][4 * g + 2] *= el[g].z; S[nb][4 * g + 3] *= el[g].w;
      }
#pragma unroll
    for (int kk = 0; kk < 4; ++kk) {
      bf16x8 a = *(const bf16x8*)(sKd + (32 * w + r) * 72 + 16 * kk + 8 * hh);
#pragma unroll
      for (int nb = 0; nb < 2; ++nb) {
        bf16x8 bb = *(const bf16x8*)(sV + (32 * nb + r) * 72 + 16 * kk + 8 * hh);
        S[nb] = MFMA32(a, bb, S[nb]);
      }
    }
    __syncthreads();
  }
  if (!sample) {
    float* so = p.out + OUT_STATE + ((((size_t)(b * 2 + gi) * 2 + d) * 4 + hd) * 128) * 256 + sp * 64;
#pragma unroll
    for (int nb = 0; nb < 2; ++nb)
#pragma unroll
      for (int i = 0; i < 16; ++i) so[(size_t)(32 * w + crow(i, hh)) * 256 + 32 * nb + r] = S[nb][i];
  }
}
DI void phase_gla_scan(const Params& p, int gi, unsigned char* smem) {
  const int nb = gridDim.x, bid = blockIdx.x;
  int idx, step;
  if (nb >= 256) { idx = bid; step = bid < 128 ? 640 : nb - 128; }
  else { idx = bid; step = nb; }
  for (; idx < 640; idx += step) {
    const bool sample = idx < 128;
    const int q = sample ? idx : idx - 128;
    gla_scan_unit(p, gi, sample, q >> 5, q & 31, smem);
  }
}

DI void phase_gla_post(const Params& p, int gi) {
  const int lane = threadIdx.x & 63;
  const int gw = blockIdx.x * 4 + (threadIdx.x >> 6), nw = gridDim.x * 4;
  const bfr* o0 = (const bfr*)(p.ws + OFF_O);
  const bfr* o1 = o0 + (size_t)NTOK * 1024;
  const bfr* gg = (const bfr*)(p.ws + OFF_PROJ + PJ_GG);
  bfr* uo = (bfr*)(p.ws + OFF_U);
  const float4 on = *(const float4*)(p.in[I_GONORM] + gi * 256 + lane * 4);
  for (int row = gw; row < NTOK; row += nw) {
#pragma unroll
    for (int hd = 0; hd < 4; ++hd) {
      size_t idx = (size_t)row * 1024 + hd * 256 + lane * 4;
      uint2 a = *(const uint2*)(o0 + idx), b = *(const uint2*)(o1 + idx), g = *(const uint2*)(gg + idx);
      float v0 = bf2f(a.x & 0xffff) + bf2f(b.x & 0xffff), v1 = bf2f(a.x >> 16) + bf2f(b.x >> 16);
      float v2 = bf2f(a.y & 0xffff) + bf2f(b.y & 0xffff), v3 = bf2f(a.y >> 16) + bf2f(b.y >> 16);
      float ss = wave_sum(v0 * v0 + v1 * v1 + v2 * v2 + v3 * v3);
      float rstd = rsqrtf(ss * (1.f / 256.f) + EPSN);
      float r0 = v0 * rstd * on.x * bf2f(g.x & 0xffff), r1 = v1 * rstd * on.y * bf2f(g.x >> 16);
      float r2 = v2 * rstd * on.z * bf2f(g.y & 0xffff), r3 = v3 * rstd * on.w * bf2f(g.y >> 16);
      *(uint2*)(uo + idx) = make_uint2(pack2(r0, r1), pack2(r2, r3));
    }
  }
}

DI void phase_out_proj(const Params& p, int l, const bfr* Bt, unsigned char* smem) {
  const bfr* A = (const bfr*)(p.ws + OFF_U);
  const float* mod = (const float*)(p.ws + OFF_MOD) + (size_t)l * 5 * 3072;
  float* sC = (float*)smem;
  const int tid = threadIdx.x;
  for (int tile = blockIdx.x; tile < 8 * 64; tile += gridDim.x) {
    const int mt = tile >> 3, nt = tile & 7, m0 = mt * 128, n0 = nt * 128;
    f32x16 acc[2][2];
    gemm_core(A, Bt, 1024, m0, n0, smem, acc);
    stage_acc(acc, sC);
    __syncthreads();
#pragma unroll 4
    for (int it = 0; it < 16; ++it) {
      int idx = it * 256 + tid, row = idx >> 5, c4 = (idx & 31) * 4;
      float4 v = *(const float4*)(sC + row * 132 + c4);
      int grow = m0 + row, col = n0 + c4;
      float4 xo = *(const float4*)(xrow_ptr(p, l, grow) + col);
      float4 gt = *(const float4*)(mod + modrow(grow) * 3072 + 2048 + col);
      float4 o = make_float4(xo.x + gt.x * v.x, xo.y + gt.y * v.y, xo.z + gt.z * v.z, xo.w + gt.w * v.w);
      *(float4*)(p.out + (size_t)grow * DM + col) = o;
    }
    __syncthreads();
  }
}

DI void phase_att_in(const Params& p, int ai, unsigned char* smem) {
  const bfr* A = (const bfr*)(p.ws + OFF_H);
  const bfr* Bt = (const bfr*)(p.ws + OFF_WT_ATT_IN) + (size_t)ai * ATT_N * 1024;
  bfr* aq = (bfr*)(p.ws + OFF_PROJ + PJ_AQ);
  bfr* ag = (bfr*)(p.ws + OFF_PROJ + PJ_AG);
  bfr* akp = (bfr*)(p.ws + OFF_PROJ + PJ_AKP);
  bfr* avpt = (bfr*)(p.ws + OFF_PROJ + PJ_AVPT);
  bfr* ks = (bfr*)(p.ws + OFF_KS);
  bfr* vst = (bfr*)(p.ws + OFF_VST);
  const float* rc = (const float*)(p.ws + OFF_ROPE);
  const float* rs = rc + 64 * 32;
  const float* qn = p.in[I_AQN] + ai * 128;
  const float* kn = p.in[I_AKN] + ai * 128;
  float* sC = (float*)smem;
  const int tid = threadIdx.x;
  constexpr int NT = 20, MT = 64;
  for (int tile = blockIdx.x; tile < NT * MT; tile += gridDim.x) {
    const int mt = tile / NT, nt = tile % NT, m0 = mt * 128, n0 = nt * 128;
    const bool samp = m0 >= NPT;
    f32x16 acc[2][2];
    gemm_core(A, Bt, 1024, m0, n0, smem, acc);
    if (nt == 10 || nt == 11) {
      const int hk = nt - 10;
      stage_acc_t(acc, sC);
      __syncthreads();
      bfr* dst; size_t ldt;
      if (!samp) { int b = m0 >> 8, t0 = m0 & 255; dst = avpt + (size_t)((b * 2 + hk) * 128) * 256 + t0; ldt = 256; }
      else { int b = (m0 - NPT) >> 10, t0 = (m0 - NPT) & 1023; dst = vst + (size_t)(((ai * 4 + b) * 2 + hk) * 128) * 1280 + t0; ldt = 1280; }
#pragma unroll 4
      for (int it = 0; it < 16; ++it) {
        int idx = it * 256 + tid, col = idx >> 5, r4 = (idx & 31) * 4;
        float4 v = *(const float4*)(sC + col * 132 + r4);
        *(uint2*)(dst + (size_t)col * ldt + r4) = make_uint2(pack2(v.x, v.y), pack2(v.z, v.w));
      }
      if (!samp) {
        __syncthreads();
        stage_acc(acc, sC);
        __syncthreads();
        const int b = m0 >> 8, t0 = m0 & 255;
#pragma unroll 4
        for (int it = 0; it < 16; ++it) {
          int idx = it * 256 + tid, row = idx >> 5, c4 = (idx & 31) * 4;
          float4 v = *(const float4*)(sC + row * 132 + c4);
          *(float4*)(p.out + OUT_CV + ((((size_t)b * 2 + ai) * 256 + t0 + row) * 2 + hk) * 128 + c4) = v;
        }
      }
    } else {
      stage_acc(acc, sC);
      __syncthreads();
#pragma unroll 2
      for (int it = 0; it < 16; ++it) {
        int idx = it * 256 + tid, row = idx >> 5, c4 = (idx & 31) * 4;
        float4 v = *(const float4*)(sC + row * 132 + c4);
        const int grow = m0 + row;
        if (nt >= 12) {
          *(uint2*)(ag + (size_t)grow * 1024 + (n0 - 1536) + c4) =
              make_uint2(pack2(siluf(v.x), siluf(v.y)), pack2(siluf(v.z), siluf(v.w)));
        } else {
          float ss = half_sum(v.x * v.x + v.y * v.y + v.z * v.z + v.w * v.w);
          const float rstd = rsqrtf(ss * (1.f / 128.f) + EPSN);
          const float* wn = nt < 8 ? qn : kn;
          float4 wv = *(const float4*)(wn + c4);
          float4 xn = make_float4(v.x * rstd * wv.x, v.y * rstd * wv.y, v.z * rstd * wv.z, v.w * rstd * wv.w);
          float4 o = xn;
          if (samp) {
            const int cp = c4 ^ 32;
            float4 pv = *(const float4*)(sC + row * 132 + cp);
            float4 pw = *(const float4*)(wn + cp);
            float4 pn = make_float4(pv.x * rstd * pw.x, pv.y * rstd * pw.y, pv.z * rstd * pw.z, pv.w * rstd * pw.w);
            const int t = (grow - NPT) & 1023;
            const int pos = (c4 < 64) ? (t >> 6) : (t & 63);
            float4 cs = *(const float4*)(rc + pos * 32 + (c4 & 31));
            float4 sn = *(const float4*)(rs + pos * 32 + (c4 & 31));
            const float sg = (c4 & 32) ? 1.f : -1.f;
            o = make_float4(xn.x * cs.x + sg * pn.x * sn.x, xn.y * cs.y + sg * pn.y * sn.y,
                            xn.z * cs.z + sg * pn.z * sn.z, xn.w * cs.w + sg * pn.w * sn.w);
          }
          if (nt < 8) {
            const float s = 0.08838834764831845f * 1.4426950408889634f;
            *(uint2*)(aq + (size_t)grow * 1024 + n0 + c4) = make_uint2(pack2(o.x * s, o.y * s), pack2(o.z * s, o.w * s));
          } else {
            const int hk = nt - 8;
            uint2 ob = make_uint2(pack2(o.x, o.y), pack2(o.z, o.w));
            if (!samp) {
              const int b = grow >> 8, t = grow & 255;
              *(float4*)(p.out + OUT_CK + ((((size_t)b * 2 + ai) * 256 + t) * 2 + hk) * 128 + c4) = o;
              *(uint2*)(akp + (size_t)grow * 256 + hk * 128 + c4) = ob;
            } else {
              const int b = (grow - NPT) >> 10, t = (grow - NPT) & 1023;
              *(uint2*)(ks + ((size_t)(ai * 4 + b) * 1280 + t) * 256 + hk * 128 + c4) = ob;
            }
          }
        }
      }
    }
    __syncthreads();
  }
}

DI void attn_unit(const Params& p, int ai, bool sample, int unit, unsigned char* smem) {
  int b, hkv, qb, ntile, tokq0;
  const bfr* Kb; const bfr* Vb; size_t ldt;
  if (sample) {
    b = unit >> 6; hkv = (unit >> 5) & 1; qb = unit & 31; ntile = 20;
    tokq0 = NPT + b * 1024 + qb * 32;
    Kb = (const bfr*)(p.ws + OFF_KS) + (size_t)(ai * 4 + b) * 1280 * 256 + hkv * 128;
    Vb = (const bfr*)(p.ws + OFF_VST) + (size_t)(((ai * 4 + b) * 2 + hkv) * 128) * 1280; ldt = 1280;
  } else {
    b = unit >> 4; hkv = (unit >> 3) & 1; qb = unit & 7; ntile = 4;
    tokq0 = b * 256 + qb * 32;
    Kb = (const bfr*)(p.ws + OFF_PROJ + PJ_AKP) + (size_t)(b * 256) * 256 + hkv * 128;
    Vb = (const bfr*)(p.ws + OFF_PROJ + PJ_AVPT) + (size_t)((b * 2 + hkv) * 128) * 256; ldt = 256;
  }
  const bfr* aq = (const bfr*)(p.ws + OFF_PROJ + PJ_AQ);
  const bfr* ag = (const bfr*)(p.ws + OFF_PROJ + PJ_AG);
  bfr* uo = (bfr*)(p.ws + OFF_U);
  const int tid = threadIdx.x, lane = tid & 63, w = tid >> 6, r = lane & 31, hh = lane >> 5;
  const int hq = hkv * 4 + w;
  bfr* sK = (bfr*)smem;
  bfr* sV = sK + 2 * 64 * 136;
  bf16x8 qf[8];
#pragma unroll
  for (int kk = 0; kk < 8; ++kk) qf[kk] = *(const bf16x8*)(aq + (size_t)(tokq0 + r) * 1024 + hq * 128 + 16 * kk + 8 * hh);
  f32x16 oacc[4];
#pragma unroll
  for (int a = 0; a < 4; ++a)
#pragma unroll
    for (int i = 0; i < 16; ++i) oacc[a][i] = 0.f;
  float m_run = -INFINITY, l_run = 0.f;
  uint4 rk[4], rv[4];
  const int krow = tid >> 4, kch = (tid & 15) * 8;
  const int vrow = tid >> 3, vch = (tid & 7) * 8;
#pragma unroll
  for (int j = 0; j < 4; ++j) {
    rk[j] = *(const uint4*)(Kb + (size_t)(krow + 16 * j) * 256 + kch);
    rv[j] = *(const uint4*)(Vb + (size_t)(vrow + 32 * j) * ldt + vch);
  }
#pragma unroll
  for (int j = 0; j < 4; ++j) {
    *(uint4*)(sK + (krow + 16 * j) * 136 + kch) = rk[j];
    *(uint4*)(sV + (vrow + 32 * j) * 72 + vch) = rv[j];
  }
  __syncthreads();
  for (int kt = 0; kt < ntile; ++kt) {
    const int cur = kt & 1;
    {
      const int key0 = (kt + 1 < ntile ? kt + 1 : kt) * 64;
#pragma unroll
      for (int j = 0; j < 4; ++j) {
        rk[j] = *(const uint4*)(Kb + (size_t)(key0 + krow + 16 * j) * 256 + kch);
        rv[j] = *(const uint4*)(Vb + (size_t)(vrow + 32 * j) * ldt + key0 + vch);
      }
    }
    const bfr* cK = sK + cur * 64 * 136;
    const bfr* cV = sV + cur * 128 * 72;
    f32x16 sacc[2];
#pragma unroll
    for (int kb = 0; kb < 2; ++kb) {
#pragma unroll
      for (int i = 0; i < 16; ++i) sacc[kb][i] = 0.f;
#pragma unroll
      for (int kk = 0; kk < 8; ++kk) {
        bf16x8 a = *(const bf16x8*)(cK + (32 * kb + r) * 136 + 16 * kk + 8 * hh);
        sacc[kb] = MFMA32(a, qf[kk], sacc[kb]);
      }
    }
    float mt = sacc[0][0];
#pragma unroll
    for (int kb = 0; kb < 2; ++kb)
#pragma unroll
      for (int i = 0; i < 16; ++i) mt = fmaxf(mt, sacc[kb][i]);
    mt = fmaxf(mt, __shfl_xor(mt, 32));
    const float m_new = fmaxf(m_run, mt);
    const float alpha = exp2f(m_run - m_new);
    m_run = m_new;
    float ls = 0.f;
#pragma unroll
    for (int kb = 0; kb < 2; ++kb)
#pragma unroll
      for (int i = 0; i < 16; ++i) { float pv = exp2f(sacc[kb][i] - m_new); sacc[kb][i] = pv; ls += pv; }
    l_run = l_run * alpha + ls;
#pragma unroll
    for (int a = 0; a < 4; ++a)
#pragma unroll
      for (int i = 0; i < 16; ++i) oacc[a][i] *= alpha;
#pragma unroll
    for (int kb = 0; kb < 2; ++kb)
#pragma unroll
      for (int s2 = 0; s2 < 2; ++s2) {
        unsigned pk[4];
#pragma unroll
        for (int j = 0; j < 4; ++j) pk[j] = pack2(sacc[kb][8 * s2 + 2 * j], sacc[kb][8 * s2 + 2 * j + 1]);
        bf16x8 pb = __builtin_bit_cast(bf16x8, make_uint4(pk[0], pk[1], pk[2], pk[3]));
#pragma unroll
        for (int dvb = 0; dvb < 4; ++dvb) {
          const bfr* vp = cV + (32 * dvb + r) * 72 + 32 * kb + 16 * s2 + 4 * hh;
          uint2 lo = *(const uint2*)vp, hi = *(const uint2*)(vp + 8);
          bf16x8 av = __builtin_bit_cast(bf16x8, make_uint4(lo.x, lo.y, hi.x, hi.y));
          oacc[dvb] = MFMA32(av, pb, oacc[dvb]);
        }
      }
    {
      bfr* nK = sK + (cur ^ 1) * 64 * 136;
      bfr* nV = sV + (cur ^ 1) * 128 * 72;
#pragma unroll
      for (int j = 0; j < 4; ++j) {
        *(uint4*)(nK + (krow + 16 * j) * 136 + kch) = rk[j];
        *(uint4*)(nV + (vrow + 32 * j) * 72 + vch) = rv[j];
      }
    }
    __syncthreads();
  }
  const float lt = l_run + __shfl_xor(l_run, 32);
  const float inv = 1.f / lt;
#pragma unroll
  for (int dvb = 0; dvb < 4; ++dvb)
#pragma unroll
    for (int g = 0; g < 4; ++g) {
      size_t idx = (size_t)(tokq0 + r) * 1024 + hq * 128 + 32 * dvb + 8 * g + 4 * hh;
      uint2 gv = *(const uint2*)(ag + idx);
      float o0 = oacc[dvb][4 * g] * inv * bf2f(gv.x & 0xffff), o1 = oacc[dvb][4 * g + 1] * inv * bf2f(gv.x >> 16);
      float o2 = oacc[dvb][4 * g + 2] * inv * bf2f(gv.y & 0xffff), o3 = oacc[dvb][4 * g + 3] * inv * bf2f(gv.y >> 16);
      *(uint2*)(uo + idx) = make_uint2(pack2(o0, o1), pack2(o2, o3));
    }
}
DI void phase_attn(const Params& p, int ai, unsigned char* smem) {
  const int nb = gridDim.x, bid = blockIdx.x;
  int idx, step;
  if (nb >= 512) { idx = bid; step = bid < 256 ? 512 : nb - 256; }
  else { idx = bid; step = nb; }
  for (; idx < 512; idx += step) {
    const bool sample = idx < 256;
    attn_unit(p, ai, sample, sample ? idx : idx - 256, smem);
  }
}


#define XB_TMO      128
#define XB_XCNT(j)  (256  + 64 * (j))
#define XB_XSUB(j)  (1280 + 64 * (j))
#define XB_XGEN(j)  (2304 + 64 * (j))
#define XB_TOP      3328
#define XB_TOPGEN   3392
#define XCD_BAR_WORDS 3456
#define XB_SPIN_CAP (1u << 18)
#define LAS __attribute__((address_space(3)))
DI unsigned xb_ld(unsigned* p) { return __hip_atomic_load(p, __ATOMIC_RELAXED, __HIP_MEMORY_SCOPE_AGENT); }
DI unsigned xb_add(unsigned* p, unsigned v) { return __hip_atomic_fetch_add(p, v, __ATOMIC_RELAXED, __HIP_MEMORY_SCOPE_AGENT); }
DI unsigned xb_xcc_id() { return (unsigned)__builtin_amdgcn_s_getreg((3 << 11) | 20) & 0xFu; }
#define XB_SPIN(cond, bar) do { unsigned _sp = 0; while (cond) { __builtin_amdgcn_s_sleep(1); \
    if ((++_sp & 255u) == 0u) { if (xb_ld(&(bar)[XB_TMO])) break; if (_sp > XB_SPIN_CAP) { atomicAdd(&(bar)[XB_TMO], 1u); break; } } } } while (0)
struct XcdBarrier { unsigned* bar; unsigned x; volatile LAS unsigned* st; };
DI XcdBarrier xcd_barrier_post(unsigned* bar, volatile LAS unsigned* st) {
  XcdBarrier b; b.bar = bar; b.x = xb_xcc_id(); b.st = st;
  if (threadIdx.x == 0) (void)xb_add(&bar[XB_XCNT(b.x)], 1u);
  return b;
}
DI void xcd_barrier_complete(unsigned* bar, unsigned x, unsigned& nloc, unsigned& nx) {
  const unsigned G = gridDim.x * gridDim.y * gridDim.z;
  unsigned sum, cnt, mine, sp = 0u;
  for (;;) {
    sum = 0u; cnt = 0u; mine = 0u;
#pragma unroll
    for (unsigned j = 0; j < 16; ++j) { const unsigned c = xb_ld(&bar[XB_XCNT(j)]); sum += c; cnt += (c > 0u) ? 1u : 0u; mine = (j == x) ? c : mine; }
    if (sum == G) break;
    __builtin_amdgcn_s_sleep(1);
    if ((++sp & 255u) == 0u) { if (xb_ld(&bar[XB_TMO])) break; if (sp > XB_SPIN_CAP) { atomicAdd(&bar[XB_TMO], 1u); break; } }
  }
  nloc = mine > 0u ? mine : 1u; nx = cnt > 0u ? cnt : 1u;
}
DI void xcd_barrier(const XcdBarrier& b) {
  asm volatile("s_waitcnt vmcnt(0)" ::: "memory");
  __syncthreads();
  if (threadIdx.x == 0) {
    unsigned* bar = b.bar;
    __builtin_amdgcn_s_waitcnt(0);
    unsigned nloc = b.st[0], nx = b.st[1];
    if (nloc == 0u) { xcd_barrier_complete(bar, b.x, nloc, nx); b.st[0] = nloc; b.st[1] = nx; }
    const unsigned old = xb_add(&bar[XB_XSUB(b.x)], 1u);
    const unsigned gen = old / nloc;
    if (old + 1u == (gen + 1u) * nloc) {
      __builtin_amdgcn_fence(__ATOMIC_RELEASE, "agent");
      asm volatile("s_waitcnt vmcnt(0)" ::: "memory");
      const unsigned og = xb_add(&bar[XB_TOP], 1u);
      const unsigned tg = og / nx;
      if (og + 1u == (tg + 1u) * nx) xb_add(&bar[XB_TOPGEN], 1u);
      else XB_SPIN(xb_ld(&bar[XB_TOPGEN]) == tg, bar);
      __builtin_amdgcn_fence(__ATOMIC_ACQUIRE, "agent");
      xb_add(&bar[XB_XGEN(b.x)], 1u);
      asm volatile("s_waitcnt vmcnt(0)" ::: "memory");
    } else {
      XB_SPIN(xb_ld(&bar[XB_XGEN(b.x)]) == gen, bar);
      __builtin_amdgcn_fence(__ATOMIC_ACQUIRE, "agent");
      asm volatile("s_waitcnt vmcnt(0)" ::: "memory");
    }
  }
  __syncthreads();
}

#ifndef REP_P0
#define REP_P0 1
#endif
#ifndef REP_SMALL
#define REP_SMALL 1
#endif
#ifndef REP_GIN
#define REP_GIN 1
#endif
#ifndef REP_AIN
#define REP_AIN 1
#endif
#ifndef REP_SCAN
#define REP_SCAN 1
#endif
#ifndef REP_ATT
#define REP_ATT 1
#endif
#ifndef REP_OUT0
#define REP_OUT0 1
#endif
#ifndef REP_SYNC
#define REP_SYNC 1
#endif
#define SYNC() do { xcd_barrier(xb); if (REP_SYNC >= 2) xcd_barrier(xb); if (REP_SYNC >= 3) xcd_barrier(xb); } while (0)
#define RUN(n, stmt) do { stmt; SYNC(); if ((n) >= 2) { stmt; SYNC(); } } while (0)

__global__ void __launch_bounds__(256, 2) fwd_megakernel(Params p) {
  __shared__ __attribute__((aligned(16))) unsigned char smem[SMEM_BYTES];
  __shared__ uint4 xb_words;
  cg::grid_group grid = cg::this_grid();
  if (p.never) grid.sync();
  if (threadIdx.x == 0) xb_words = make_uint4(0u, 0u, 0u, 0u);
  __syncthreads();
  XcdBarrier xb = xcd_barrier_post((unsigned*)(p.ws + OFF_BAR), (volatile LAS unsigned*)&xb_words);
  RUN(REP_P0, phase0(p, smem));
  RUN(REP_SMALL, phase_norm(p, 0));
  RUN(REP_GIN, phase_gla_in(p, 0, smem));
  RUN(REP_SMALL, phase_gla_prep(p, 0, smem));
  RUN(REP_SCAN, phase_gla_scan(p, 0, smem));
  RUN(REP_SMALL, phase_gla_post(p, 0));
  RUN(REP_OUT0, phase_out_proj(p, 0, (const bfr*)(p.ws + OFF_WT_GLA_OUT), smem));
  RUN(REP_SMALL, phase_norm(p, 1));
  RUN(REP_AIN, phase_att_in(p, 0, smem));
  RUN(REP_ATT, phase_attn(p, 0, smem));
  phase_out_proj(p, 1, (const bfr*)(p.ws + OFF_WT_ATT_OUT), smem); SYNC();
  RUN(REP_SMALL, phase_norm(p, 2));
  RUN(REP_GIN, phase_gla_in(p, 1, smem));
  RUN(REP_SMALL, phase_gla_prep(p, 1, smem));
  RUN(REP_SCAN, phase_gla_scan(p, 1, smem));
  RUN(REP_SMALL, phase_gla_post(p, 1));
  phase_out_proj(p, 2, (const bfr*)(p.ws + OFF_WT_GLA_OUT) + (size_t)1024 * 1024, smem); SYNC();
  RUN(REP_SMALL, phase_norm(p, 3));
  RUN(REP_AIN, phase_att_in(p, 1, smem));
  RUN(REP_ATT, phase_attn(p, 1, smem));
  phase_out_proj(p, 3, (const bfr*)(p.ws + OFF_WT_ATT_OUT) + (size_t)1024 * 1024, smem);
}

extern "C" void kernel_launch(void* const* d_in, const int* in_sizes, int n_in, void* d_out, int out_size, void* d_ws,
                              size_t ws_size, hipStream_t stream) {
  static int grid_blocks = 0;
  if (!grid_blocks) {
    int dev = 0, cus = 0, per_cu = 0;
    hipGetDevice(&dev);
    hipDeviceGetAttribute(&cus, hipDeviceAttributeMultiprocessorCount, dev);
    hipOccupancyMaxActiveBlocksPerMultiprocessor(&per_cu, fwd_megakernel, 256, 0);
    if (per_cu > 2) per_cu = 2;
    if (per_cu < 1) per_cu = 1;
    grid_blocks = cus * per_cu;
  }
  Params p{};
  for (int i = 0; i < 20; ++i) p.in[i] = (const float*)d_in[i];
  p.out = (float*)d_out;
  p.ws = (unsigned char*)d_ws;
  p.never = 0;
  p.pad = 0;
  hipMemsetAsync((unsigned char*)d_ws + OFF_BAR, 0, 3456 * 4, stream);
  void* args[] = {&p};
  hipError_t e = hipLaunchCooperativeKernel((void*)fwd_megakernel, dim3(grid_blocks), dim3(256), args, 0, stream);
  if (e != hipSuccess) fprintf(stderr, "cooperative launch failed: %s (grid %d)\n", hipGetErrorString(e), grid_blocks);
}
```

```cpp
#include <hip/hip_runtime.h>
#include <hip/hip_cooperative_groups.h>
#include <stdint.h>
#include <stdio.h>
namespace cg = cooperative_groups;

typedef unsigned short bfr;
using bf16x8 = __attribute__((ext_vector_type(8))) short;
using bf16x4 = __attribute__((ext_vector_type(4))) short;
using f32x16 = __attribute__((ext_vector_type(16))) float;
using f32x4 = __attribute__((ext_vector_type(4))) float;
#define DI __device__ __forceinline__
#define MFMA32(a, b, c) __builtin_amdgcn_mfma_f32_32x32x16_bf16((a), (b), (c), 0, 0, 0)

constexpr int NTOK = 8192;
constexpr int DM = 1024;
constexpr int NPT = 4096;
constexpr float EPSN = 1e-6f;
constexpr int GLA_NPAD = 3200;
constexpr int ATT_N = 2560;

constexpr size_t OFF_WT_GLA_IN = 0;
constexpr size_t OFF_WT_GLA_OUT = OFF_WT_GLA_IN + 2ull * GLA_NPAD * 1024 * 2;
constexpr size_t OFF_WT_ATT_IN = OFF_WT_GLA_OUT + 2ull * 1024 * 1024 * 2;
constexpr size_t OFF_WT_ATT_OUT = OFF_WT_ATT_IN + 2ull * ATT_N * 1024 * 2;
constexpr size_t OFF_MOD = OFF_WT_ATT_OUT + 2ull * 1024 * 1024 * 2;
constexpr size_t OFF_ROPE = OFF_MOD + 4ull * 5 * 3072 * 4;
constexpr size_t OFF_H = OFF_ROPE + 2ull * 64 * 32 * 4;
constexpr size_t OFF_PROJ = OFF_H + (size_t)NTOK * 1024 * 2;
constexpr size_t OFF_TBUF = OFF_PROJ + (size_t)NTOK * 3072 * 2;
constexpr size_t OFF_QE = OFF_TBUF + (size_t)NTOK * 32 * 4;
constexpr size_t OFF_KDT = OFF_QE + 2ull * NTOK * 512 * 2;
constexpr size_t OFF_ABUF = OFF_KDT + 2ull * NTOK * 512 * 2;
constexpr size_t OFF_ELAST = OFF_ABUF + 1024ull * 64 * 64 * 2;
constexpr size_t OFF_O = OFF_ELAST + 1024ull * 128 * 4;
constexpr size_t OFF_U = OFF_O + 2ull * NTOK * 1024 * 2;
constexpr size_t OFF_KS = OFF_U + (size_t)NTOK * 1024 * 2;
constexpr size_t OFF_VST = OFF_KS + 2ull * 4 * 1280 * 256 * 2;
constexpr size_t OFF_BAR = OFF_VST + 2ull * 4 * 1280 * 256 * 2;
constexpr size_t WS_END = OFF_BAR + 3456 * 4;
constexpr size_t PJ_GQ = 0;
constexpr size_t PJ_GK = (size_t)NTOK * 512 * 2;
constexpr size_t PJ_GG = (size_t)NTOK * 1024 * 2;
constexpr size_t PJ_GVT = (size_t)NTOK * 2048 * 2;
constexpr size_t PJ_AQ = 0;
constexpr size_t PJ_AG = (size_t)NTOK * 1024 * 2;
constexpr size_t PJ_AKP = (size_t)NTOK * 2048 * 2;
constexpr size_t PJ_AVPT = PJ_AKP + 4096ull * 256 * 2;

constexpr size_t OUT_STATE = 2ull * 4096 * 1024;
constexpr size_t OUT_CK = OUT_STATE + 16ull * 2 * 2 * 4 * 128 * 256;
constexpr size_t OUT_CV = OUT_CK + 16ull * 2 * 256 * 2 * 128;

constexpr int SMEM_BYTES = 73728;

struct Params {
  const float* in[20];
  float* out;
  unsigned char* ws;
  int never;
  int pad;
};
enum { I_XP = 0, I_XS, I_STATE, I_CK, I_CV, I_C, I_CCTX, I_NORMG, I_WADA, I_BADA, I_GWIN, I_GWA1, I_GWA2, I_GBA,
       I_GONORM, I_GWOUT, I_AWIN, I_AQN, I_AKN, I_AWOUT };

typedef __bf16 bf16v2 __attribute__((ext_vector_type(2)));
typedef float f32v2 __attribute__((ext_vector_type(2)));
DI unsigned pack2(float a, float b) {
  f32v2 v = {a, b};
  return __builtin_bit_cast(unsigned, __builtin_convertvector(v, bf16v2));
}
DI bfr f2bf(float x) { return (bfr)(pack2(x, x) & 0xffffu); }
DI float bf2f(bfr b) { return __uint_as_float(((unsigned)b) << 16); }
DI int crow(int reg, int h) { return (reg & 3) + 8 * (reg >> 2) + 4 * h; }
DI float siluf(float x) { return x * __builtin_amdgcn_rcpf(1.f + __expf(-x)); }
DI int modrow(int row) { return row < NPT ? 0 : 1 + ((row - NPT) >> 10); }
DI const float* xrow_ptr(const Params& p, int l, int row) {
  if (l == 0) return row < NPT ? p.in[I_XP] + (size_t)row * DM : p.in[I_XS] + (size_t)(row - NPT) * DM;
  return p.out + (size_t)row * DM;
}
DI float wave_sum(float v) {
#pragma unroll
  for (int o = 32; o >= 1; o >>= 1) v += __shfl_xor(v, o);
  return v;
}
DI float half_sum(float v) {
#pragma unroll
  for (int o = 16; o >= 1; o >>= 1) v += __shfl_xor(v, o);
  return v;
}

DI void transpose_tile(const float* __restrict__ src, int src_ld, int k0, int n0, int ncols, bfr* __restrict__ dst,
                       size_t dst_ld, unsigned char* smem) {
  float* tile = (float*)smem;
  const int tid = threadIdx.x;
  const int c4 = (tid & 15) * 4, kr = tid >> 4;
#pragma unroll
  for (int j = 0; j < 4; ++j) {
    int k = kr + 16 * j;
    if (c4 < ncols) {
      float4 v = *(const float4*)(src + (size_t)(k0 + k) * src_ld + n0 + c4);
      tile[k * 65 + c4] = v.x; tile[k * 65 + c4 + 1] = v.y; tile[k * 65 + c4 + 2] = v.z; tile[k * 65 + c4 + 3] = v.w;
    }
  }
  __syncthreads();
  const int n = tid >> 2, kq = (tid & 3) * 16;
  if (n < ncols) {
    unsigned pk[8];
#pragma unroll
    for (int j = 0; j < 8; ++j) pk[j] = pack2(tile[(kq + 2 * j) * 65 + n], tile[(kq + 2 * j + 1) * 65 + n]);
    uint4* d = (uint4*)(dst + (size_t)(n0 + n) * dst_ld + k0 + kq);
    d[0] = make_uint4(pk[0], pk[1], pk[2], pk[3]);
    d[1] = make_uint4(pk[4], pk[5], pk[6], pk[7]);
  }
  __syncthreads();
}

DI void mod_unit(const Params& p, int unit, unsigned char* smem) {
  const int l = unit / 96, n0 = (unit % 96) * 32;
  float* sil = (float*)smem;
  float* red = sil + 5 * 1024;
  const int tid = threadIdx.x;
  for (int e = tid; e < 5 * 1024; e += 256) {
    int r = e >> 10, k = e & 1023;
    float cv = r == 0 ? p.in[I_CCTX][k] : p.in[I_C][(r - 1) * 1024 + k];
    sil[e] = cv / (1.f + expf(-cv));
  }
  __syncthreads();
  const int kg = tid >> 5, cn = tid & 31;
  const float* w = p.in[I_WADA] + (size_t)l * 1024 * 3072 + n0 + cn;
  float a0 = 0, a1 = 0, a2 = 0, a3 = 0, a4 = 0;
#pragma unroll 8
  for (int kk = 0; kk < 128; ++kk) {
    int k = kg * 128 + kk;
    float wv = w[(size_t)k * 3072];
    a0 += sil[k] * wv; a1 += sil[1024 + k] * wv; a2 += sil[2048 + k] * wv; a3 += sil[3072 + k] * wv; a4 += sil[4096 + k] * wv;
  }
  red[(kg * 5 + 0) * 32 + cn] = a0; red[(kg * 5 + 1) * 32 + cn] = a1; red[(kg * 5 + 2) * 32 + cn] = a2;
  red[(kg * 5 + 3) * 32 + cn] = a3; red[(kg * 5 + 4) * 32 + cn] = a4;
  __syncthreads();
  if (tid < 160) {
    int r = tid >> 5;
    float s = p.in[I_BADA][l * 3072 + n0 + cn];
#pragma unroll
    for (int g = 0; g < 8; ++g) s += red[(g * 5 + r) * 32 + cn];
    ((float*)(p.ws + OFF_MOD))[(l * 5 + r) * 3072 + n0 + cn] = s;
  }
  __syncthreads();
}

DI void phase0(const Params& p, unsigned char* smem) {
  constexpr int U_MOD = 384;
  constexpr int U_GIN = 2 * 16 * 48;
  constexpr int U_GA1 = 2 * 2 * 16;
  constexpr int U_GZ = 2;
  constexpr int U_GOUT = 2 * 16 * 16;
  constexpr int U_AIN = 2 * 16 * 40;
  constexpr int U_AOUT = 2 * 16 * 16;
  constexpr int U_ROPE = 1;
  constexpr int U_CK = 64;
  constexpr int U_CV = 4 * 2 * 16;
  constexpr int U_TOTAL = U_MOD + U_GIN + U_GA1 + U_GZ + U_GOUT + U_AIN + U_AOUT + U_ROPE + U_CK + U_CV;
  bfr* wt_gin = (bfr*)(p.ws + OFF_WT_GLA_IN);
  bfr* wt_gout = (bfr*)(p.ws + OFF_WT_GLA_OUT);
  bfr* wt_ain = (bfr*)(p.ws + OFF_WT_ATT_IN);
  bfr* wt_aout = (bfr*)(p.ws + OFF_WT_ATT_OUT);
  const int tid = threadIdx.x;
  for (int unit = blockIdx.x; unit < U_TOTAL; unit += gridDim.x) {
    int u = unit;
    if (u < U_MOD) { mod_unit(p, u, smem); continue; }
    u -= U_MOD;
    if (u < U_GIN) {
      int i = u / 768, r = u % 768, kt = r / 48, nt = r % 48;
      transpose_tile(p.in[I_GWIN] + (size_t)i * 1024 * 3072, 3072, kt * 64, nt * 64, 64,
                     wt_gin + (size_t)i * GLA_NPAD * 1024, 1024, smem);
      continue;
    }
    u -= U_GIN;
    if (u < U_GA1) {
      int id = u / 16, kt = u % 16;
      int i = id >> 1, d = id & 1;
      transpose_tile(p.in[I_GWA1] + (size_t)id * 1024 * 16, 16, kt * 64, 0, 16,
                     wt_gin + ((size_t)i * GLA_NPAD + 3072 + d * 16) * 1024, 1024, smem);
      continue;
    }
    u -= U_GA1;
    if (u < U_GZ) {
      uint4* z = (uint4*)(wt_gin + ((size_t)u * GLA_NPAD + 3104) * 1024);
      for (int e = tid; e < 96 * 1024 / 8; e += 256) z[e] = make_uint4(0, 0, 0, 0);
      continue;
    }
    u -= U_GZ;
    if (u < U_GOUT) {
      int i = u / 256, r = u % 256, kt = r / 16, nt = r % 16;
      transpose_tile(p.in[I_GWOUT] + (size_t)i * 1024 * 1024, 1024, kt * 64, nt * 64, 64,
                     wt_gout + (size_t)i * 1024 * 1024, 1024, smem);
      continue;
    }
    u -= U_GOUT;
    if (u < U_AIN) {
      int i = u / 640, r = u % 640, kt = r / 40, nt = r % 40;
      transpose_tile(p.in[I_AWIN] + (size_t)i * 1024 * ATT_N, ATT_N, kt * 64, nt * 64, 64,
                     wt_ain + (size_t)i * ATT_N * 1024, 1024, smem);
      continue;
    }
    u -= U_AIN;
    if (u < U_AOUT) {
      int i = u / 256, r = u % 256, kt = r / 16, nt = r % 16;
      transpose_tile(p.in[I_AWOUT] + (size_t)i * 1024 * 1024, 1024, kt * 64, nt * 64, 64,
                     wt_aout + (size_t)i * 1024 * 1024, 1024, smem);
      continue;
    }
    u -= U_AOUT;
    if (u < U_ROPE) {
      float* rc = (float*)(p.ws + OFF_ROPE);
      float* rs = rc + 64 * 32;
      for (int e = tid; e < 2048; e += 256) {
        int pos = e >> 5, f = e & 31;
        float fr = powf(10000.0f, -(float)f / 32.0f);
        float ang = (float)pos * fr;
        rc[e] = cosf(ang);
        rs[e] = sinf(ang);
      }
      continue;
    }
    u -= U_ROPE;
    if (u < U_CK) {
      bfr* ks = (bfr*)(p.ws + OFF_KS);
      for (int e = tid; e < 2048; e += 256) {
        size_t idx = (size_t)u * 8192 + (size_t)e * 4;
        int c = idx & 255, t = (idx >> 8) & 255, i = (idx >> 16) & 1, b = (int)(idx >> 17);
        float4 v = *(const float4*)(p.in[I_CK] + idx);
        uint2 o = make_uint2(pack2(v.x, v.y), pack2(v.z, v.w));
        *(uint2*)(ks + ((size_t)(i * 4 + b) * 1280 + 1024 + t) * 256 + c) = o;
      }
      continue;
    }
    u -= U_CK;
    {
      int bi = u / 16, r = u % 16, kt = r / 4, nt = r % 4;
      int b = bi >> 1, i = bi & 1;
      transpose_tile(p.in[I_CV] + (size_t)bi * 256 * 256, 256, kt * 64, nt * 64, 64,
                     (bfr*)(p.ws + OFF_VST) + (size_t)(i * 4 + b) * 256 * 1280 + 1024, 1280, smem);
    }
  }
}

DI void phase_norm(const Params& p, int l) {
  const int lane = threadIdx.x & 63;
  const int gw = blockIdx.x * 4 + (threadIdx.x >> 6), nw = gridDim.x * 4;
  const float* g = p.in[I_NORMG] + l * DM;
  const float* mod = (const float*)(p.ws + OFF_MOD) + (size_t)l * 5 * 3072;
  bfr* h = (bfr*)(p.ws + OFF_H);
  for (int row = gw; row < NTOK; row += nw) {
    const float* x = xrow_ptr(p, l, row);
    float4 v[4];
    float ss = 0.f;
#pragma unroll
    for (int j = 0; j < 4; ++j) {
      v[j] = *(const float4*)(x + lane * 4 + 256 * j);
      ss += v[j].x * v[j].x + v[j].y * v[j].y + v[j].z * v[j].z + v[j].w * v[j].w;
    }
    ss = wave_sum(ss);
    const float rstd = rsqrtf(ss * (1.f / 1024.f) + EPSN);
    const float* mr = mod + modrow(row) * 3072;
#pragma unroll
    for (int j = 0; j < 4; ++j) {
      int c = lane * 4 + 256 * j;
      float4 gg = *(const float4*)(g + c);
      float4 sh = *(const float4*)(mr + c);
      float4 sc = *(const float4*)(mr + 1024 + c);
      float o0 = v[j].x * rstd * gg.x * (1.f + sc.x) + sh.x;
      float o1 = v[j].y * rstd * gg.y * (1.f + sc.y) + sh.y;
      float o2 = v[j].z * rstd * gg.z * (1.f + sc.z) + sh.z;
      float o3 = v[j].w * rstd * gg.w * (1.f + sc.w) + sh.w;
      *(uint2*)(h + (size_t)row * DM + c) = make_uint2(pack2(o0, o1), pack2(o2, o3));
    }
  }
}

DI void gemm_core(const bfr* __restrict__ A, const bfr* __restrict__ Bt, int K, int m0, int n0, unsigned char* smem,
                  f32x16 (&acc)[2][2]) {
  bfr* sA = (bfr*)smem;
  bfr* sB = sA + 2 * 128 * 72;
  const int tid = threadIdx.x, lane = tid & 63, w = tid >> 6, wm = w >> 1, wn = w & 1, r = lane & 31, hh = lane >> 5;
  const int lrow = tid >> 3, lch = (tid & 7) * 8;
  const bfr* gA = A + (size_t)(m0 + lrow) * K + lch;
  const bfr* gB = Bt + (size_t)(n0 + lrow) * K + lch;
#pragma unroll
  for (int a = 0; a < 2; ++a)
#pragma unroll
    for (int b = 0; b < 2; ++b)
#pragma unroll
      for (int i = 0; i < 16; ++i) acc[a][b][i] = 0.f;
  uint4 ra[4], rb[4];
#pragma unroll
  for (int j = 0; j < 4; ++j) {
    ra[j] = *(const uint4*)(gA + (size_t)(32 * j) * K);
    rb[j] = *(const uint4*)(gB + (size_t)(32 * j) * K);
  }
#pragma unroll
  for (int j = 0; j < 4; ++j) {
    *(uint4*)(sA + (lrow + 32 * j) * 72 + lch) = ra[j];
    *(uint4*)(sB + (lrow + 32 * j) * 72 + lch) = rb[j];
  }
  __syncthreads();
  const int KT = K >> 6;
  for (int kt = 0; kt < KT; ++kt) {
    const int cur = kt & 1;
    if (kt + 1 < KT) {
#pragma unroll
      for (int j = 0; j < 4; ++j) {
        ra[j] = *(const uint4*)(gA + (size_t)(32 * j) * K + (kt + 1) * 64);
        rb[j] = *(const uint4*)(gB + (size_t)(32 * j) * K + (kt + 1) * 64);
      }
    }
    const bfr* cA = sA + cur * 128 * 72;
    const bfr* cB = sB + cur * 128 * 72;
#pragma unroll
    for (int kk = 0; kk < 4; ++kk) {
      bf16x8 a[2], b[2];
#pragma unroll
      for (int mb = 0; mb < 2; ++mb) a[mb] = *(const bf16x8*)(cA + (64 * wm + 32 * mb + r) * 72 + 16 * kk + 8 * hh);
#pragma unroll
      for (int nb = 0; nb < 2; ++nb) b[nb] = *(const bf16x8*)(cB + (64 * wn + 32 * nb + r) * 72 + 16 * kk + 8 * hh);
#pragma unroll
      for (int mb = 0; mb < 2; ++mb)
#pragma unroll
        for (int nb = 0; nb < 2; ++nb) acc[mb][nb] = MFMA32(a[mb], b[nb], acc[mb][nb]);
    }
    if (kt + 1 < KT) {
      bfr* nA = sA + (cur ^ 1) * 128 * 72;
      bfr* nB = sB + (cur ^ 1) * 128 * 72;
#pragma unroll
      for (int j = 0; j < 4; ++j) {
        *(uint4*)(nA + (lrow + 32 * j) * 72 + lch) = ra[j];
        *(uint4*)(nB + (lrow + 32 * j) * 72 + lch) = rb[j];
      }
    }
    __syncthreads();
  }
}
DI void stage_acc(const f32x16 (&acc)[2][2], float* sC) {
  const int lane = threadIdx.x & 63, w = threadIdx.x >> 6, wm = w >> 1, wn = w & 1, r = lane & 31, hh = lane >> 5;
#pragma unroll
  for (int mb = 0; mb < 2; ++mb)
#pragma unroll
    for (int nb = 0; nb < 2; ++nb)
#pragma unroll
      for (int i = 0; i < 16; ++i) sC[(64 * wm + 32 * mb + crow(i, hh)) * 132 + 64 * wn + 32 * nb + r] = acc[mb][nb][i];
}
DI void stage_acc_t(const f32x16 (&acc)[2][2], float* sC) {
  const int lane = threadIdx.x & 63, w = threadIdx.x >> 6, wm = w >> 1, wn = w & 1, r = lane & 31, hh = lane >> 5;
#pragma unroll
  for (int mb = 0; mb < 2; ++mb)
#pragma unroll
    for (int nb = 0; nb < 2; ++nb)
#pragma unroll
      for (int g = 0; g < 4; ++g) {
        float4 v = make_float4(acc[mb][nb][4 * g], acc[mb][nb][4 * g + 1], acc[mb][nb][4 * g + 2], acc[mb][nb][4 * g + 3]);
        *(float4*)(sC + (64 * wn + 32 * nb + r) * 132 + 64 * wm + 32 * mb + 8 * g + 4 * hh) = v;
      }
}

struct TileIter {
  int lt, step, nl, mbase, mmask, mshift;
  DI TileIter(int NT) {
    const int nblk = gridDim.x, bid = blockIdx.x;
    if ((nblk & 7) == 0) { mbase = (bid & 7) * 8; lt = bid >> 3; step = nblk >> 3; nl = 8 * NT; mmask = 7; mshift = 3; }
    else { mbase = 0; lt = bid; step = nblk; nl = 64 * NT; mmask = 63; mshift = 6; }
  }
  DI bool valid() const { return lt < nl; }
  DI int mt() const { return mbase + (lt & mmask); }
  DI int nt() const { return lt >> mshift; }
  DI void next() { lt += step; }
};

DI void phase_gla_in(const Params& p, int gi, unsigned char* smem) {
  const bfr* A = (const bfr*)(p.ws + OFF_H);
  const bfr* Bt = (const bfr*)(p.ws + OFF_WT_GLA_IN) + (size_t)gi * GLA_NPAD * 1024;
  bfr* gq = (bfr*)(p.ws + OFF_PROJ + PJ_GQ);
  bfr* gk = (bfr*)(p.ws + OFF_PROJ + PJ_GK);
  bfr* gg = (bfr*)(p.ws + OFF_PROJ + PJ_GG);
  bfr* gvt = (bfr*)(p.ws + OFF_PROJ + PJ_GVT);
  float* tb = (float*)(p.ws + OFF_TBUF);
  float* sC = (float*)smem;
  const int tid = threadIdx.x;
  constexpr int NT = 25, MT = 64;
  for (TileIter ti(NT); ti.valid(); ti.next()) {
    const int mt = ti.mt(), nt = ti.nt(), m0 = mt * 128, n0 = nt * 128;
    f32x16 acc[2][2];
    gemm_core(A, Bt, 1024, m0, n0, smem, acc);
    if (nt >= 8 && nt < 16) {
      stage_acc_t(acc, sC);
      __syncthreads();
#pragma unroll 4
      for (int it = 0; it < 16; ++it) {
        int idx = it * 256 + tid, col = idx >> 5, r4 = (idx & 31) * 4;
        float4 v = *(const float4*)(sC + col * 132 + r4);
        *(uint2*)(gvt + (size_t)((nt - 8) * 128 + col) * NTOK + m0 + r4) = make_uint2(pack2(v.x, v.y), pack2(v.z, v.w));
      }
    } else {
      stage_acc(acc, sC);
      __syncthreads();
#pragma unroll 4
      for (int it = 0; it < 16; ++it) {
        int idx = it * 256 + tid, row = idx >> 5, c4 = (idx & 31) * 4;
        float4 v = *(const float4*)(sC + row * 132 + c4);
        size_t grow = m0 + row;
        if (nt < 4) {
          const float s = 0.08838834764831845f;
          *(uint2*)(gq + grow * 512 + n0 + c4) = make_uint2(pack2(v.x * s, v.y * s), pack2(v.z * s, v.w * s));
        } else if (nt < 8) {
          *(uint2*)(gk + grow * 512 + (n0 - 512) + c4) = make_uint2(pack2(v.x, v.y), pack2(v.z, v.w));
        } else if (nt < 24) {
          *(uint2*)(gg + grow * 1024 + (n0 - 2048) + c4) =
              make_uint2(pack2(siluf(v.x), siluf(v.y)), pack2(siluf(v.z), siluf(v.w)));
        } else {
          if (c4 < 32) *(float4*)(tb + grow * 32 + c4) = v;
        }
      }
    }
    __syncthreads();
  }
}

DI void phase_gla_prep(const Params& p, int gi, unsigned char* smem) {
  const bfr* gq = (const bfr*)(p.ws + OFF_PROJ + PJ_GQ);
  const bfr* gk = (const bfr*)(p.ws + OFF_PROJ + PJ_GK);
  const float* tb = (const float*)(p.ws + OFF_TBUF);
  bfr* qe_o = (bfr*)(p.ws + OFF_QE);
  bfr* kdt_o = (bfr*)(p.ws + OFF_KDT);
  bfr* a_o = (bfr*)(p.ws + OFF_ABUF);
  float* el_o = (float*)(p.ws + OFF_ELAST);
  bfr* sQ = (bfr*)smem;
  bfr* sK = sQ + 64 * 136;
  float* tl = (float*)(sK + 64 * 136);
  float* tot = tl + 64 * 16;
  const int tid = threadIdx.x, lane = tid & 63, w = tid >> 6, r = lane & 31, hh = lane >> 5;
  const int dk = tid & 127, half = tid >> 7;
  for (int u = blockIdx.x; u < 1024; u += gridDim.x) {
    const int d = u >> 9, cgi = (u >> 2) & 127, hd = u & 3;
    const int token0 = cgi * 64;
    {
      int s = tid >> 2, j4 = (tid & 3) * 4;
      *(float4*)(tl + s * 16 + j4) = *(const float4*)(tb + (size_t)(token0 + s) * 32 + d * 16 + j4);
    }
#pragma unroll
    for (int j = 0; j < 4; ++j) {
      int id = j * 256 + tid, row = id >> 4, ch = (id & 15) * 8;
      *(uint4*)(sQ + row * 136 + ch) = *(const uint4*)(gq + (size_t)(token0 + row) * 512 + hd * 128 + ch);
      *(uint4*)(sK + row * 136 + ch) = *(const uint4*)(gk + (size_t)(token0 + row) * 512 + hd * 128 + ch);
    }
    float w2[16];
    const float* wa2 = p.in[I_GWA2] + (size_t)(gi * 2 + d) * 16 * 512 + hd * 128 + dk;
#pragma unroll
    for (int j = 0; j < 16; ++j) w2[j] = wa2[j * 512];
    const float bias = p.in[I_GBA][(gi * 2 + d) * 512 + hd * 128 + dk];
    __syncthreads();
    float pc[32];
    float cum = 0.f;
#pragma unroll
    for (int sl = 0; sl < 32; ++sl) {
      const float* tr = tl + (half * 32 + sl) * 16;
      float z = bias;
#pragma unroll
      for (int j4 = 0; j4 < 4; ++j4) {
        float4 tv = *(const float4*)(tr + j4 * 4);
        z += tv.x * w2[j4 * 4] + tv.y * w2[j4 * 4 + 1] + tv.z * w2[j4 * 4 + 2] + tv.w * w2[j4 * 4 + 3];
      }
      float lg = (fminf(z, 0.f) - __logf(1.f + __expf(-fabsf(z)))) * (1.f / 16.f);
      cum += lg;
      pc[sl] = cum;
    }
    tot[half * 128 + dk] = cum;
    __syncthreads();
    const float t0 = tot[dk], t1 = tot[128 + dk];
    const float total = t0 + t1;
    const float base = half ? t0 : 0.f;
    const float etot = __expf(total);
    if (half == 0) el_o[(size_t)u * 128 + dk] = etot;
    unsigned kdp[16];
    float kd_prev = 0.f;
#pragma unroll
    for (int sl = 0; sl < 32; ++sl) {
      const int s = half * 32 + sl;
      const float pin = base + pc[sl];
      const float pex = base + (sl == 0 ? 0.f : pc[sl == 0 ? 0 : sl - 1]);
      const float b = d ? (total - pex) : pin;
      const float qv = bf2f(sQ[s * 136 + dk]), kv = bf2f(sK[s * 136 + dk]);
      const float eb = __expf(b), enb = __builtin_amdgcn_rcpf(eb);
      const float qe = qv * eb, ke = kv * enb, kd = kv * (etot * enb);
      sQ[s * 136 + dk] = f2bf(qe);
      sK[s * 136 + dk] = f2bf(ke);
      if (sl & 1) kdp[sl >> 1] = pack2(kd_prev, kd); else kd_prev = kd;
    }
    {
      uint4* dst = (uint4*)(kdt_o + ((size_t)u * 128 + dk) * 64 + half * 32);
      dst[0] = make_uint4(kdp[0], kdp[1], kdp[2], kdp[3]);
      dst[1] = make_uint4(kdp[4], kdp[5], kdp[6], kdp[7]);
      dst[2] = make_uint4(kdp[8], kdp[9], kdp[10], kdp[11]);
      dst[3] = make_uint4(kdp[12], kdp[13], kdp[14], kdp[15]);
    }
    __syncthreads();
#pragma unroll
    for (int j = 0; j < 4; ++j) {
      int id = j * 256 + tid, row = id >> 4, ch = (id & 15) * 8;
      *(uint4*)(qe_o + ((size_t)u * 64 + row) * 128 + ch) = *(const uint4*)(sQ + row * 136 + ch);
    }
    const int sb = w >> 1, tbk = w & 1;
    f32x16 acc;
#pragma unroll
    for (int i = 0; i < 16; ++i) acc[i] = 0.f;
#pragma unroll
    for (int kk = 0; kk < 8; ++kk) {
      bf16x8 a = *(const bf16x8*)(sK + (32 * sb + r) * 136 + 16 * kk + 8 * hh);
      bf16x8 b = *(const bf16x8*)(sQ + (32 * tbk + r) * 136 + 16 * kk + 8 * hh);
      acc = MFMA32(a, b, acc);
    }
    const int t = 32 * tbk + r;
#pragma unroll
    for (int g = 0; g < 4; ++g) {
      const int s4 = 32 * sb + 8 * g + 4 * hh;
      float v[4];
#pragma unroll
      for (int j = 0; j < 4; ++j) {
        const int s = s4 + j;
        const bool keep = d ? (s >= t) : (s <= t);
        v[j] = keep ? acc[4 * g + j] : 0.f;
      }
      *(uint2*)(a_o + ((size_t)u * 64 + t) * 64 + s4) = make_uint2(pack2(v[0], v[1]), pack2(v[2], v[3]));
    }
    __syncthreads();
  }
}

DI void gla_scan_unit(const Params& p, int gi, bool sample, int b, int rem, unsigned char* smem) {
  const int hd = rem >> 3, d = (rem >> 2) & 1, sp = rem & 3;
  const int nch = sample ? 16 : 4;
  const int cg0 = sample ? 64 + b * 16 : b * 4;
  const bfr* qe_i = (const bfr*)(p.ws + OFF_QE);
  const bfr* kdt_i = (const bfr*)(p.ws + OFF_KDT);
  const bfr* a_i = (const bfr*)(p.ws + OFF_ABUF);
  const float* el_i = (const float*)(p.ws + OFF_ELAST);
  const bfr* gvt = (const bfr*)(p.ws + OFF_PROJ + PJ_GVT);
  bfr* o_o = (bfr*)(p.ws + OFF_O) + (size_t)d * NTOK * 1024;
  bfr* sSt = (bfr*)smem;
  bfr* sQ = sSt + 64 * 136;
  bfr* sA = sQ + 64 * 136;
  bfr* sV = sA + 64 * 72;
  bfr* sKd = sV + 64 * 72;
  const int tid = threadIdx.x, lane = tid & 63, w = tid >> 6, r = lane & 31, hh = lane >> 5;
  f32x16 S[2];
  if (sample) {
    const float* st = p.in[I_STATE] + ((((size_t)(b * 2 + gi) * 2 + d) * 4 + hd) * 128) * 256 + sp * 64;
#pragma unroll
    for (int nb = 0; nb < 2; ++nb)
#pragma unroll
      for (int i = 0; i < 16; ++i) S[nb][i] = st[(size_t)(32 * w + crow(i, hh)) * 256 + 32 * nb + r];
  } else {
#pragma unroll
    for (int nb = 0; nb < 2; ++nb)
#pragma unroll
      for (int i = 0; i < 16; ++i) S[nb][i] = 0.f;
  }
  for (int c = 0; c < nch; ++c) {
    const int cl = d ? nch - 1 - c : c;
    const int cgi = cg0 + cl;
    const int u = (d * 128 + cgi) * 4 + hd;
    const int token0 = cgi * 64;
#pragma unroll
    for (int j = 0; j < 4; ++j) {
      int id = j * 256 + tid, row = id >> 4, ch = (id & 15) * 8;
      *(uint4*)(sQ + row * 136 + ch) = *(const uint4*)(qe_i + ((size_t)u * 64 + row) * 128 + ch);
    }
#pragma unroll
    for (int j = 0; j < 2; ++j) {
      int id = j * 256 + tid, row = id >> 3, ch = (id & 7) * 8;
      *(uint4*)(sA + row * 72 + ch) = *(const uint4*)(a_i + ((size_t)u * 64 + row) * 64 + ch);
      *(uint4*)(sV + row * 72 + ch) = *(const uint4*)(gvt + (size_t)(hd * 256 + sp * 64 + row) * NTOK + token0 + ch);
    }
#pragma unroll
    for (int j = 0; j < 4; ++j) {
      int id = j * 256 + tid, row = id >> 3, ch = (id & 7) * 8;
      *(uint4*)(sKd + row * 72 + ch) = *(const uint4*)(kdt_i + ((size_t)u * 128 + row) * 64 + ch);
    }
    float4 el[4];
#pragma unroll
    for (int g = 0; g < 4; ++g) el[g] = *(const float4*)(el_i + (size_t)u * 128 + 32 * w + 8 * g + 4 * hh);
#pragma unroll
    for (int nb = 0; nb < 2; ++nb)
#pragma unroll
      for (int g = 0; g < 4; ++g)
        *(uint2*)(sSt + (32 * nb + r) * 136 + 32 * w + 8 * g + 4 * hh) =
            make_uint2(pack2(S[nb][4 * g], S[nb][4 * g + 1]), pack2(S[nb][4 * g + 2], S[nb][4 * g + 3]));
    __syncthreads();
    {
      const int tbk = w >> 1, nbo = w & 1;
      f32x16 oa;
#pragma unroll
      for (int i = 0; i < 16; ++i) oa[i] = 0.f;
#pragma unroll
      for (int kk = 0; kk < 8; ++kk) {
        bf16x8 a = *(const bf16x8*)(sQ + (32 * tbk + r) * 136 + 16 * kk + 8 * hh);
        bf16x8 bb = *(const bf16x8*)(sSt + (32 * nbo + r) * 136 + 16 * kk + 8 * hh);
        oa = MFMA32(a, bb, oa);
      }
#pragma unroll
      for (int kk = 0; kk < 4; ++kk) {
        bf16x8 a = *(const bf16x8*)(sA + (32 * tbk + r) * 72 + 16 * kk + 8 * hh);
        bf16x8 bb = *(const bf16x8*)(sV + (32 * nbo + r) * 72 + 16 * kk + 8 * hh);
        oa = MFMA32(a, bb, oa);
      }
#pragma unroll
      for (int i = 0; i < 16; ++i)
        o_o[(size_t)(token0 + 32 * tbk + crow(i, hh)) * 1024 + hd * 256 + sp * 64 + 32 * nbo + r] = f2bf(oa[i]);
    }
#pragma unroll
    for (int nb = 0; nb < 2; ++nb)
#pragma unroll
      for (int g = 0; g < 4; ++g) {
        S[nb][4 * g] *= el[g].x; S[nb][4 * g + 1] *= el[g].y; S[nb][4 * g + 2] *= el[g].z; S[nb][4 * g + 3] *= el[g].w;
      }
#pragma unroll
    for (int kk = 0; kk < 4; ++kk) {
      bf16x8 a = *(const bf16x8*)(sKd + (32 * w + r) * 72 + 16 * kk + 8 * hh);
#pragma unroll
      for (int nb = 0; nb < 2; ++nb) {
        bf16x8 bb = *(const bf16x8*)(sV + (32 * nb + r) * 72 + 16 * kk + 8 * hh);
        S[nb] = MFMA32(a, bb, S[nb]);
      }
    }
    __syncthreads();
  }
  if (!sample) {
    float* so = p.out + OUT_STATE + ((((size_t)(b * 2 + gi) * 2 + d) * 4 + hd) * 128) * 256 + sp * 64;
#pragma unroll
    for (int nb = 0; nb < 2; ++nb)
#pragma unroll
      for (int i = 0; i < 16; ++i) so[(size_t)(32 * w + crow(i, hh)) * 256 + 32 * nb + r] = S[nb][i];
  }
}
DI void phase_gla_scan(const Params& p, int gi, unsigned char* smem) {
  const int nb = gridDim.x, bid = blockIdx.x;
  int idx, step;
  if (nb >= 256) { idx = bid; step = bid < 128 ? 640 : nb - 128; }
  else { idx = bid; step = nb; }
  for (; idx < 640; idx += step) {
    const bool sample = idx < 128;
    const int q = sample ? idx : idx - 128;
    gla_scan_unit(p, gi, sample, q >> 5, q & 31, smem);
  }
}

DI void phase_gla_post(const Params& p, int gi) {
  const int lane = threadIdx.x & 63;
  const int gw = blockIdx.x * 4 + (threadIdx.x >> 6), nw = gridDim.x * 4;
  const bfr* o0 = (const bfr*)(p.ws + OFF_O);
  const bfr* o1 = o0 + (size_t)NTOK * 1024;
  const bfr* gg = (const bfr*)(p.ws + OFF_PROJ + PJ_GG);
  bfr* uo = (bfr*)(p.ws + OFF_U);
  const float4 on = *(const float4*)(p.in[I_GONORM] + gi * 256 + lane * 4);
  for (int row = gw; row < NTOK; row += nw) {
#pragma unroll
    for (int hd = 0; hd < 4; ++hd) {
      size_t idx = (size_t)row * 1024 + hd * 256 + lane * 4;
      uint2 a = *(const uint2*)(o0 + idx), b = *(const uint2*)(o1 + idx), g = *(const uint2*)(gg + idx);
      float v0 = bf2f(a.x & 0xffff) + bf2f(b.x & 0xffff), v1 = bf2f(a.x >> 16) + bf2f(b.x >> 16);
      float v2 = bf2f(a.y & 0xffff) + bf2f(b.y & 0xffff), v3 = bf2f(a.y >> 16) + bf2f(b.y >> 16);
      float ss = wave_sum(v0 * v0 + v1 * v1 + v2 * v2 + v3 * v3);
      float rstd = rsqrtf(ss * (1.f / 256.f) + EPSN);
      float r0 = v0 * rstd * on.x * bf2f(g.x & 0xffff), r1 = v1 * rstd * on.y * bf2f(g.x >> 16);
      float r2 = v2 * rstd * on.z * bf2f(g.y & 0xffff), r3 = v3 * rstd * on.w * bf2f(g.y >> 16);
      *(uint2*)(uo + idx) = make_uint2(pack2(r0, r1), pack2(r2, r3));
    }
  }
}

DI void phase_out_proj(const Params& p, int l, const bfr* Bt, unsigned char* smem) {
  const bfr* A = (const bfr*)(p.ws + OFF_U);
  const float* mod = (const float*)(p.ws + OFF_MOD) + (size_t)l * 5 * 3072;
  float* sC = (float*)smem;
  const int tid = threadIdx.x;
  for (TileIter ti(8); ti.valid(); ti.next()) {
    const int mt = ti.mt(), nt = ti.nt(), m0 = mt * 128, n0 = nt * 128;
    f32x16 acc[2][2];
    gemm_core(A, Bt, 1024, m0, n0, smem, acc);
    stage_acc(acc, sC);
    __syncthreads();
#pragma unroll 4
    for (int it = 0; it < 16; ++it) {
      int idx = it * 256 + tid, row = idx >> 5, c4 = (idx & 31) * 4;
      float4 v = *(const float4*)(sC + row * 132 + c4);
      int grow = m0 + row, col = n0 + c4;
      float4 xo = *(const float4*)(xrow_ptr(p, l, grow) + col);
      float4 gt = *(const float4*)(mod + modrow(grow) * 3072 + 2048 + col);
      float4 o = make_float4(xo.x + gt.x * v.x, xo.y + gt.y * v.y, xo.z + gt.z * v.z, xo.w + gt.w * v.w);
      *(float4*)(p.out + (size_t)grow * DM + col) = o;
    }
    __syncthreads();
  }
}

DI void phase_att_in(const Params& p, int ai, unsigned char* smem) {
  const bfr* A = (const bfr*)(p.ws + OFF_H);
  const bfr* Bt = (const bfr*)(p.ws + OFF_WT_ATT_IN) + (size_t)ai * ATT_N * 1024;
  bfr* aq = (bfr*)(p.ws + OFF_PROJ + PJ_AQ);
  bfr* ag = (bfr*)(p.ws + OFF_PROJ + PJ_AG);
  bfr* akp = (bfr*)(p.ws + OFF_PROJ + PJ_AKP);
  bfr* avpt = (bfr*)(p.ws + OFF_PROJ + PJ_AVPT);
  bfr* ks = (bfr*)(p.ws + OFF_KS);
  bfr* vst = (bfr*)(p.ws + OFF_VST);
  const float* rc = (const float*)(p.ws + OFF_ROPE);
  const float* rs = rc + 64 * 32;
  const float* qn = p.in[I_AQN] + ai * 128;
  const float* kn = p.in[I_AKN] + ai * 128;
  float* sC = (float*)smem;
  const int tid = threadIdx.x;
  constexpr int NT = 20, MT = 64;
  for (TileIter ti(NT); ti.valid(); ti.next()) {
    const int mt = ti.mt(), nt = ti.nt(), m0 = mt * 128, n0 = nt * 128;
    const bool samp = m0 >= NPT;
    f32x16 acc[2][2];
    gemm_core(A, Bt, 1024, m0, n0, smem, acc);
    if (nt == 10 || nt == 11) {
      const int hk = nt - 10;
      stage_acc_t(acc, sC);
      __syncthreads();
      bfr* dst; size_t ldt;
      if (!samp) { int b = m0 >> 8, t0 = m0 & 255; dst = avpt + (size_t)((b * 2 + hk) * 128) * 256 + t0; ldt = 256; }
      else { int b = (m0 - NPT) >> 10, t0 = (m0 - NPT) & 1023; dst = vst + (size_t)(((ai * 4 + b) * 2 + hk) * 128) * 1280 + t0; ldt = 1280; }
#pragma unroll 4
      for (int it = 0; it < 16; ++it) {
        int idx = it * 256 + tid, col = idx >> 5, r4 = (idx & 31) * 4;
        float4 v = *(const float4*)(sC + col * 132 + r4);
        *(uint2*)(dst + (size_t)col * ldt + r4) = make_uint2(pack2(v.x, v.y), pack2(v.z, v.w));
      }
      if (!samp) {
        __syncthreads();
        stage_acc(acc, sC);
        __syncthreads();
        const int b = m0 >> 8, t0 = m0 & 255;
#pragma unroll 4
        for (int it = 0; it < 16; ++it) {
          int idx = it * 256 + tid, row = idx >> 5, c4 = (idx & 31) * 4;
          float4 v = *(const float4*)(sC + row * 132 + c4);
          *(float4*)(p.out + OUT_CV + ((((size_t)b * 2 + ai) * 256 + t0 + row) * 2 + hk) * 128 + c4) = v;
        }
      }
    } else {
      stage_acc(acc, sC);
      __syncthreads();
#pragma unroll 2
      for (int it = 0; it < 16; ++it) {
        int idx = it * 256 + tid, row = idx >> 5, c4 = (idx & 31) * 4;
        float4 v = *(const float4*)(sC + row * 132 + c4);
        const int grow = m0 + row;
        if (nt >= 12) {
          *(uint2*)(ag + (size_t)grow * 1024 + (n0 - 1536) + c4) =
              make_uint2(pack2(siluf(v.x), siluf(v.y)), pack2(siluf(v.z), siluf(v.w)));
        } else {
          float ss = half_sum(v.x * v.x + v.y * v.y + v.z * v.z + v.w * v.w);
          const float rstd = rsqrtf(ss * (1.f / 128.f) + EPSN);
          const float* wn = nt < 8 ? qn : kn;
          float4 wv = *(const float4*)(wn + c4);
          float4 xn = make_float4(v.x * rstd * wv.x, v.y * rstd * wv.y, v.z * rstd * wv.z, v.w * rstd * wv.w);
          float4 o = xn;
          if (samp) {
            const int cp = c4 ^ 32;
            float4 pv = *(const float4*)(sC + row * 132 + cp);
            float4 pw = *(const float4*)(wn + cp);
            float4 pn = make_float4(pv.x * rstd * pw.x, pv.y * rstd * pw.y, pv.z * rstd * pw.z, pv.w * rstd * pw.w);
            const int t = (grow - NPT) & 1023;
            const int pos = (c4 < 64) ? (t >> 6) : (t & 63);
            float4 cs = *(const float4*)(rc + pos * 32 + (c4 & 31));
            float4 sn = *(const float4*)(rs + pos * 32 + (c4 & 31));
            const float sg = (c4 & 32) ? 1.f : -1.f;
            o = make_float4(xn.x * cs.x + sg * pn.x * sn.x, xn.y * cs.y + sg * pn.y * sn.y,
                            xn.z * cs.z + sg * pn.z * sn.z, xn.w * cs.w + sg * pn.w * sn.w);
          }
          if (nt < 8) {
            const float s = 0.08838834764831845f * 1.4426950408889634f;
            *(uint2*)(aq + (size_t)grow * 1024 + n0 + c4) = make_uint2(pack2(o.x * s, o.y * s), pack2(o.z * s, o.w * s));
          } else {
            const int hk = nt - 8;
            uint2 ob = make_uint2(pack2(o.x, o.y), pack2(o.z, o.w));
            if (!samp) {
              const int b = grow >> 8, t = grow & 255;
              *(float4*)(p.out + OUT_CK + ((((size_t)b * 2 + ai) * 256 + t) * 2 + hk) * 128 + c4) = o;
              *(uint2*)(akp + (size_t)grow * 256 + hk * 128 + c4) = ob;
            } else {
              const int b = (grow - NPT) >> 10, t = (grow - NPT) & 1023;
              *(uint2*)(ks + ((size_t)(ai * 4 + b) * 1280 + t) * 256 + hk * 128 + c4) = ob;
            }
          }
        }
      }
    }
    __syncthreads();
  }
}

DI void attn_unit(const Params& p, int ai, bool sample, int unit, unsigned char* smem) {
  int b, hkv, qb, ntile, tokq0;
  const bfr* Kb; const bfr* Vb; size_t ldt;
  if (sample) {
    b = unit >> 6; hkv = (unit >> 5) & 1; qb = unit & 31; ntile = 20;
    tokq0 = NPT + b * 1024 + qb * 32;
    Kb = (const bfr*)(p.ws + OFF_KS) + (size_t)(ai * 4 + b) * 1280 * 256 + hkv * 128;
    Vb = (const bfr*)(p.ws + OFF_VST) + (size_t)(((ai * 4 + b) * 2 + hkv) * 128) * 1280; ldt = 1280;
  } else {
    b = unit >> 4; hkv = (unit >> 3) & 1; qb = unit & 7; ntile = 4;
    tokq0 = b * 256 + qb * 32;
    Kb = (const bfr*)(p.ws + OFF_PROJ + PJ_AKP) + (size_t)(b * 256) * 256 + hkv * 128;
    Vb = (const bfr*)(p.ws + OFF_PROJ + PJ_AVPT) + (size_t)((b * 2 + hkv) * 128) * 256; ldt = 256;
  }
  const bfr* aq = (const bfr*)(p.ws + OFF_PROJ + PJ_AQ);
  const bfr* ag = (const bfr*)(p.ws + OFF_PROJ + PJ_AG);
  bfr* uo = (bfr*)(p.ws + OFF_U);
  const int tid = threadIdx.x, lane = tid & 63, w = tid >> 6, r = lane & 31, hh = lane >> 5;
  const int hq = hkv * 4 + w;
  bfr* sK = (bfr*)smem;
  bfr* sV = sK + 2 * 64 * 136;
  bf16x8 qf[8];
#pragma unroll
  for (int kk = 0; kk < 8; ++kk) qf[kk] = *(const bf16x8*)(aq + (size_t)(tokq0 + r) * 1024 + hq * 128 + 16 * kk + 8 * hh);
  f32x16 oacc[4];
#pragma unroll
  for (int a = 0; a < 4; ++a)
#pragma unroll
    for (int i = 0; i < 16; ++i) oacc[a][i] = 0.f;
  float m_run = -INFINITY, l_run = 0.f;
  uint4 rk[4], rv[4];
  const int krow = tid >> 4, kch = (tid & 15) * 8;
  const int vrow = tid >> 3, vch = (tid & 7) * 8;
#pragma unroll
  for (int j = 0; j < 4; ++j) {
    rk[j] = *(const uint4*)(Kb + (size_t)(krow + 16 * j) * 256 + kch);
    rv[j] = *(const uint4*)(Vb + (size_t)(vrow + 32 * j) * ldt + vch);
  }
#pragma unroll
  for (int j = 0; j < 4; ++j) {
    *(uint4*)(sK + (krow + 16 * j) * 136 + kch) = rk[j];
    *(uint4*)(sV + (vrow + 32 * j) * 72 + vch) = rv[j];
  }
  __syncthreads();
  for (int kt = 0; kt < ntile; ++kt) {
    const int cur = kt & 1;
    {
      const int key0 = (kt + 1 < ntile ? kt + 1 : kt) * 64;
#pragma unroll
      for (int j = 0; j < 4; ++j) {
        rk[j] = *(const uint4*)(Kb + (size_t)(key0 + krow + 16 * j) * 256 + kch);
        rv[j] = *(const uint4*)(Vb + (size_t)(vrow + 32 * j) * ldt + key0 + vch);
      }
    }
    const bfr* cK = sK + cur * 64 * 136;
    const bfr* cV = sV + cur * 128 * 72;
    f32x16 sacc[2];
#pragma unroll
    for (int kb = 0; kb < 2; ++kb) {
#pragma unroll
      for (int i = 0; i < 16; ++i) sacc[kb][i] = 0.f;
#pragma unroll
      for (int kk = 0; kk < 8; ++kk) {
        bf16x8 a = *(const bf16x8*)(cK + (32 * kb + r) * 136 + 16 * kk + 8 * hh);
        sacc[kb] = MFMA32(a, qf[kk], sacc[kb]);
      }
    }
    float mt = sacc[0][0];
#pragma unroll
    for (int kb = 0; kb < 2; ++kb)
#pragma unroll
      for (int i = 0; i < 16; ++i) mt = fmaxf(mt, sacc[kb][i]);
    mt = fmaxf(mt, __shfl_xor(mt, 32));
    const float m_new = fmaxf(m_run, mt);
    const float alpha = __builtin_amdgcn_exp2f(m_run - m_new);
    m_run = m_new;
    float ls = 0.f;
#pragma unroll
    for (int kb = 0; kb < 2; ++kb)
#pragma unroll
      for (int i = 0; i < 16; ++i) { float pv = __builtin_amdgcn_exp2f(sacc[kb][i] - m_new); sacc[kb][i] = pv; ls += pv; }
    l_run = l_run * alpha + ls;
#pragma unroll
    for (int a = 0; a < 4; ++a)
#pragma unroll
      for (int i = 0; i < 16; ++i) oacc[a][i] *= alpha;
#pragma unroll
    for (int kb = 0; kb < 2; ++kb)
#pragma unroll
      for (int s2 = 0; s2 < 2; ++s2) {
        unsigned pk[4];
#pragma unroll
        for (int j = 0; j < 4; ++j) pk[j] = pack2(sacc[kb][8 * s2 + 2 * j], sacc[kb][8 * s2 + 2 * j + 1]);
        bf16x8 pb = __builtin_bit_cast(bf16x8, make_uint4(pk[0], pk[1], pk[2], pk[3]));
#pragma unroll
        for (int dvb = 0; dvb < 4; ++dvb) {
          const bfr* vp = cV + (32 * dvb + r) * 72 + 32 * kb + 16 * s2 + 4 * hh;
          uint2 lo = *(const uint2*)vp, hi = *(const uint2*)(vp + 8);
          bf16x8 av = __builtin_bit_cast(bf16x8, make_uint4(lo.x, lo.y, hi.x, hi.y));
          oacc[dvb] = MFMA32(av, pb, oacc[dvb]);
        }
      }
    {
      bfr* nK = sK + (cur ^ 1) * 64 * 136;
      bfr* nV = sV + (cur ^ 1) * 128 * 72;
#pragma unroll
      for (int j = 0; j < 4; ++j) {
        *(uint4*)(nK + (krow + 16 * j) * 136 + kch) = rk[j];
        *(uint4*)(nV + (vrow + 32 * j) * 72 + vch) = rv[j];
      }
    }
    __syncthreads();
  }
  const float lt = l_run + __shfl_xor(l_run, 32);
  const float inv = 1.f / lt;
#pragma unroll
  for (int dvb = 0; dvb < 4; ++dvb)
#pragma unroll
    for (int g = 0; g < 4; ++g) {
      size_t idx = (size_t)(tokq0 + r) * 1024 + hq * 128 + 32 * dvb + 8 * g + 4 * hh;
      uint2 gv = *(const uint2*)(ag + idx);
      float o0 = oacc[dvb][4 * g] * inv * bf2f(gv.x & 0xffff), o1 = oacc[dvb][4 * g + 1] * inv * bf2f(gv.x >> 16);
      float o2 = oacc[dvb][4 * g + 2] * inv * bf2f(gv.y & 0xffff), o3 = oacc[dvb][4 * g + 3] * inv * bf2f(gv.y >> 16);
      *(uint2*)(uo + idx) = make_uint2(pack2(o0, o1), pack2(o2, o3));
    }
}
DI void phase_attn(const Params& p, int ai, unsigned char* smem) {
  const int nb = gridDim.x, bid = blockIdx.x;
  int idx, step;
  if (nb >= 512) { idx = bid; step = bid < 256 ? 512 : nb - 256; }
  else { idx = bid; step = nb; }
  for (; idx < 512; idx += step) {
    const bool sample = idx < 256;
    attn_unit(p, ai, sample, sample ? idx : idx - 256, smem);
  }
}


#define XB_TMO      128
#define XB_XCNT(j)  (256  + 64 * (j))
#define XB_XSUB(j)  (1280 + 64 * (j))
#define XB_XGEN(j)  (2304 + 64 * (j))
#define XB_TOP      3328
#define XB_TOPGEN   3392
#define XCD_BAR_WORDS 3456
#define XB_SPIN_CAP (1u << 18)
#define LAS __attribute__((address_space(3)))
DI unsigned xb_ld(unsigned* p) { return __hip_atomic_load(p, __ATOMIC_RELAXED, __HIP_MEMORY_SCOPE_AGENT); }
DI unsigned xb_add(unsigned* p, unsigned v) { return __hip_atomic_fetch_add(p, v, __ATOMIC_RELAXED, __HIP_MEMORY_SCOPE_AGENT); }
DI unsigned xb_xcc_id() { return (unsigned)__builtin_amdgcn_s_getreg((3 << 11) | 20) & 0xFu; }
#define XB_SPIN(cond, bar) do { unsigned _sp = 0; while (cond) { __builtin_amdgcn_s_sleep(1); \
    if ((++_sp & 255u) == 0u) { if (xb_ld(&(bar)[XB_TMO])) break; if (_sp > XB_SPIN_CAP) { atomicAdd(&(bar)[XB_TMO], 1u); break; } } } } while (0)
struct XcdBarrier { unsigned* bar; unsigned x; volatile LAS unsigned* st; };
DI XcdBarrier xcd_barrier_post(unsigned* bar, volatile LAS unsigned* st) {
  XcdBarrier b; b.bar = bar; b.x = xb_xcc_id(); b.st = st;
  if (threadIdx.x == 0) (void)xb_add(&bar[XB_XCNT(b.x)], 1u);
  return b;
}
DI void xcd_barrier_complete(unsigned* bar, unsigned x, unsigned& nloc, unsigned& nx) {
  const unsigned G = gridDim.x * gridDim.y * gridDim.z;
  unsigned sum, cnt, mine, sp = 0u;
  for (;;) {
    sum = 0u; cnt = 0u; mine = 0u;
#pragma unroll
    for (unsigned j = 0; j < 16; ++j) { const unsigned c = xb_ld(&bar[XB_XCNT(j)]); sum += c; cnt += (c > 0u) ? 1u : 0u; mine = (j == x) ? c : mine; }
    if (sum == G) break;
    __builtin_amdgcn_s_sleep(1);
    if ((++sp & 255u) == 0u) { if (xb_ld(&bar[XB_TMO])) break; if (sp > XB_SPIN_CAP) { atomicAdd(&bar[XB_TMO], 1u); break; } }
  }
  nloc = mine > 0u ? mine : 1u; nx = cnt > 0u ? cnt : 1u;
}
DI void xcd_barrier(const XcdBarrier& b) {
  asm volatile("s_waitcnt vmcnt(0)" ::: "memory");
  __syncthreads();
  if (threadIdx.x == 0) {
    unsigned* bar = b.bar;
    __builtin_amdgcn_s_waitcnt(0);
    unsigned nloc = b.st[0], nx = b.st[1];
    if (nloc == 0u) { xcd_barrier_complete(bar, b.x, nloc, nx); b.st[0] = nloc; b.st[1] = nx; }
    const unsigned old = xb_add(&bar[XB_XSUB(b.x)], 1u);
    const unsigned gen = old / nloc;
    if (old + 1u == (gen + 1u) * nloc) {
      __builtin_amdgcn_fence(__ATOMIC_RELEASE, "agent");
      asm volatile("s_waitcnt vmcnt(0)" ::: "memory");
      const unsigned og = xb_add(&bar[XB_TOP], 1u);
      const unsigned tg = og / nx;
      if (og + 1u == (tg + 1u) * nx) xb_add(&bar[XB_TOPGEN], 1u);
      else XB_SPIN(xb_ld(&bar[XB_TOPGEN]) == tg, bar);
      __builtin_amdgcn_fence(__ATOMIC_ACQUIRE, "agent");
      xb_add(&bar[XB_XGEN(b.x)], 1u);
      asm volatile("s_waitcnt vmcnt(0)" ::: "memory");
    } else {
      XB_SPIN(xb_ld(&bar[XB_XGEN(b.x)]) == gen, bar);
      __builtin_amdgcn_fence(__ATOMIC_ACQUIRE, "agent");
      asm volatile("s_waitcnt vmcnt(0)" ::: "memory");
    }
  }
  __syncthreads();
}

#ifndef REP_P0
#define REP_P0 1
#endif
#ifndef REP_SMALL
#define REP_SMALL 1
#endif
#ifndef REP_GIN
#define REP_GIN 1
#endif
#ifndef REP_AIN
#define REP_AIN 1
#endif
#ifndef REP_SCAN
#define REP_SCAN 1
#endif
#ifndef REP_ATT
#define REP_ATT 1
#endif
#ifndef REP_OUT0
#define REP_OUT0 1
#endif
#ifndef REP_SYNC
#define REP_SYNC 1
#endif
#define SYNC() do { xcd_barrier(xb); if (REP_SYNC >= 2) xcd_barrier(xb); if (REP_SYNC >= 3) xcd_barrier(xb); } while (0)
#define RUN(n, stmt) do { stmt; SYNC(); if ((n) >= 2) { stmt; SYNC(); } } while (0)

__global__ void __launch_bounds__(256, 2) fwd_megakernel(Params p) {
  __shared__ __attribute__((aligned(16))) unsigned char smem[SMEM_BYTES];
  __shared__ uint4 xb_words;
  cg::grid_group grid = cg::this_grid();
  if (p.never) grid.sync();
  if (threadIdx.x == 0) xb_words = make_uint4(0u, 0u, 0u, 0u);
  __syncthreads();
  XcdBarrier xb = xcd_barrier_post((unsigned*)(p.ws + OFF_BAR), (volatile LAS unsigned*)&xb_words);
  RUN(REP_P0, phase0(p, smem));
  RUN(REP_SMALL, phase_norm(p, 0));
  RUN(REP_GIN, phase_gla_in(p, 0, smem));
  RUN(REP_SMALL, phase_gla_prep(p, 0, smem));
  RUN(REP_SCAN, phase_gla_scan(p, 0, smem));
  RUN(REP_SMALL, phase_gla_post(p, 0));
  RUN(REP_OUT0, phase_out_proj(p, 0, (const bfr*)(p.ws + OFF_WT_GLA_OUT), smem));
  RUN(REP_SMALL, phase_norm(p, 1));
  RUN(REP_AIN, phase_att_in(p, 0, smem));
  RUN(REP_ATT, phase_attn(p, 0, smem));
  phase_out_proj(p, 1, (const bfr*)(p.ws + OFF_WT_ATT_OUT), smem); SYNC();
  RUN(REP_SMALL, phase_norm(p, 2));
  RUN(REP_GIN, phase_gla_in(p, 1, smem));
  RUN(REP_SMALL, phase_gla_prep(p, 1, smem));
  RUN(REP_SCAN, phase_gla_scan(p, 1, smem));
  RUN(REP_SMALL, phase_gla_post(p, 1));
  phase_out_proj(p, 2, (const bfr*)(p.ws + OFF_WT_GLA_OUT) + (size_t)1024 * 1024, smem); SYNC();
  RUN(REP_SMALL, phase_norm(p, 3));
  RUN(REP_AIN, phase_att_in(p, 1, smem));
  RUN(REP_ATT, phase_attn(p, 1, smem));
  phase_out_proj(p, 3, (const bfr*)(p.ws + OFF_WT_ATT_OUT) + (size_t)1024 * 1024, smem);
}

extern "C" void kernel_launch(void* const* d_in, const int* in_sizes, int n_in, void* d_out, int out_size, void* d_ws,
                              size_t ws_size, hipStream_t stream) {
  static int grid_blocks = 0;
  if (!grid_blocks) {
    int dev = 0, cus = 0, per_cu = 0;
    hipGetDevice(&dev);
    hipDeviceGetAttribute(&cus, hipDeviceAttributeMultiprocessorCount, dev);
    hipOccupancyMaxActiveBlocksPerMultiprocessor(&per_cu, fwd_megakernel, 256, 0);
    if (per_cu > 2) per_cu = 2;
    if (per_cu < 1) per_cu = 1;
    grid_blocks = cus * per_cu;
  }
  Params p{};
  for (int i = 0; i < 20; ++i) p.in[i] = (const float*)d_in[i];
  p.out = (float*)d_out;
  p.ws = (unsigned char*)d_ws;
  p.never = 0;
  p.pad = 0;
  hipMemsetAsync((unsigned char*)d_ws + OFF_BAR, 0, 3456 * 4, stream);
  void* args[] = {&p};
  hipError_t e = hipLaunchCooperativeKernel((void*)fwd_megakernel, dim3(grid_blocks), dim3(256), args, 0, stream);
  if (e != hipSuccess) fprintf(stderr, "cooperative launch failed: %s (grid %d)\n", hipGetErrorString(e), grid_blocks);
}
```

```cpp
#include <hip/hip_runtime.h>
#include <hip/hip_cooperative_groups.h>
#include <stdint.h>
#include <stdio.h>
namespace cg = cooperative_groups;

typedef unsigned short bfr;
using bf16x8 = __attribute__((ext_vector_type(8))) short;
using bf16x4 = __attribute__((ext_vector_type(4))) short;
using f32x16 = __attribute__((ext_vector_type(16))) float;
using f32x4 = __attribute__((ext_vector_type(4))) float;
#define DI __device__ __forceinline__
#define MFMA32(a, b, c) __builtin_amdgcn_mfma_f32_32x32x16_bf16((a), (b), (c), 0, 0, 0)

constexpr int NTOK = 8192;
constexpr int DM = 1024;
constexpr int NPT = 4096;
constexpr float EPSN = 1e-6f;
constexpr int GLA_NPAD = 3200;
constexpr int ATT_N = 2560;

constexpr size_t OFF_WT_GLA_IN = 0;
constexpr size_t OFF_WT_GLA_OUT = OFF_WT_GLA_IN + 2ull * GLA_NPAD * 1024 * 2;
constexpr size_t OFF_WT_ATT_IN = OFF_WT_GLA_OUT + 2ull * 1024 * 1024 * 2;
constexpr size_t OFF_WT_ATT_OUT = OFF_WT_ATT_IN + 2ull * ATT_N * 1024 * 2;
constexpr size_t OFF_MOD = OFF_WT_ATT_OUT + 2ull * 1024 * 1024 * 2;
constexpr size_t OFF_ROPE = OFF_MOD + 4ull * 5 * 3072 * 4;
constexpr size_t OFF_H = OFF_ROPE + 2ull * 64 * 32 * 4;
constexpr size_t OFF_PROJ = OFF_H + (size_t)NTOK * 1024 * 2;
constexpr size_t OFF_TBUF = OFF_PROJ + (size_t)NTOK * 3072 * 2;
constexpr size_t OFF_QE = OFF_TBUF + (size_t)NTOK * 32 * 4;
constexpr size_t OFF_KDT = OFF_QE + 2ull * NTOK * 512 * 2;
constexpr size_t OFF_ABUF = OFF_KDT + 2ull * NTOK * 512 * 2;
constexpr size_t OFF_ELAST = OFF_ABUF + 1024ull * 64 * 64 * 2;
constexpr size_t OFF_O = OFF_ELAST + 1024ull * 128 * 4;
constexpr size_t OFF_U = OFF_O + 2ull * NTOK * 1024 * 2;
constexpr size_t OFF_KS = OFF_U + (size_t)NTOK * 1024 * 2;
constexpr size_t OFF_VST = OFF_KS + 2ull * 4 * 1280 * 256 * 2;
constexpr size_t OFF_BAR = OFF_VST + 2ull * 4 * 1280 * 256 * 2;
constexpr size_t WS_END = OFF_BAR + 3456 * 4;
constexpr size_t PJ_GQ = 0;
constexpr size_t PJ_GK = (size_t)NTOK * 512 * 2;
constexpr size_t PJ_GG = (size_t)NTOK * 1024 * 2;
constexpr size_t PJ_GVT = (size_t)NTOK * 2048 * 2;
constexpr size_t PJ_AQ = 0;
constexpr size_t PJ_AG = (size_t)NTOK * 1024 * 2;
constexpr size_t PJ_AKP = (size_t)NTOK * 2048 * 2;
constexpr size_t PJ_AVPT = PJ_AKP + 4096ull * 256 * 2;

constexpr size_t OUT_STATE = 2ull * 4096 * 1024;
constexpr size_t OUT_CK = OUT_STATE + 16ull * 2 * 2 * 4 * 128 * 256;
constexpr size_t OUT_CV = OUT_CK + 16ull * 2 * 256 * 2 * 128;

constexpr int SMEM_BYTES = 73728;

struct Params {
  const float* in[20];
  float* out;
  unsigned char* ws;
  int never;
  int pad;
};
enum { I_XP = 0, I_XS, I_STATE, I_CK, I_CV, I_C, I_CCTX, I_NORMG, I_WADA, I_BADA, I_GWIN, I_GWA1, I_GWA2, I_GBA,
       I_GONORM, I_GWOUT, I_AWIN, I_AQN, I_AKN, I_AWOUT };

typedef __bf16 bf16v2 __attribute__((ext_vector_type(2)));
typedef float f32v2 __attribute__((ext_vector_type(2)));
DI unsigned pack2(float a, float b) {
  f32v2 v = {a, b};
  return __builtin_bit_cast(unsigned, __builtin_convertvector(v, bf16v2));
}
DI bfr f2bf(float x) { return (bfr)(pack2(x, x) & 0xffffu); }
DI float bf2f(bfr b) { return __uint_as_float(((unsigned)b) << 16); }
DI int crow(int reg, int h) { return (reg & 3) + 8 * (reg >> 2) + 4 * h; }
DI float siluf(float x) { return x * __builtin_amdgcn_rcpf(1.f + __expf(-x)); }
DI int modrow(int row) { return row < NPT ? 0 : 1 + ((row - NPT) >> 10); }
DI const float* xrow_ptr(const Params& p, int l, int row) {
  if (l == 0) return row < NPT ? p.in[I_XP] + (size_t)row * DM : p.in[I_XS] + (size_t)(row - NPT) * DM;
  return p.out + (size_t)row * DM;
}
DI float wave_sum(float v) {
#pragma unroll
  for (int o = 32; o >= 1; o >>= 1) v += __shfl_xor(v, o);
  return v;
}
DI float half_sum(float v) {
#pragma unroll
  for (int o = 16; o >= 1; o >>= 1) v += __shfl_xor(v, o);
  return v;
}

DI void transpose_tile(const float* __restrict__ src, int src_ld, int k0, int n0, int ncols, bfr* __restrict__ dst,
                       size_t dst_ld, unsigned char* smem) {
  float* tile = (float*)smem;
  const int tid = threadIdx.x;
  const int c4 = (tid & 15) * 4, kr = tid >> 4;
#pragma unroll
  for (int j = 0; j < 4; ++j) {
    int k = kr + 16 * j;
    if (c4 < ncols) {
      float4 v = *(const float4*)(src + (size_t)(k0 + k) * src_ld + n0 + c4);
      tile[k * 65 + c4] = v.x; tile[k * 65 + c4 + 1] = v.y; tile[k * 65 + c4 + 2] = v.z; tile[k * 65 + c4 + 3] = v.w;
    }
  }
  __syncthreads();
  const int n = tid >> 2, kq = (tid & 3) * 16;
  if (n < ncols) {
    unsigned pk[8];
#pragma unroll
    for (int j = 0; j < 8; ++j) pk[j] = pack2(tile[(kq + 2 * j) * 65 + n], tile[(kq + 2 * j + 1) * 65 + n]);
    uint4* d = (uint4*)(dst + (size_t)(n0 + n) * dst_ld + k0 + kq);
    d[0] = make_uint4(pk[0], pk[1], pk[2], pk[3]);
    d[1] = make_uint4(pk[4], pk[5], pk[6], pk[7]);
  }
  __syncthreads();
}

DI void mod_unit(const Params& p, int unit, unsigned char* smem) {
  const int l = unit / 96, n0 = (unit % 96) * 32;
  float* sil = (float*)smem;
  float* red = sil + 5 * 1024;
  const int tid = threadIdx.x;
  for (int e = tid; e < 5 * 1024; e += 256) {
    int r = e >> 10, k = e & 1023;
    float cv = r == 0 ? p.in[I_CCTX][k] : p.in[I_C][(r - 1) * 1024 + k];
    sil[e] = cv / (1.f + expf(-cv));
  }
  __syncthreads();
  const int kg = tid >> 5, cn = tid & 31;
  const float* w = p.in[I_WADA] + (size_t)l * 1024 * 3072 + n0 + cn;
  float a0 = 0, a1 = 0, a2 = 0, a3 = 0, a4 = 0;
#pragma unroll 8
  for (int kk = 0; kk < 128; ++kk) {
    int k = kg * 128 + kk;
    float wv = w[(size_t)k * 3072];
    a0 += sil[k] * wv; a1 += sil[1024 + k] * wv; a2 += sil[2048 + k] * wv; a3 += sil[3072 + k] * wv; a4 += sil[4096 + k] * wv;
  }
  red[(kg * 5 + 0) * 32 + cn] = a0; red[(kg * 5 + 1) * 32 + cn] = a1; red[(kg * 5 + 2) * 32 + cn] = a2;
  red[(kg * 5 + 3) * 32 + cn] = a3; red[(kg * 5 + 4) * 32 + cn] = a4;
  __syncthreads();
  if (tid < 160) {
    int r = tid >> 5;
    float s = p.in[I_BADA][l * 3072 + n0 + cn];
#pragma unroll
    for (int g = 0; g < 8; ++g) s += red[(g * 5 + r) * 32 + cn];
    ((float*)(p.ws + OFF_MOD))[(l * 5 + r) * 3072 + n0 + cn] = s;
  }
  __syncthreads();
}

DI void phase0(const Params& p, unsigned char* smem) {
  constexpr int U_MOD = 384;
  constexpr int U_GIN = 2 * 16 * 48;
  constexpr int U_GA1 = 2 * 2 * 16;
  constexpr int U_GZ = 2;
  constexpr int U_GOUT = 2 * 16 * 16;
  constexpr int U_AIN = 2 * 16 * 40;
  constexpr int U_AOUT = 2 * 16 * 16;
  constexpr int U_ROPE = 1;
  constexpr int U_CK = 64;
  constexpr int U_CV = 4 * 2 * 16;
  constexpr int U_TOTAL = U_MOD + U_GIN + U_GA1 + U_GZ + U_GOUT + U_AIN + U_AOUT + U_ROPE + U_CK + U_CV;
  bfr* wt_gin = (bfr*)(p.ws + OFF_WT_GLA_IN);
  bfr* wt_gout = (bfr*)(p.ws + OFF_WT_GLA_OUT);
  bfr* wt_ain = (bfr*)(p.ws + OFF_WT_ATT_IN);
  bfr* wt_aout = (bfr*)(p.ws + OFF_WT_ATT_OUT);
  const int tid = threadIdx.x;
  for (int unit = blockIdx.x; unit < U_TOTAL; unit += gridDim.x) {
    int u = unit;
    if (u < U_MOD) { mod_unit(p, u, smem); continue; }
    u -= U_MOD;
    if (u < U_GIN) {
      int i = u / 768, r = u % 768, kt = r / 48, nt = r % 48;
      transpose_tile(p.in[I_GWIN] + (size_t)i * 1024 * 3072, 3072, kt * 64, nt * 64, 64,
                     wt_gin + (size_t)i * GLA_NPAD * 1024, 1024, smem);
      continue;
    }
    u -= U_GIN;
    if (u < U_GA1) {
      int id = u / 16, kt = u % 16;
      int i = id >> 1, d = id & 1;
      transpose_tile(p.in[I_GWA1] + (size_t)id * 1024 * 16, 16, kt * 64, 0, 16,
                     wt_gin + ((size_t)i * GLA_NPAD + 3072 + d * 16) * 1024, 1024, smem);
      continue;
    }
    u -= U_GA1;
    if (u < U_GZ) {
      uint4* z = (uint4*)(wt_gin + ((size_t)u * GLA_NPAD + 3104) * 1024);
      for (int e = tid; e < 96 * 1024 / 8; e += 256) z[e] = make_uint4(0, 0, 0, 0);
      continue;
    }
    u -= U_GZ;
    if (u < U_GOUT) {
      int i = u / 256, r = u % 256, kt = r / 16, nt = r % 16;
      transpose_tile(p.in[I_GWOUT] + (size_t)i * 1024 * 1024, 1024, kt * 64, nt * 64, 64,
                     wt_gout + (size_t)i * 1024 * 1024, 1024, smem);
      continue;
    }
    u -= U_GOUT;
    if (u < U_AIN) {
      int i = u / 640, r = u % 640, kt = r / 40, nt = r % 40;
      transpose_tile(p.in[I_AWIN] + (size_t)i * 1024 * ATT_N, ATT_N, kt * 64, nt * 64, 64,
                     wt_ain + (size_t)i * ATT_N * 1024, 1024, smem);
      continue;
    }
    u -= U_AIN;
    if (u < U_AOUT) {
      int i = u / 256, r = u % 256, kt = r / 16, nt = r % 16;
      transpose_tile(p.in[I_AWOUT] + (size_t)i * 1024 * 1024, 1024, kt * 64, nt * 64, 64,
                     wt_aout + (size_t)i * 1024 * 1024, 1024, smem);
      continue;
    }
    u -= U_AOUT;
    if (u < U_ROPE) {
      float* rc = (float*)(p.ws + OFF_ROPE);
      float* rs = rc + 64 * 32;
      for (int e = tid; e < 2048; e += 256) {
        int pos = e >> 5, f = e & 31;
        float fr = powf(10000.0f, -(float)f / 32.0f);
        float ang = (float)pos * fr;
        rc[e] = cosf(ang);
        rs[e] = sinf(ang);
      }
      continue;
    }
    u -= U_ROPE;
    if (u < U_CK) {
      bfr* ks = (bfr*)(p.ws + OFF_KS);
      for (int e = tid; e < 2048; e += 256) {
        size_t idx = (size_t)u * 8192 + (size_t)e * 4;
        int c = idx & 255, t = (idx >> 8) & 255, i = (idx >> 16) & 1, b = (int)(idx >> 17);
        float4 v = *(const float4*)(p.in[I_CK] + idx);
        uint2 o = make_uint2(pack2(v.x, v.y), pack2(v.z, v.w));
        *(uint2*)(ks + ((size_t)(i * 4 + b) * 1280 + 1024 + t) * 256 + c) = o;
      }
      continue;
    }
    u -= U_CK;
    {
      int bi = u / 16, r = u % 16, kt = r / 4, nt = r % 4;
      int b = bi >> 1, i = bi & 1;
      transpose_tile(p.in[I_CV] + (size_t)bi * 256 * 256, 256, kt * 64, nt * 64, 64,
                     (bfr*)(p.ws + OFF_VST) + (size_t)(i * 4 + b) * 256 * 1280 + 1024, 1280, smem);
    }
  }
}

DI void phase_norm(const Params& p, int l) {
  const int lane = threadIdx.x & 63;
  const int gw = blockIdx.x * 4 + (threadIdx.x >> 6), nw = gridDim.x * 4;
  const float* g = p.in[I_NORMG] + l * DM;
  const float* mod = (const float*)(p.ws + OFF_MOD) + (size_t)l * 5 * 3072;
  bfr* h = (bfr*)(p.ws + OFF_H);
  for (int row = gw; row < NTOK; row += nw) {
    const float* x = xrow_ptr(p, l, row);
    float4 v[4];
    float ss = 0.f;
#pragma unroll
    for (int j = 0; j < 4; ++j) {
      v[j] = *(const float4*)(x + lane * 4 + 256 * j);
      ss += v[j].x * v[j].x + v[j].y * v[j].y + v[j].z * v[j].z + v[j].w * v[j].w;
    }
    ss = wave_sum(ss);
    const float rstd = rsqrtf(ss * (1.f / 1024.f) + EPSN);
    const float* mr = mod + modrow(row) * 3072;
#pragma unroll
    for (int j = 0; j < 4; ++j) {
      int c = lane * 4 + 256 * j;
      float4 gg = *(const float4*)(g + c);
      float4 sh = *(const float4*)(mr + c);
      float4 sc = *(const float4*)(mr + 1024 + c);
      float o0 = v[j].x * rstd * gg.x * (1.f + sc.x) + sh.x;
      float o1 = v[j].y * rstd * gg.y * (1.f + sc.y) + sh.y;
      float o2 = v[j].z * rstd * gg.z * (1.f + sc.z) + sh.z;
      float o3 = v[j].w * rstd * gg.w * (1.f + sc.w) + sh.w;
      *(uint2*)(h + (size_t)row * DM + c) = make_uint2(pack2(o0, o1), pack2(o2, o3));
    }
  }
}

DI void gemm_core(const bfr* __restrict__ A, const bfr* __restrict__ Bt, int K, int m0, int n0, unsigned char* smem,
                  f32x16 (&acc)[2][2]) {
  unsigned char* sA = smem;
  unsigned char* sB = smem + 32768;
  const int tid = threadIdx.x, lane = tid & 63, w = tid >> 6, wm = w >> 1, wn = w & 1, r = lane & 31, hh = lane >> 5;
  const bfr* gA = A + (size_t)m0 * K;
  const bfr* gB = Bt + (size_t)n0 * K;
  int goff[4];
#pragma unroll
  for (int i = 0; i < 4; ++i) {
    const int row = (i * 4 + w) * 8 + (lane >> 3);
    goff[i] = row * K + (((lane & 7) ^ ((row >> 1) & 7)) << 3);
  }
#pragma unroll
  for (int a = 0; a < 2; ++a)
#pragma unroll
    for (int b = 0; b < 2; ++b)
#pragma unroll
      for (int i = 0; i < 16; ++i) acc[a][b][i] = 0.f;
#define GEMM_STAGE(buf, kt)                                                                                         \
  do {                                                                                                              \
    _Pragma("unroll") for (int i = 0; i < 4; ++i) {                                                                 \
      __builtin_amdgcn_global_load_lds((const unsigned*)(gA + goff[i] + (kt) * 64),                                 \
                                       (unsigned*)(sA + (buf) * 16384 + (i * 4 + w) * 1024), 16, 0, 0);            \
      __builtin_amdgcn_global_load_lds((const unsigned*)(gB + goff[i] + (kt) * 64),                                 \
                                       (unsigned*)(sB + (buf) * 16384 + (i * 4 + w) * 1024), 16, 0, 0);            \
    }                                                                                                               \
  } while (0)
  GEMM_STAGE(0, 0);
  asm volatile("s_waitcnt vmcnt(0)" ::: "memory");
  __syncthreads();
  const int swz = (r >> 1) & 7;
  const int arow = (64 * wm + r) * 128, brow = (64 * wn + r) * 128;
  const int KT = K >> 6;
  for (int kt = 0; kt < KT; ++kt) {
    const int cur = kt & 1;
    if (kt + 1 < KT) GEMM_STAGE(cur ^ 1, kt + 1);
    const unsigned char* cA = sA + cur * 16384 + arow;
    const unsigned char* cB = sB + cur * 16384 + brow;
#pragma unroll
    for (int kk = 0; kk < 4; ++kk) {
      const int co = ((2 * kk + hh) ^ swz) << 4;
      bf16x8 a[2], b[2];
#pragma unroll
      for (int mb = 0; mb < 2; ++mb) a[mb] = *(const bf16x8*)(cA + mb * 4096 + co);
#pragma unroll
      for (int nb = 0; nb < 2; ++nb) b[nb] = *(const bf16x8*)(cB + nb * 4096 + co);
#pragma unroll
      for (int mb = 0; mb < 2; ++mb)
#pragma unroll
        for (int nb = 0; nb < 2; ++nb) acc[mb][nb] = MFMA32(a[mb], b[nb], acc[mb][nb]);
    }
    asm volatile("s_waitcnt vmcnt(0)" ::: "memory");
    __syncthreads();
  }
#undef GEMM_STAGE
}
DI void stage_acc(const f32x16 (&acc)[2][2], float* sC) {
  const int lane = threadIdx.x & 63, w = threadIdx.x >> 6, wm = w >> 1, wn = w & 1, r = lane & 31, hh = lane >> 5;
#pragma unroll
  for (int mb = 0; mb < 2; ++mb)
#pragma unroll
    for (int nb = 0; nb < 2; ++nb)
#pragma unroll
      for (int i = 0; i < 16; ++i) sC[(64 * wm + 32 * mb + crow(i, hh)) * 132 + 64 * wn + 32 * nb + r] = acc[mb][nb][i];
}
DI void stage_acc_t(const f32x16 (&acc)[2][2], float* sC) {
  const int lane = threadIdx.x & 63, w = threadIdx.x >> 6, wm = w >> 1, wn = w & 1, r = lane & 31, hh = lane >> 5;
#pragma unroll
  for (int mb = 0; mb < 2; ++mb)
#pragma unroll
    for (int nb = 0; nb < 2; ++nb)
#pragma unroll
      for (int g = 0; g < 4; ++g) {
        float4 v = make_float4(acc[mb][nb][4 * g], acc[mb][nb][4 * g + 1], acc[mb][nb][4 * g + 2], acc[mb][nb][4 * g + 3]);
        *(float4*)(sC + (64 * wn + 32 * nb + r) * 132 + 64 * wm + 32 * mb + 8 * g + 4 * hh) = v;
      }
}

struct TileIter {
  int lt, step, nl, mbase, mmask, mshift;
  DI TileIter(int NT) {
    const int nblk = gridDim.x, bid = blockIdx.x;
    if ((nblk & 7) == 0) { mbase = (bid & 7) * 8; lt = bid >> 3; step = nblk >> 3; nl = 8 * NT; mmask = 7; mshift = 3; }
    else { mbase = 0; lt = bid; step = nblk; nl = 64 * NT; mmask = 63; mshift = 6; }
  }
  DI bool valid() const { return lt < nl; }
  DI int mt() const { return mbase + (lt & mmask); }
  DI int nt() const { return lt >> mshift; }
  DI void next() { lt += step; }
};

DI void phase_gla_in(const Params& p, int gi, unsigned char* smem) {
  const bfr* A = (const bfr*)(p.ws + OFF_H);
  const bfr* Bt = (const bfr*)(p.ws + OFF_WT_GLA_IN) + (size_t)gi * GLA_NPAD * 1024;
  bfr* gq = (bfr*)(p.ws + OFF_PROJ + PJ_GQ);
  bfr* gk = (bfr*)(p.ws + OFF_PROJ + PJ_GK);
  bfr* gg = (bfr*)(p.ws + OFF_PROJ + PJ_GG);
  bfr* gvt = (bfr*)(p.ws + OFF_PROJ + PJ_GVT);
  float* tb = (float*)(p.ws + OFF_TBUF);
  float* sC = (float*)smem;
  const int tid = threadIdx.x;
  constexpr int NT = 25, MT = 64;
  for (TileIter ti(NT); ti.valid(); ti.next()) {
    const int mt = ti.mt(), nt = ti.nt(), m0 = mt * 128, n0 = nt * 128;
    f32x16 acc[2][2];
    gemm_core(A, Bt, 1024, m0, n0, smem, acc);
    if (nt >= 8 && nt < 16) {
      stage_acc_t(acc, sC);
      __syncthreads();
#pragma unroll 4
      for (int it = 0; it < 16; ++it) {
        int idx = it * 256 + tid, col = idx >> 5, r4 = (idx & 31) * 4;
        float4 v = *(const float4*)(sC + col * 132 + r4);
        *(uint2*)(gvt + (size_t)((nt - 8) * 128 + col) * NTOK + m0 + r4) = make_uint2(pack2(v.x, v.y), pack2(v.z, v.w));
      }
    } else {
      stage_acc(acc, sC);
      __syncthreads();
#pragma unroll 4
      for (int it = 0; it < 16; ++it) {
        int idx = it * 256 + tid, row = idx >> 5, c4 = (idx & 31) * 4;
        float4 v = *(const float4*)(sC + row * 132 + c4);
        size_t grow = m0 + row;
        if (nt < 4) {
          const float s = 0.08838834764831845f;
          *(uint2*)(gq + grow * 512 + n0 + c4) = make_uint2(pack2(v.x * s, v.y * s), pack2(v.z * s, v.w * s));
        } else if (nt < 8) {
          *(uint2*)(gk + grow * 512 + (n0 - 512) + c4) = make_uint2(pack2(v.x, v.y), pack2(v.z, v.w));
        } else if (nt < 24) {
          *(uint2*)(gg + grow * 1024 + (n0 - 2048) + c4) =
              make_uint2(pack2(siluf(v.x), siluf(v.y)), pack2(siluf(v.z), siluf(v.w)));
        } else {
          if (c4 < 32) *(float4*)(tb + grow * 32 + c4) = v;
        }
      }
    }
    __syncthreads();
  }
}

DI void phase_gla_prep(const Params& p, int gi, unsigned char* smem) {
  const bfr* gq = (const bfr*)(p.ws + OFF_PROJ + PJ_GQ);
  const bfr* gk = (const bfr*)(p.ws + OFF_PROJ + PJ_GK);
  const float* tb = (const float*)(p.ws + OFF_TBUF);
  bfr* qe_o = (bfr*)(p.ws + OFF_QE);
  bfr* kdt_o = (bfr*)(p.ws + OFF_KDT);
  bfr* a_o = (bfr*)(p.ws + OFF_ABUF);
  float* el_o = (float*)(p.ws + OFF_ELAST);
  bfr* sQ = (bfr*)smem;
  bfr* sK = sQ + 64 * 136;
  float* tl = (float*)(sK + 64 * 136);
  float* tot = tl + 64 * 16;
  const int tid = threadIdx.x, lane = tid & 63, w = tid >> 6, r = lane & 31, hh = lane >> 5;
  const int dk = tid & 127, half = tid >> 7;
  for (int u = blockIdx.x; u < 1024; u += gridDim.x) {
    const int d = u >> 9, cgi = (u >> 2) & 127, hd = u & 3;
    const int token0 = cgi * 64;
    {
      int s = tid >> 2, j4 = (tid & 3) * 4;
      *(float4*)(tl + s * 16 + j4) = *(const float4*)(tb + (size_t)(token0 + s) * 32 + d * 16 + j4);
    }
#pragma unroll
    for (int j = 0; j < 4; ++j) {
      int id = j * 256 + tid, row = id >> 4, ch = (id & 15) * 8;
      *(uint4*)(sQ + row * 136 + ch) = *(const uint4*)(gq + (size_t)(token0 + row) * 512 + hd * 128 + ch);
      *(uint4*)(sK + row * 136 + ch) = *(const uint4*)(gk + (size_t)(token0 + row) * 512 + hd * 128 + ch);
    }
    float w2[16];
    const float* wa2 = p.in[I_GWA2] + (size_t)(gi * 2 + d) * 16 * 512 + hd * 128 + dk;
#pragma unroll
    for (int j = 0; j < 16; ++j) w2[j] = wa2[j * 512];
    const float bias = p.in[I_GBA][(gi * 2 + d) * 512 + hd * 128 + dk];
    __syncthreads();
    float pc[32];
    float cum = 0.f;
#pragma unroll
    for (int sl = 0; sl < 32; ++sl) {
      const float* tr = tl + (half * 32 + sl) * 16;
      float z = bias;
#pragma unroll
      for (int j4 = 0; j4 < 4; ++j4) {
        float4 tv = *(const float4*)(tr + j4 * 4);
        z += tv.x * w2[j4 * 4] + tv.y * w2[j4 * 4 + 1] + tv.z * w2[j4 * 4 + 2] + tv.w * w2[j4 * 4 + 3];
      }
      float lg = (fminf(z, 0.f) - __logf(1.f + __expf(-fabsf(z)))) * (1.f / 16.f);
      cum += lg;
      pc[sl] = cum;
    }
    tot[half * 128 + dk] = cum;
    __syncthreads();
    const float t0 = tot[dk], t1 = tot[128 + dk];
    const float total = t0 + t1;
    const float base = half ? t0 : 0.f;
    const float etot = __expf(total);
    if (half == 0) el_o[(size_t)u * 128 + dk] = etot;
    unsigned kdp[16];
    float kd_prev = 0.f;
#pragma unroll
    for (int sl = 0; sl < 32; ++sl) {
      const int s = half * 32 + sl;
      const float pin = base + pc[sl];
      const float pex = base + (sl == 0 ? 0.f : pc[sl == 0 ? 0 : sl - 1]);
      const float b = d ? (total - pex) : pin;
      const float qv = bf2f(sQ[s * 136 + dk]), kv = bf2f(sK[s * 136 + dk]);
      const float eb = __expf(b), enb = __builtin_amdgcn_rcpf(eb);
      const float qe = qv * eb, ke = kv * enb, kd = kv * (etot * enb);
      sQ[s * 136 + dk] = f2bf(qe);
      sK[s * 136 + dk] = f2bf(ke);
      if (sl & 1) kdp[sl >> 1] = pack2(kd_prev, kd); else kd_prev = kd;
    }
    {
      uint4* dst = (uint4*)(kdt_o + ((size_t)u * 128 + dk) * 64 + half * 32);
      dst[0] = make_uint4(kdp[0], kdp[1], kdp[2], kdp[3]);
      dst[1] = make_uint4(kdp[4], kdp[5], kdp[6], kdp[7]);
      dst[2] = make_uint4(kdp[8], kdp[9], kdp[10], kdp[11]);
      dst[3] = make_uint4(kdp[12], kdp[13], kdp[14], kdp[15]);
    }
    __syncthreads();
#pragma unroll
    for (int j = 0; j < 4; ++j) {
      int id = j * 256 + tid, row = id >> 4, ch = (id & 15) * 8;
      *(uint4*)(qe_o + ((size_t)u * 64 + row) * 128 + ch) = *(const uint4*)(sQ + row * 136 + ch);
    }
    const int sb = w >> 1, tbk = w & 1;
    f32x16 acc;
#pragma unroll
    for (int i = 0; i < 16; ++i) acc[i] = 0.f;
#pragma unroll
    for (int kk = 0; kk < 8; ++kk) {
      bf16x8 a = *(const bf16x8*)(sK + (32 * sb + r) * 136 + 16 * kk + 8 * hh);
      bf16x8 b = *(const bf16x8*)(sQ + (32 * tbk + r) * 136 + 16 * kk + 8 * hh);
      acc = MFMA32(a, b, acc);
    }
    const int t = 32 * tbk + r;
#pragma unroll
    for (int g = 0; g < 4; ++g) {
      const int s4 = 32 * sb + 8 * g + 4 * hh;
      float v[4];
#pragma unroll
      for (int j = 0; j < 4; ++j) {
        const int s = s4 + j;
        const bool keep = d ? (s >= t) : (s <= t);
        v[j] = keep ? acc[4 * g + j] : 0.f;
      }
      *(uint2*)(a_o + ((size_t)u * 64 + t) * 64 + s4) = make_uint2(pack2(v[0], v[1]), pack2(v[2], v[3]));
    }
    __syncthreads();
  }
}

DI void gla_scan_unit(const Params& p, int gi, bool sample, int b, int rem, unsigned char* smem) {
  const int hd = rem >> 3, d = (rem >> 2) & 1, sp = rem & 3;
  const int nch = sample ? 16 : 4;
  const int cg0 = sample ? 64 + b * 16 : b * 4;
  const bfr* qe_i = (const bfr*)(p.ws + OFF_QE);
  const bfr* kdt_i = (const bfr*)(p.ws + OFF_KDT);
  const bfr* a_i = (const bfr*)(p.ws + OFF_ABUF);
  const float* el_i = (const float*)(p.ws + OFF_ELAST);
  const bfr* gvt = (const bfr*)(p.ws + OFF_PROJ + PJ_GVT);
  bfr* o_o = (bfr*)(p.ws + OFF_O) + (size_t)d * NTOK * 1024;
  bfr* sSt = (bfr*)smem;
  bfr* sQ = sSt + 64 * 136;
  bfr* sA = sQ + 64 * 136;
  bfr* sV = sA + 64 * 72;
  bfr* sKd = sV + 64 * 72;
  const int tid = threadIdx.x, lane = tid & 63, w = tid >> 6, r = lane & 31, hh = lane >> 5;
  f32x16 S[2];
  if (sample) {
    const float* st = p.in[I_STATE] + ((((size_t)(b * 2 + gi) * 2 + d) * 4 + hd) * 128) * 256 + sp * 64;
#pragma unroll
    for (int nb = 0; nb < 2; ++nb)
#pragma unroll
      for (int i = 0; i < 16; ++i) S[nb][i] = st[(size_t)(32 * w + crow(i, hh)) * 256 + 32 * nb + r];
  } else {
#pragma unroll
    for (int nb = 0; nb < 2; ++nb)
#pragma unroll
      for (int i = 0; i < 16; ++i) S[nb][i] = 0.f;
  }
  for (int c = 0; c < nch; ++c) {
    const int cl = d ? nch - 1 - c : c;
    const int cgi = cg0 + cl;
    const int u = (d * 128 + cgi) * 4 + hd;
    const int token0 = cgi * 64;
#pragma unroll
    for (int j = 0; j < 4; ++j) {
      int id = j * 256 + tid, row = id >> 4, ch = (id & 15) * 8;
      *(uint4*)(sQ + row * 136 + ch) = *(const uint4*)(qe_i + ((size_t)u * 64 + row) * 128 + ch);
    }
#pragma unroll
    for (int j = 0; j < 2; ++j) {
      int id = j * 256 + tid, row = id >> 3, ch = (id & 7) * 8;
      *(uint4*)(sA + row * 72 + ch) = *(const uint4*)(a_i + ((size_t)u * 64 + row) * 64 + ch);
      *(uint4*)(sV + row * 72 + ch) = *(const uint4*)(gvt + (size_t)(hd * 256 + sp * 64 + row) * NTOK + token0 + ch);
    }
#pragma unroll
    for (int j = 0; j < 4; ++j) {
      int id = j * 256 + tid, row = id >> 3, ch = (id & 7) * 8;
      *(uint4*)(sKd + row * 72 + ch) = *(const uint4*)(kdt_i + ((size_t)u * 128 + row) * 64 + ch);
    }
    float4 el[4];
#pragma unroll
    for (int g = 0; g < 4; ++g) el[g] = *(const float4*)(el_i + (size_t)u * 128 + 32 * w + 8 * g + 4 * hh);
#pragma unroll
    for (int nb = 0; nb < 2; ++nb)
#pragma unroll
      for (int g = 0; g < 4; ++g)
        *(uint2*)(sSt + (32 * nb + r) * 136 + 32 * w + 8 * g + 4 * hh) =
            make_uint2(pack2(S[nb][4 * g], S[nb][4 * g + 1]), pack2(S[nb][4 * g + 2], S[nb][4 * g + 3]));
    __syncthreads();
    {
      const int tbk = w >> 1, nbo = w & 1;
      f32x16 oa;
#pragma unroll
      for (int i = 0; i < 16; ++i) oa[i] = 0.f;
#pragma unroll
      for (int kk = 0; kk < 8; ++kk) {
        bf16x8 a = *(const bf16x8*)(sQ + (32 * tbk + r) * 136 + 16 * kk + 8 * hh);
        bf16x8 bb = *(const bf16x8*)(sSt + (32 * nbo + r) * 136 + 16 * kk + 8 * hh);
        oa = MFMA32(a, bb, oa);
      }
#pragma unroll
      for (int kk = 0; kk < 4; ++kk) {
        bf16x8 a = *(const bf16x8*)(sA + (32 * tbk + r) * 72 + 16 * kk + 8 * hh);
        bf16x8 bb = *(const bf16x8*)(sV + (32 * nbo + r) * 72 + 16 * kk + 8 * hh);
        oa = MFMA32(a, bb, oa);
      }
#pragma unroll
      for (int i = 0; i < 16; ++i)
        o_o[(size_t)(token0 + 32 * tbk + crow(i, hh)) * 1024 + hd * 256 + sp * 64 + 32 * nbo + r] = f2bf(oa[i]);
    }
#pragma unroll
    for (int nb = 0; nb < 2; ++nb)
#pragma unroll
      for (int g = 0; g < 4; ++g) {
        S[nb][4 * g] *= el[g].x; S[nb][4 * g + 1] *= el[g].y; S[nb][4 * g + 2] *= el[g].z; S[nb][4 * g + 3] *= el[g].w;
      }
#pragma unroll
    for (int kk = 0; kk < 4; ++kk) {
      bf16x8 a = *(const bf16x8*)(sKd + (32 * w + r) * 72 + 16 * kk + 8 * hh);
#pragma unroll
      for (int nb = 0; nb < 2; ++nb) {
        bf16x8 bb = *(const bf16x8*)(sV + (32 * nb + r) * 72 + 16 * kk + 8 * hh);
        S[nb] = MFMA32(a, bb, S[nb]);
      }
    }
    __syncthreads();
  }
  if (!sample) {
    float* so = p.out + OUT_STATE + ((((size_t)(b * 2 + gi) * 2 + d) * 4 + hd) * 128) * 256 + sp * 64;
#pragma unroll
    for (int nb = 0; nb < 2; ++nb)
#pragma unroll
      for (int i = 0; i < 16; ++i) so[(size_t)(32 * w + crow(i, hh)) * 256 + 32 * nb + r] = S[nb][i];
  }
}
DI void phase_gla_scan(const Params& p, int gi, unsigned char* smem) {
  const int nb = gridDim.x, bid = blockIdx.x;
  int idx, step;
  if (nb >= 256) { idx = bid; step = bid < 128 ? 640 : nb - 128; }
  else { idx = bid; step = nb; }
  for (; idx < 640; idx += step) {
    const bool sample = idx < 128;
    const int q = sample ? idx : idx - 128;
    gla_scan_unit(p, gi, sample, q >> 5, q & 31, smem);
  }
}

DI void phase_gla_post(const Params& p, int gi) {
  const int lane = threadIdx.x & 63;
  const int gw = blockIdx.x * 4 + (threadIdx.x >> 6), nw = gridDim.x * 4;
  const bfr* o0 = (const bfr*)(p.ws + OFF_O);
  const bfr* o1 = o0 + (size_t)NTOK * 1024;
  const bfr* gg = (const bfr*)(p.ws + OFF_PROJ + PJ_GG);
  bfr* uo = (bfr*)(p.ws + OFF_U);
  const float4 on = *(const float4*)(p.in[I_GONORM] + gi * 256 + lane * 4);
  for (int row = gw; row < NTOK; row += nw) {
#pragma unroll
    for (int hd = 0; hd < 4; ++hd) {
      size_t idx = (size_t)row * 1024 + hd * 256 + lane * 4;
      uint2 a = *(const uint2*)(o0 + idx), b = *(const uint2*)(o1 + idx), g = *(const uint2*)(gg + idx);
      float v0 = bf2f(a.x & 0xffff) + bf2f(b.x & 0xffff), v1 = bf2f(a.x >> 16) + bf2f(b.x >> 16);
      float v2 = bf2f(a.y & 0xffff) + bf2f(b.y & 0xffff), v3 = bf2f(a.y >> 16) + bf2f(b.y >> 16);
      float ss = wave_sum(v0 * v0 + v1 * v1 + v2 * v2 + v3 * v3);
      float rstd = rsqrtf(ss * (1.f / 256.f) + EPSN);
      float r0 = v0 * rstd * on.x * bf2f(g.x & 0xffff), r1 = v1 * rstd * on.y * bf2f(g.x >> 16);
      float r2 = v2 * rstd * on.z * bf2f(g.y & 0xffff), r3 = v3 * rstd * on.w * bf2f(g.y >> 16);
      *(uint2*)(uo + idx) = make_uint2(pack2(r0, r1), pack2(r2, r3));
    }
  }
}

DI void phase_out_proj(const Params& p, int l, const bfr* Bt, unsigned char* smem) {
  const bfr* A = (const bfr*)(p.ws + OFF_U);
  const float* mod = (const float*)(p.ws + OFF_MOD) + (size_t)l * 5 * 3072;
  float* sC = (float*)smem;
  const int tid = threadIdx.x;
  for (TileIter ti(8); ti.valid(); ti.next()) {
    const int mt = ti.mt(), nt = ti.nt(), m0 = mt * 128, n0 = nt * 128;
    f32x16 acc[2][2];
    gemm_core(A, Bt, 1024, m0, n0, smem, acc);
    stage_acc(acc, sC);
    __syncthreads();
#pragma unroll 4
    for (int it = 0; it < 16; ++it) {
      int idx = it * 256 + tid, row = idx >> 5, c4 = (idx & 31) * 4;
      float4 v = *(const float4*)(sC + row * 132 + c4);
      int grow = m0 + row, col = n0 + c4;
      float4 xo = *(const float4*)(xrow_ptr(p, l, grow) + col);
      float4 gt = *(const float4*)(mod + modrow(grow) * 3072 + 2048 + col);
      float4 o = make_float4(xo.x + gt.x * v.x, xo.y + gt.y * v.y, xo.z + gt.z * v.z, xo.w + gt.w * v.w);
      *(float4*)(p.out + (size_t)grow * DM + col) = o;
    }
    __syncthreads();
  }
}

DI void phase_att_in(const Params& p, int ai, unsigned char* smem) {
  const bfr* A = (const bfr*)(p.ws + OFF_H);
  const bfr* Bt = (const bfr*)(p.ws + OFF_WT_ATT_IN) + (size_t)ai * ATT_N * 1024;
  bfr* aq = (bfr*)(p.ws + OFF_PROJ + PJ_AQ);
  bfr* ag = (bfr*)(p.ws + OFF_PROJ + PJ_AG);
  bfr* akp = (bfr*)(p.ws + OFF_PROJ + PJ_AKP);
  bfr* avpt = (bfr*)(p.ws + OFF_PROJ + PJ_AVPT);
  bfr* ks = (bfr*)(p.ws + OFF_KS);
  bfr* vst = (bfr*)(p.ws + OFF_VST);
  const float* rc = (const float*)(p.ws + OFF_ROPE);
  const float* rs = rc + 64 * 32;
  const float* qn = p.in[I_AQN] + ai * 128;
  const float* kn = p.in[I_AKN] + ai * 128;
  float* sC = (float*)smem;
  const int tid = threadIdx.x;
  constexpr int NT = 20, MT = 64;
  for (TileIter ti(NT); ti.valid(); ti.next()) {
    const int mt = ti.mt(), nt = ti.nt(), m0 = mt * 128, n0 = nt * 128;
    const bool samp = m0 >= NPT;
    f32x16 acc[2][2];
    gemm_core(A, Bt, 1024, m0, n0, smem, acc);
    if (nt == 10 || nt == 11) {
      const int hk = nt - 10;
      stage_acc_t(acc, sC);
      __syncthreads();
      bfr* dst; size_t ldt;
      if (!samp) { int b = m0 >> 8, t0 = m0 & 255; dst = avpt + (size_t)((b * 2 + hk) * 128) * 256 + t0; ldt = 256; }
      else { int b = (m0 - NPT) >> 10, t0 = (m0 - NPT) & 1023; dst = vst + (size_t)(((ai * 4 + b) * 2 + hk) * 128) * 1280 + t0; ldt = 1280; }
#pragma unroll 4
      for (int it = 0; it < 16; ++it) {
        int idx = it * 256 + tid, col = idx >> 5, r4 = (idx & 31) * 4;
        float4 v = *(const float4*)(sC + col * 132 + r4);
        *(uint2*)(dst + (size_t)col * ldt + r4) = make_uint2(pack2(v.x, v.y), pack2(v.z, v.w));
      }
      if (!samp) {
        __syncthreads();
        stage_acc(acc, sC);
        __syncthreads();
        const int b = m0 >> 8, t0 = m0 & 255;
#pragma unroll 4
        for (int it = 0; it < 16; ++it) {
          int idx = it * 256 + tid, row = idx >> 5, c4 = (idx & 31) * 4;
          float4 v = *(const float4*)(sC + row * 132 + c4);
          *(float4*)(p.out + OUT_CV + ((((size_t)b * 2 + ai) * 256 + t0 + row) * 2 + hk) * 128 + c4) = v;
        }
      }
    } else {
      stage_acc(acc, sC);
      __syncthreads();
#pragma unroll 2
      for (int it = 0; it < 16; ++it) {
        int idx = it * 256 + tid, row = idx >> 5, c4 = (idx & 31) * 4;
        float4 v = *(const float4*)(sC + row * 132 + c4);
        const int grow = m0 + row;
        if (nt >= 12) {
          *(uint2*)(ag + (size_t)grow * 1024 + (n0 - 1536) + c4) =
              make_uint2(pack2(siluf(v.x), siluf(v.y)), pack2(siluf(v.z), siluf(v.w)));
        } else {
          float ss = half_sum(v.x * v.x + v.y * v.y + v.z * v.z + v.w * v.w);
          const float rstd = rsqrtf(ss * (1.f / 128.f) + EPSN);
          const float* wn = nt < 8 ? qn : kn;
          float4 wv = *(const float4*)(wn + c4);
          float4 xn = make_float4(v.x * rstd * wv.x, v.y * rstd * wv.y, v.z * rstd * wv.z, v.w * rstd * wv.w);
          float4 o = xn;
          if (samp) {
            const int cp = c4 ^ 32;
            float4 pv = *(const float4*)(sC + row * 132 + cp);
            float4 pw = *(const float4*)(wn + cp);
            float4 pn = make_float4(pv.x * rstd * pw.x, pv.y * rstd * pw.y, pv.z * rstd * pw.z, pv.w * rstd * pw.w);
            const int t = (grow - NPT) & 1023;
            const int pos = (c4 < 64) ? (t >> 6) : (t & 63);
            float4 cs = *(const float4*)(rc + pos * 32 + (c4 & 31));
            float4 sn = *(const float4*)(rs + pos * 32 + (c4 & 31));
            const float sg = (c4 & 32) ? 1.f : -1.f;
            o = make_float4(xn.x * cs.x + sg * pn.x * sn.x, xn.y * cs.y + sg * pn.y * sn.y,
                            xn.z * cs.z + sg * pn.z * sn.z, xn.w * cs.w + sg * pn.w * sn.w);
          }
          if (nt < 8) {
            const float s = 0.08838834764831845f * 1.4426950408889634f;
            *(uint2*)(aq + (size_t)grow * 1024 + n0 + c4) = make_uint2(pack2(o.x * s, o.y * s), pack2(o.z * s, o.w * s));
          } else {
            const int hk = nt - 8;
            uint2 ob = make_uint2(pack2(o.x, o.y), pack2(o.z, o.w));
            if (!samp) {
              const int b = grow >> 8, t = grow & 255;
              *(float4*)(p.out + OUT_CK + ((((size_t)b * 2 + ai) * 256 + t) * 2 + hk) * 128 + c4) = o;
              *(uint2*)(akp + (size_t)grow * 256 + hk * 128 + c4) = ob;
            } else {
              const int b = (grow - NPT) >> 10, t = (grow - NPT) & 1023;
              *(uint2*)(ks + ((size_t)(ai * 4 + b) * 1280 + t) * 256 + hk * 128 + c4) = ob;
            }
          }
        }
      }
    }
    __syncthreads();
  }
}

DI void attn_unit(const Params& p, int ai, bool sample, int unit, unsigned char* smem) {
  int b, hkv, qb, ntile, tokq0;
  const bfr* Kb; const bfr* Vb; size_t ldt;
  if (sample) {
    b = unit >> 6; hkv = (unit >> 5) & 1; qb = unit & 31; ntile = 20;
    tokq0 = NPT + b * 1024 + qb * 32;
    Kb = (const bfr*)(p.ws + OFF_KS) + (size_t)(ai * 4 + b) * 1280 * 256 + hkv * 128;
    Vb = (const bfr*)(p.ws + OFF_VST) + (size_t)(((ai * 4 + b) * 2 + hkv) * 128) * 1280; ldt = 1280;
  } else {
    b = unit >> 4; hkv = (unit >> 3) & 1; qb = unit & 7; ntile = 4;
    tokq0 = b * 256 + qb * 32;
    Kb = (const bfr*)(p.ws + OFF_PROJ + PJ_AKP) + (size_t)(b * 256) * 256 + hkv * 128;
    Vb = (const bfr*)(p.ws + OFF_PROJ + PJ_AVPT) + (size_t)((b * 2 + hkv) * 128) * 256; ldt = 256;
  }
  const bfr* aq = (const bfr*)(p.ws + OFF_PROJ + PJ_AQ);
  const bfr* ag = (const bfr*)(p.ws + OFF_PROJ + PJ_AG);
  bfr* uo = (bfr*)(p.ws + OFF_U);
  const int tid = threadIdx.x, lane = tid & 63, w = tid >> 6, r = lane & 31, hh = lane >> 5;
  const int hq = hkv * 4 + w;
  unsigned char* sK = smem;
  unsigned char* sV = smem + 32768;
  bf16x8 qf[8];
#pragma unroll
  for (int kk = 0; kk < 8; ++kk) qf[kk] = *(const bf16x8*)(aq + (size_t)(tokq0 + r) * 1024 + hq * 128 + 16 * kk + 8 * hh);
  f32x16 oacc[4];
#pragma unroll
  for (int a = 0; a < 4; ++a)
#pragma unroll
    for (int i = 0; i < 16; ++i) oacc[a][i] = 0.f;
  float m_run = -INFINITY, l_run = 0.f;
  int koff[4], voff[4];
#pragma unroll
  for (int i = 0; i < 4; ++i) {
    const int krow = (i * 4 + w) * 4 + (lane >> 4);
    koff[i] = krow * 256 + (((lane & 15) ^ (krow & 15)) << 3);
    const int vrow = (i * 4 + w) * 8 + (lane >> 3);
    voff[i] = vrow * (int)ldt + (((lane & 7) ^ ((vrow >> 1) & 7)) << 3);
  }
#define ATT_STAGE(buf, kt)                                                                                          \
  do {                                                                                                              \
    _Pragma("unroll") for (int i = 0; i < 4; ++i) {                                                                 \
      __builtin_amdgcn_global_load_lds((const unsigned*)(Kb + koff[i] + (kt) * (64 * 256)),                         \
                                       (unsigned*)(sK + (buf) * 16384 + (i * 4 + w) * 1024), 16, 0, 0);            \
      __builtin_amdgcn_global_load_lds((const unsigned*)(Vb + voff[i] + (kt) * 64),                                 \
                                       (unsigned*)(sV + (buf) * 16384 + (i * 4 + w) * 1024), 16, 0, 0);            \
    }                                                                                                               \
  } while (0)
  ATT_STAGE(0, 0);
  asm volatile("s_waitcnt vmcnt(0)" ::: "memory");
  __syncthreads();
  const int kswz = r & 15, vswz = (r >> 1) & 7;
  for (int kt = 0; kt < ntile; ++kt) {
    const int cur = kt & 1;
    if (kt + 1 < ntile) ATT_STAGE(cur ^ 1, kt + 1);
    const unsigned char* cK = sK + cur * 16384 + r * 256;
    const unsigned char* cV = sV + cur * 16384 + r * 128 + 8 * hh;
    f32x16 sacc[2];
#pragma unroll
    for (int kb = 0; kb < 2; ++kb) {
#pragma unroll
      for (int i = 0; i < 16; ++i) sacc[kb][i] = 0.f;
#pragma unroll
      for (int kk = 0; kk < 8; ++kk) {
        bf16x8 a = *(const bf16x8*)(cK + kb * 8192 + (((2 * kk + hh) ^ kswz) << 4));
        sacc[kb] = MFMA32(a, qf[kk], sacc[kb]);
      }
    }
    float mt = sacc[0][0];
#pragma unroll
    for (int kb = 0; kb < 2; ++kb)
#pragma unroll
      for (int i = 0; i < 16; ++i) mt = fmaxf(mt, sacc[kb][i]);
    mt = fmaxf(mt, __shfl_xor(mt, 32));
    const float m_new = fmaxf(m_run, mt);
    const float alpha = __builtin_amdgcn_exp2f(m_run - m_new);
    m_run = m_new;
    float ls = 0.f;
#pragma unroll
    for (int kb = 0; kb < 2; ++kb)
#pragma unroll
      for (int i = 0; i < 16; ++i) { float pv = __builtin_amdgcn_exp2f(sacc[kb][i] - m_new); sacc[kb][i] = pv; ls += pv; }
    l_run = l_run * alpha + ls;
#pragma unroll
    for (int a = 0; a < 4; ++a)
#pragma unroll
      for (int i = 0; i < 16; ++i) oacc[a][i] *= alpha;
#pragma unroll
    for (int kb = 0; kb < 2; ++kb)
#pragma unroll
      for (int s2 = 0; s2 < 2; ++s2) {
        unsigned pk[4];
#pragma unroll
        for (int j = 0; j < 4; ++j) pk[j] = pack2(sacc[kb][8 * s2 + 2 * j], sacc[kb][8 * s2 + 2 * j + 1]);
        bf16x8 pb = __builtin_bit_cast(bf16x8, make_uint4(pk[0], pk[1], pk[2], pk[3]));
        const int c0 = 4 * kb + 2 * s2;
#pragma unroll
        for (int dvb = 0; dvb < 4; ++dvb) {
          const unsigned char* vp = cV + dvb * 4096;
          uint2 lo = *(const uint2*)(vp + ((c0 ^ vswz) << 4)), hi = *(const uint2*)(vp + (((c0 + 1) ^ vswz) << 4));
          bf16x8 av = __builtin_bit_cast(bf16x8, make_uint4(lo.x, lo.y, hi.x, hi.y));
          oacc[dvb] = MFMA32(av, pb, oacc[dvb]);
        }
      }
    asm volatile("s_waitcnt vmcnt(0)" ::: "memory");
    __syncthreads();
  }
#undef ATT_STAGE
  const float lt = l_run + __shfl_xor(l_run, 32);
  const float inv = 1.f / lt;
#pragma unroll
  for (int dvb = 0; dvb < 4; ++dvb)
#pragma unroll
    for (int g = 0; g < 4; ++g) {
      size_t idx = (size_t)(tokq0 + r) * 1024 + hq * 128 + 32 * dvb + 8 * g + 4 * hh;
      uint2 gv = *(const uint2*)(ag + idx);
      float o0 = oacc[dvb][4 * g] * inv * bf2f(gv.x & 0xffff), o1 = oacc[dvb][4 * g + 1] * inv * bf2f(gv.x >> 16);
      float o2 = oacc[dvb][4 * g + 2] * inv * bf2f(gv.y & 0xffff), o3 = oacc[dvb][4 * g + 3] * inv * bf2f(gv.y >> 16);
      *(uint2*)(uo + idx) = make_uint2(pack2(o0, o1), pack2(o2, o3));
    }
}
DI void phase_attn(const Params& p, int ai, unsigned char* smem) {
  const int nb = gridDim.x, bid = blockIdx.x;
  int idx, step;
  if (nb >= 512) { idx = bid; step = bid < 256 ? 512 : nb - 256; }
  else { idx = bid; step = nb; }
  for (; idx < 512; idx += step) {
    const bool sample = idx < 256;
    attn_unit(p, ai, sample, sample ? idx : idx - 256, smem);
  }
}


#define XB_TMO      128
#define XB_XCNT(j)  (256  + 64 * (j))
#define XB_XSUB(j)  (1280 + 64 * (j))
#define XB_XGEN(j)  (2304 + 64 * (j))
#define XB_TOP      3328
#define XB_TOPGEN   3392
#define XCD_BAR_WORDS 3456
#define XB_SPIN_CAP (1u << 18)
#define LAS __attribute__((address_space(3)))
DI unsigned xb_ld(unsigned* p) { return __hip_atomic_load(p, __ATOMIC_RELAXED, __HIP_MEMORY_SCOPE_AGENT); }
DI unsigned xb_add(unsigned* p, unsigned v) { return __hip_atomic_fetch_add(p, v, __ATOMIC_RELAXED, __HIP_MEMORY_SCOPE_AGENT); }
DI unsigned xb_xcc_id() { return (unsigned)__builtin_amdgcn_s_getreg((3 << 11) | 20) & 0xFu; }
#define XB_SPIN(cond, bar) do { unsigned _sp = 0; while (cond) { __builtin_amdgcn_s_sleep(1); \
    if ((++_sp & 255u) == 0u) { if (xb_ld(&(bar)[XB_TMO])) break; if (_sp > XB_SPIN_CAP) { atomicAdd(&(bar)[XB_TMO], 1u); break; } } } } while (0)
struct XcdBarrier { unsigned* bar; unsigned x; volatile LAS unsigned* st; };
DI XcdBarrier xcd_barrier_post(unsigned* bar, volatile LAS unsigned* st) {
  XcdBarrier b; b.bar = bar; b.x = xb_xcc_id(); b.st = st;
  if (threadIdx.x == 0) (void)xb_add(&bar[XB_XCNT(b.x)], 1u);
  return b;
}
DI void xcd_barrier_complete(unsigned* bar, unsigned x, unsigned& nloc, unsigned& nx) {
  const unsigned G = gridDim.x * gridDim.y * gridDim.z;
  unsigned sum, cnt, mine, sp = 0u;
  for (;;) {
    sum = 0u; cnt = 0u; mine = 0u;
#pragma unroll
    for (unsigned j = 0; j < 16; ++j) { const unsigned c = xb_ld(&bar[XB_XCNT(j)]); sum += c; cnt += (c > 0u) ? 1u : 0u; mine = (j == x) ? c : mine; }
    if (sum == G) break;
    __builtin_amdgcn_s_sleep(1);
    if ((++sp & 255u) == 0u) { if (xb_ld(&bar[XB_TMO])) break; if (sp > XB_SPIN_CAP) { atomicAdd(&bar[XB_TMO], 1u); break; } }
  }
  nloc = mine > 0u ? mine : 1u; nx = cnt > 0u ? cnt : 1u;
}
DI void xcd_barrier(const XcdBarrier& b) {
  asm volatile("s_waitcnt vmcnt(0)" ::: "memory");
  __syncthreads();
  if (threadIdx.x == 0) {
    unsigned* bar = b.bar;
    __builtin_amdgcn_s_waitcnt(0);
    unsigned nloc = b.st[0], nx = b.st[1];
    if (nloc == 0u) { xcd_barrier_complete(bar, b.x, nloc, nx); b.st[0] = nloc; b.st[1] = nx; }
    const unsigned old = xb_add(&bar[XB_XSUB(b.x)], 1u);
    const unsigned gen = old / nloc;
    if (old + 1u == (gen + 1u) * nloc) {
      __builtin_amdgcn_fence(__ATOMIC_RELEASE, "agent");
      asm volatile("s_waitcnt vmcnt(0)" ::: "memory");
      const unsigned og = xb_add(&bar[XB_TOP], 1u);
      const unsigned tg = og / nx;
      if (og + 1u == (tg + 1u) * nx) xb_add(&bar[XB_TOPGEN], 1u);
      else XB_SPIN(xb_ld(&bar[XB_TOPGEN]) == tg, bar);
      __builtin_amdgcn_fence(__ATOMIC_ACQUIRE, "agent");
      xb_add(&bar[XB_XGEN(b.x)], 1u);
      asm volatile("s_waitcnt vmcnt(0)" ::: "memory");
    } else {
      XB_SPIN(xb_ld(&bar[XB_XGEN(b.x)]) == gen, bar);
      __builtin_amdgcn_fence(__ATOMIC_ACQUIRE, "agent");
      asm volatile("s_waitcnt vmcnt(0)" ::: "memory");
    }
  }
  __syncthreads();
}

#ifndef REP_P0
#define REP_P0 1
#endif
#ifndef REP_SMALL
#define REP_SMALL 1
#endif
#ifndef REP_GIN
#define REP_GIN 1
#endif
#ifndef REP_AIN
#define REP_AIN 1
#endif
#ifndef REP_SCAN
#define REP_SCAN 1
#endif
#ifndef REP_ATT
#define REP_ATT 1
#endif
#ifndef REP_OUT0
#define REP_OUT0 1
#endif
#ifndef REP_SYNC
#define REP_SYNC 1
#endif
#define SYNC() do { xcd_barrier(xb); if (REP_SYNC >= 2) xcd_barrier(xb); if (REP_SYNC >= 3) xcd_barrier(xb); } while (0)
#define RUN(n, stmt) do { stmt; SYNC(); if ((n) >= 2) { stmt; SYNC(); } } while (0)

__global__ void __launch_bounds__(256, 2) fwd_megakernel(Params p) {
  __shared__ __attribute__((aligned(16))) unsigned char smem[SMEM_BYTES + 16];
  cg::grid_group grid = cg::this_grid();
  if (p.never) grid.sync();
  if (threadIdx.x == 0) *(uint4*)(smem + SMEM_BYTES) = make_uint4(0u, 0u, 0u, 0u);
  __syncthreads();
  XcdBarrier xb = xcd_barrier_post((unsigned*)(p.ws + OFF_BAR), (volatile LAS unsigned*)(smem + SMEM_BYTES));
  RUN(REP_P0, phase0(p, smem));
  RUN(REP_SMALL, phase_norm(p, 0));
  RUN(REP_GIN, phase_gla_in(p, 0, smem));
  RUN(REP_SMALL, phase_gla_prep(p, 0, smem));
  RUN(REP_SCAN, phase_gla_scan(p, 0, smem));
  RUN(REP_SMALL, phase_gla_post(p, 0));
  RUN(REP_OUT0, phase_out_proj(p, 0, (const bfr*)(p.ws + OFF_WT_GLA_OUT), smem));
  RUN(REP_SMALL, phase_norm(p, 1));
  RUN(REP_AIN, phase_att_in(p, 0, smem));
  RUN(REP_ATT, phase_attn(p, 0, smem));
  phase_out_proj(p, 1, (const bfr*)(p.ws + OFF_WT_ATT_OUT), smem); SYNC();
  RUN(REP_SMALL, phase_norm(p, 2));
  RUN(REP_GIN, phase_gla_in(p, 1, smem));
  RUN(REP_SMALL, phase_gla_prep(p, 1, smem));
  RUN(REP_SCAN, phase_gla_scan(p, 1, smem));
  RUN(REP_SMALL, phase_gla_post(p, 1));
  phase_out_proj(p, 2, (const bfr*)(p.ws + OFF_WT_GLA_OUT) + (size_t)1024 * 1024, smem); SYNC();
  RUN(REP_SMALL, phase_norm(p, 3));
  RUN(REP_AIN, phase_att_in(p, 1, smem));
  RUN(REP_ATT, phase_attn(p, 1, smem));
  phase_out_proj(p, 3, (const bfr*)(p.ws + OFF_WT_ATT_OUT) + (size_t)1024 * 1024, smem);
}

extern "C" void kernel_launch(void* const* d_in, const int* in_sizes, int n_in, void* d_out, int out_size, void* d_ws,
                              size_t ws_size, hipStream_t stream) {
  static int grid_blocks = 0;
  if (!grid_blocks) {
    int dev = 0, cus = 0, per_cu = 0;
    hipGetDevice(&dev);
    hipDeviceGetAttribute(&cus, hipDeviceAttributeMultiprocessorCount, dev);
    hipOccupancyMaxActiveBlocksPerMultiprocessor(&per_cu, fwd_megakernel, 256, 0);
    if (per_cu > 2) per_cu = 2;
    if (per_cu < 1) per_cu = 1;
    grid_blocks = cus * per_cu;
  }
  Params p{};
  for (int i = 0; i < 20; ++i) p.in[i] = (const float*)d_in[i];
  p.out = (float*)d_out;
  p.ws = (unsigned char*)d_ws;
  p.never = 0;
  p.pad = 0;
  hipMemsetAsync((unsigned char*)d_ws + OFF_BAR, 0, 3456 * 4, stream);
  void* args[] = {&p};
  hipError_t e = hipLaunchCooperativeKernel((void*)fwd_megakernel, dim3(grid_blocks), dim3(256), args, 0, stream);
  if (e != hipSuccess) fprintf(stderr, "cooperative launch failed: %s (grid %d)\n", hipGetErrorString(e), grid_blocks);
}
```

```cpp
#include <hip/hip_runtime.h>
#include <hip/hip_cooperative_groups.h>
#include <stdint.h>
#include <stdio.h>
namespace cg = cooperative_groups;

typedef unsigned short bfr;
using bf16x8 = __attribute__((ext_vector_type(8))) short;
using bf16x4 = __attribute__((ext_vector_type(4))) short;
using f32x16 = __attribute__((ext_vector_type(16))) float;
using f32x4 = __attribute__((ext_vector_type(4))) float;
#define DI __device__ __forceinline__
using u32x4 = __attribute__((ext_vector_type(4))) unsigned;
using u32x2 = __attribute__((ext_vector_type(2))) unsigned;
#define GLOAD16(dst, ptr) asm volatile("global_load_dwordx4 %0, %1, off" : "=v"(dst) : "v"(ptr) : "memory")
#define MFMA32(a, b, c) __builtin_amdgcn_mfma_f32_32x32x16_bf16((a), (b), (c), 0, 0, 0)

constexpr int NTOK = 8192;
constexpr int DM = 1024;
constexpr int NPT = 4096;
constexpr float EPSN = 1e-6f;
constexpr int GLA_NPAD = 3200;
constexpr int ATT_N = 2560;

constexpr size_t OFF_WT_GLA_IN = 0;
constexpr size_t OFF_WT_GLA_OUT = OFF_WT_GLA_IN + 2ull * GLA_NPAD * 1024 * 2;
constexpr size_t OFF_WT_ATT_IN = OFF_WT_GLA_OUT + 2ull * 1024 * 1024 * 2;
constexpr size_t OFF_WT_ATT_OUT = OFF_WT_ATT_IN + 2ull * ATT_N * 1024 * 2;
constexpr size_t OFF_MOD = OFF_WT_ATT_OUT + 2ull * 1024 * 1024 * 2;
constexpr size_t OFF_ROPE = OFF_MOD + 4ull * 5 * 3072 * 4;
constexpr size_t OFF_H = OFF_ROPE + 2ull * 64 * 32 * 4;
constexpr size_t OFF_PROJ = OFF_H + (size_t)NTOK * 1024 * 2;
constexpr size_t OFF_TBUF = OFF_PROJ + (size_t)NTOK * 3072 * 2;
constexpr size_t OFF_QE = OFF_TBUF + (size_t)NTOK * 32 * 4;
constexpr size_t OFF_KDT = OFF_QE + 2ull * NTOK * 512 * 2;
constexpr size_t OFF_ABUF = OFF_KDT + 2ull * NTOK * 512 * 2;
constexpr size_t OFF_ELAST = OFF_ABUF + 1024ull * 64 * 64 * 2;
constexpr size_t OFF_O = OFF_ELAST + 1024ull * 128 * 4;
constexpr size_t OFF_U = OFF_O + 2ull * NTOK * 1024 * 2;
constexpr size_t OFF_KS = OFF_U + (size_t)NTOK * 1024 * 2;
constexpr size_t OFF_VST = OFF_KS + 2ull * 4 * 1280 * 256 * 2;
constexpr size_t OFF_BAR = OFF_VST + 2ull * 4 * 1280 * 256 * 2;
constexpr size_t OFF_ROWSS = OFF_BAR + 3456 * 4;
constexpr size_t OFF_BIAS2 = OFF_ROWSS + 4ull * 8192 * 4;
constexpr size_t WS_END = OFF_BIAS2 + 4ull * 5 * 3200 * 4;
constexpr size_t PJ_GQ = 0;
constexpr size_t PJ_GK = (size_t)NTOK * 512 * 2;
constexpr size_t PJ_GG = (size_t)NTOK * 1024 * 2;
constexpr size_t PJ_GVT = (size_t)NTOK * 2048 * 2;
constexpr size_t PJ_AQ = 0;
constexpr size_t PJ_AG = (size_t)NTOK * 1024 * 2;
constexpr size_t PJ_AKP = (size_t)NTOK * 2048 * 2;
constexpr size_t PJ_AVPT = PJ_AKP + 4096ull * 256 * 2;

constexpr size_t OUT_STATE = 2ull * 4096 * 1024;
constexpr size_t OUT_CK = OUT_STATE + 16ull * 2 * 2 * 4 * 128 * 256;
constexpr size_t OUT_CV = OUT_CK + 16ull * 2 * 256 * 2 * 128;

constexpr int SMEM_BYTES = 73728;

struct Params {
  const float* in[20];
  float* out;
  unsigned char* ws;
  int never;
  int pad;
};
enum { I_XP = 0, I_XS, I_STATE, I_CK, I_CV, I_C, I_CCTX, I_NORMG, I_WADA, I_BADA, I_GWIN, I_GWA1, I_GWA2, I_GBA,
       I_GONORM, I_GWOUT, I_AWIN, I_AQN, I_AKN, I_AWOUT };

typedef __bf16 bf16v2 __attribute__((ext_vector_type(2)));
typedef float f32v2 __attribute__((ext_vector_type(2)));
DI unsigned pack2(float a, float b) {
  f32v2 v = {a, b};
  return __builtin_bit_cast(unsigned, __builtin_convertvector(v, bf16v2));
}
DI bfr f2bf(float x) { return (bfr)(pack2(x, x) & 0xffffu); }
DI float bf2f(bfr b) { return __uint_as_float(((unsigned)b) << 16); }
DI int fresh_tid() { int t = threadIdx.x; asm volatile("" : "+v"(t)); return t; }
DI int crow(int reg, int h) { return (reg & 3) + 8 * (reg >> 2) + 4 * h; }
DI float siluf(float x) { return x * __builtin_amdgcn_rcpf(1.f + __expf(-x)); }
DI int modrow(int row) { return row < NPT ? 0 : 1 + ((row - NPT) >> 10); }
DI const float* xrow_ptr(const Params& p, int l, int row) {
  if (l == 0) return row < NPT ? p.in[I_XP] + (size_t)row * DM : p.in[I_XS] + (size_t)(row - NPT) * DM;
  return p.out + (size_t)row * DM;
}
DI float wave_sum(float v) {
#pragma unroll
  for (int o = 32; o >= 1; o >>= 1) v += __shfl_xor(v, o);
  return v;
}
DI float half_sum(float v) {
#pragma unroll
  for (int o = 16; o >= 1; o >>= 1) v += __shfl_xor(v, o);
  return v;
}

DI void transpose_tile(const float* __restrict__ src, int src_ld, int k0, int n0, int ncols, bfr* __restrict__ dst,
                       size_t dst_ld, unsigned char* smem) {
  float* tile = (float*)smem;
  const int tid = threadIdx.x;
  const int c4 = (tid & 15) * 4, kr = tid >> 4;
#pragma unroll
  for (int j = 0; j < 4; ++j) {
    int k = kr + 16 * j;
    if (c4 < ncols) {
      float4 v = *(const float4*)(src + (size_t)(k0 + k) * src_ld + n0 + c4);
      tile[k * 65 + c4] = v.x; tile[k * 65 + c4 + 1] = v.y; tile[k * 65 + c4 + 2] = v.z; tile[k * 65 + c4 + 3] = v.w;
    }
  }
  __syncthreads();
  const int n = tid >> 2, kq = (tid & 3) * 16;
  if (n < ncols) {
    unsigned pk[8];
#pragma unroll
    for (int j = 0; j < 8; ++j) pk[j] = pack2(tile[(kq + 2 * j) * 65 + n], tile[(kq + 2 * j + 1) * 65 + n]);
    uint4* d = (uint4*)(dst + (size_t)(n0 + n) * dst_ld + k0 + kq);
    d[0] = make_uint4(pk[0], pk[1], pk[2], pk[3]);
    d[1] = make_uint4(pk[4], pk[5], pk[6], pk[7]);
  }
  __syncthreads();
}

DI void transpose_wide(const float* __restrict__ src, int src_ld, int k0, int n0, bfr* __restrict__ dst, size_t dst_ld,
                       unsigned char* smem) {
  float* tile = (float*)smem;
  const int tid = threadIdx.x;
  const int c4 = (tid & 63) * 4, kr = tid >> 6;
  f32x4 v[16];
#pragma unroll
  for (int j = 0; j < 16; ++j) GLOAD16(v[j], src + (size_t)(k0 + j * 4 + kr) * src_ld + n0 + c4);
  asm volatile("s_waitcnt vmcnt(0)"
               : "+v"(v[0]), "+v"(v[1]), "+v"(v[2]), "+v"(v[3]), "+v"(v[4]), "+v"(v[5]), "+v"(v[6]), "+v"(v[7]),
                 "+v"(v[8]), "+v"(v[9]), "+v"(v[10]), "+v"(v[11]), "+v"(v[12]), "+v"(v[13]), "+v"(v[14]), "+v"(v[15])
               :
               : "memory");
#pragma unroll
  for (int j = 0; j < 16; ++j) *(f32x4*)(tile + (j * 4 + kr) * 260 + c4) = v[j];
  __syncthreads();
  uint4* d = (uint4*)(dst + (size_t)(n0 + tid) * dst_ld + k0);
#pragma unroll
  for (int q = 0; q < 8; ++q) {
    unsigned pk[4];
#pragma unroll
    for (int j = 0; j < 4; ++j) pk[j] = pack2(tile[(q * 8 + 2 * j) * 260 + tid], tile[(q * 8 + 2 * j + 1) * 260 + tid]);
    d[q] = make_uint4(pk[0], pk[1], pk[2], pk[3]);
  }
  __syncthreads();
}

DI void mod_unit(const Params& p, int unit, unsigned char* smem) {
  const int l = unit / 96, n0 = (unit % 96) * 32;
  float* sil = (float*)smem;
  float* red = sil + 5 * 1024;
  const int tid = threadIdx.x;
  for (int e = tid; e < 5 * 1024; e += 256) {
    int r = e >> 10, k = e & 1023;
    float cv = r == 0 ? p.in[I_CCTX][k] : p.in[I_C][(r - 1) * 1024 + k];
    sil[e] = cv / (1.f + expf(-cv));
  }
  __syncthreads();
  const int kg = tid >> 5, cn = tid & 31;
  const float* w = p.in[I_WADA] + (size_t)l * 1024 * 3072 + n0 + cn + (size_t)(kg * 128) * 3072;
  float a0 = 0, a1 = 0, a2 = 0, a3 = 0, a4 = 0;
  float wa[16], wb[16];
#define MOD_ISSUE(arr, kb)                                                                                          \
  _Pragma("unroll") for (int j = 0; j < 16; ++j)                                                                    \
      asm volatile("global_load_dword %0, %1, off" : "=v"(arr[j]) : "v"(w + (size_t)((kb) * 16 + j) * 3072) : "memory")
#define MOD_WAIT(arr, n)                                                                                            \
  asm volatile("s_waitcnt vmcnt(" #n ")"                                                                            \
               : "+v"(arr[0]), "+v"(arr[1]), "+v"(arr[2]), "+v"(arr[3]), "+v"(arr[4]), "+v"(arr[5]), "+v"(arr[6]),   \
                 "+v"(arr[7]), "+v"(arr[8]), "+v"(arr[9]), "+v"(arr[10]), "+v"(arr[11]), "+v"(arr[12]),             \
                 "+v"(arr[13]), "+v"(arr[14]), "+v"(arr[15])                                                        \
               :                                                                                                    \
               : "memory")
#define MOD_USE(arr, kb)                                                                                            \
  _Pragma("unroll") for (int j = 0; j < 16; ++j) {                                                                  \
    const int k = kg * 128 + (kb) * 16 + j;                                                                         \
    const float wv = arr[j];                                                                                        \
    a0 += sil[k] * wv; a1 += sil[1024 + k] * wv; a2 += sil[2048 + k] * wv; a3 += sil[3072 + k] * wv; a4 += sil[4096 + k] * wv; \
  }
  MOD_ISSUE(wa, 0);
  MOD_ISSUE(wb, 1);
#pragma unroll
  for (int kb = 0; kb < 8; kb += 2) {
    MOD_WAIT(wa, 16);
    MOD_USE(wa, kb);
    if (kb + 2 < 8) { MOD_ISSUE(wa, kb + 2); MOD_WAIT(wb, 16); } else { MOD_WAIT(wb, 0); }
    MOD_USE(wb, kb + 1);
    if (kb + 3 < 8) MOD_ISSUE(wb, kb + 3);
  }
#undef MOD_ISSUE
#undef MOD_WAIT
#undef MOD_USE
  red[(kg * 5 + 0) * 32 + cn] = a0; red[(kg * 5 + 1) * 32 + cn] = a1; red[(kg * 5 + 2) * 32 + cn] = a2;
  red[(kg * 5 + 3) * 32 + cn] = a3; red[(kg * 5 + 4) * 32 + cn] = a4;
  __syncthreads();
  if (tid < 160) {
    int r = tid >> 5;
    float s = p.in[I_BADA][l * 3072 + n0 + cn];
#pragma unroll
    for (int g = 0; g < 8; ++g) s += red[(g * 5 + r) * 32 + cn];
    ((float*)(p.ws + OFF_MOD))[(l * 5 + r) * 3072 + n0 + cn] = s;
  }
  __syncthreads();
}

DI void p0_do_unit(const Params& p, int unit, unsigned char* smem) {
  constexpr int U_MOD = 384;
  constexpr int U_GIN = 2 * 16 * 12;
  constexpr int U_GA1 = 2 * 2 * 16;
  constexpr int U_GZ = 2;
  constexpr int U_GOUT = 2 * 16 * 4;
  constexpr int U_AIN = 2 * 16 * 10;
  constexpr int U_AOUT = 2 * 16 * 4;
  constexpr int U_ROPE = 1;
  constexpr int U_CK = 64;
  bfr* wt_gin = (bfr*)(p.ws + OFF_WT_GLA_IN);
  bfr* wt_gout = (bfr*)(p.ws + OFF_WT_GLA_OUT);
  bfr* wt_ain = (bfr*)(p.ws + OFF_WT_ATT_IN);
  bfr* wt_aout = (bfr*)(p.ws + OFF_WT_ATT_OUT);
  const int tid = threadIdx.x;
  int u = unit;
  if (u < U_MOD) { mod_unit(p, u, smem); return; }
  u -= U_MOD;
  if (u < U_GIN) {
    int i = u / 192, r = u % 192, kt = r / 12, nt = r % 12;
    transpose_wide(p.in[I_GWIN] + (size_t)i * 1024 * 3072, 3072, kt * 64, nt * 256, wt_gin + (size_t)i * GLA_NPAD * 1024, 1024, smem);
    return;
  }
  u -= U_GIN;
  if (u < U_GA1) {
    int id = u / 16, kt = u % 16;
    int i = id >> 1, d = id & 1;
    transpose_tile(p.in[I_GWA1] + (size_t)id * 1024 * 16, 16, kt * 64, 0, 16,
                   wt_gin + ((size_t)i * GLA_NPAD + 3072 + d * 16) * 1024, 1024, smem);
    return;
  }
  u -= U_GA1;
  if (u < U_GZ) {
    uint4* z = (uint4*)(wt_gin + ((size_t)u * GLA_NPAD + 3104) * 1024);
    for (int e = tid; e < 96 * 1024 / 8; e += 256) z[e] = make_uint4(0, 0, 0, 0);
    return;
  }
  u -= U_GZ;
  if (u < U_GOUT) {
    int i = u / 64, r = u % 64, kt = r / 4, nt = r % 4;
    transpose_wide(p.in[I_GWOUT] + (size_t)i * 1024 * 1024, 1024, kt * 64, nt * 256, wt_gout + (size_t)i * 1024 * 1024, 1024, smem);
    return;
  }
  u -= U_GOUT;
  if (u < U_AIN) {
    int i = u / 160, r = u % 160, kt = r / 10, nt = r % 10;
    transpose_wide(p.in[I_AWIN] + (size_t)i * 1024 * ATT_N, ATT_N, kt * 64, nt * 256, wt_ain + (size_t)i * ATT_N * 1024, 1024, smem);
    return;
  }
  u -= U_AIN;
  if (u < U_AOUT) {
    int i = u / 64, r = u % 64, kt = r / 4, nt = r % 4;
    transpose_wide(p.in[I_AWOUT] + (size_t)i * 1024 * 1024, 1024, kt * 64, nt * 256, wt_aout + (size_t)i * 1024 * 1024, 1024, smem);
    return;
  }
  u -= U_AOUT;
  if (u < U_ROPE) {
    float* rc = (float*)(p.ws + OFF_ROPE);
    float* rs = rc + 64 * 32;
    for (int e = tid; e < 2048; e += 256) {
      int pos = e >> 5, f = e & 31;
      float fr = powf(10000.0f, -(float)f / 32.0f);
      float ang = (float)pos * fr;
      rc[e] = cosf(ang);
      rs[e] = sinf(ang);
    }
    return;
  }
  u -= U_ROPE;
  if (u < U_CK) {
    bfr* ks = (bfr*)(p.ws + OFF_KS);
    f32x4 cv[8];
#pragma unroll
    for (int j = 0; j < 8; ++j) GLOAD16(cv[j], p.in[I_CK] + (size_t)u * 8192 + (size_t)(j * 256 + tid) * 4);
    asm volatile("s_waitcnt vmcnt(0)"
                 : "+v"(cv[0]), "+v"(cv[1]), "+v"(cv[2]), "+v"(cv[3]), "+v"(cv[4]), "+v"(cv[5]), "+v"(cv[6]), "+v"(cv[7])
                 :
                 : "memory");
#pragma unroll
    for (int j = 0; j < 8; ++j) {
      size_t idx = (size_t)u * 8192 + (size_t)(j * 256 + tid) * 4;
      int c = idx & 255, t = (idx >> 8) & 255, i = (idx >> 16) & 1, b = (int)(idx >> 17);
      uint2 o = make_uint2(pack2(cv[j][0], cv[j][1]), pack2(cv[j][2], cv[j][3]));
      *(uint2*)(ks + ((size_t)(i * 4 + b) * 1280 + 1024 + t) * 256 + c) = o;
    }
    return;
  }
  u -= U_CK;
  {
    int bi = u / 4, kt = u % 4;
    int b = bi >> 1, i = bi & 1;
    transpose_wide(p.in[I_CV] + (size_t)bi * 256 * 256, 256, kt * 64, 0,
                   (bfr*)(p.ws + OFF_VST) + (size_t)(i * 4 + b) * 256 * 1280 + 1024, 1280, smem);
  }
}

constexpr int P0_NEARLY = 96 + 192 + 32 + 1 + 64;
constexpr int P0_NDEFER = 288 + 192 + 32 + 1 + 64 + 545;
DI int p0_early(int e) {
  const int lo[5] = {0, 384, 768, 832, 834}, hi[5] = {96, 576, 800, 833, 898};
  int r = -1;
#pragma unroll
  for (int i = 0; i < 5; ++i) { const int sz = hi[i] - lo[i]; if (r < 0 && e >= 0 && e < sz) r = lo[i] + e; e -= sz; }
  return r;
}
DI int p0_defer(int e) {
  const int lo[6] = {96, 576, 800, 833, 898, 962}, hi[6] = {384, 768, 832, 834, 962, 1507};
  int r = -1;
#pragma unroll
  for (int i = 0; i < 6; ++i) { const int sz = hi[i] - lo[i]; if (r < 0 && e >= 0 && e < sz) r = lo[i] + e; e -= sz; }
  return r;
}
DI void phase0(const Params& p, unsigned char* smem) {
  for (int e = blockIdx.x; e < 1507; e += gridDim.x) p0_do_unit(p, e, smem);
}
DI void phase0_deferred(const Params& p, int first, int step, unsigned char* smem) {
  for (int e = first; e < P0_NDEFER; e += step) p0_do_unit(p, p0_defer(e), smem);
}

DI void phase_pre0(const Params& p) {
  const int lane = threadIdx.x & 63;
  const int gw = blockIdx.x * 4 + (threadIdx.x >> 6), nw = gridDim.x * 4;
  const float* g = p.in[I_NORMG];
  const float* mod = (const float*)(p.ws + OFF_MOD);
  bfr* h = (bfr*)(p.ws + OFF_H);
  float* rowss = (float*)(p.ws + OFF_ROWSS);
  for (int rg = gw; rg < NTOK / 4; rg += nw) {
    const int row0 = rg * 4;
    float4 v[4][4];
#pragma unroll
    for (int k = 0; k < 4; ++k) {
      const float* x = xrow_ptr(p, 0, row0 + k);
#pragma unroll
      for (int j = 0; j < 4; ++j) v[k][j] = *(const float4*)(x + lane * 4 + 256 * j);
    }
    const float* mr = mod + modrow(row0) * 3072;
    float4 ca[4];
#pragma unroll
    for (int j = 0; j < 4; ++j) {
      const int c = lane * 4 + 256 * j;
      const float4 gg = *(const float4*)(g + c);
      const float4 sc = *(const float4*)(mr + 1024 + c);
      ca[j] = make_float4(gg.x * (1.f + sc.x), gg.y * (1.f + sc.y), gg.z * (1.f + sc.z), gg.w * (1.f + sc.w));
    }
#pragma unroll
    for (int k = 0; k < 4; ++k) {
      float ss = 0.f;
#pragma unroll
      for (int j = 0; j < 4; ++j) ss += v[k][j].x * v[k][j].x + v[k][j].y * v[k][j].y + v[k][j].z * v[k][j].z + v[k][j].w * v[k][j].w;
      ss = wave_sum(ss);
      if (lane == 0) rowss[row0 + k] = ss;
#pragma unroll
      for (int j = 0; j < 4; ++j) {
        const int c = lane * 4 + 256 * j;
        *(uint2*)(h + (size_t)(row0 + k) * DM + c) =
            make_uint2(pack2(v[k][j].x * ca[j].x, v[k][j].y * ca[j].y), pack2(v[k][j].z * ca[j].z, v[k][j].w * ca[j].w));
      }
    }
  }
  float* bias2 = (float*)(p.ws + OFF_BIAS2);
  constexpr int NG = 3104, NA = 2560, NTASK = 2 * NG + 2 * NA;
  for (int task = gw; task < NTASK; task += nw) {
    int l, n;
    const bfr* wt;
    if (task < 2 * NG) { const int i = task / NG; n = task % NG; l = 2 * i; wt = (const bfr*)(p.ws + OFF_WT_GLA_IN) + ((size_t)i * GLA_NPAD + n) * 1024; }
    else { const int t2 = task - 2 * NG, i = t2 / NA; n = t2 % NA; l = 2 * i + 1; wt = (const bfr*)(p.ws + OFF_WT_ATT_IN) + ((size_t)i * ATT_N + n) * 1024; }
    u32x4 w0, w1;
    f32x4 cbv[20];
    GLOAD16(w0, wt + lane * 16);
    GLOAD16(w1, wt + lane * 16 + 8);
#pragma unroll
    for (int r = 0; r < 5; ++r)
#pragma unroll
      for (int j4 = 0; j4 < 4; ++j4) GLOAD16(cbv[r * 4 + j4], mod + (size_t)(l * 5 + r) * 3072 + lane * 16 + j4 * 4);
    asm volatile("s_waitcnt vmcnt(0)"
                 : "+v"(w0), "+v"(w1), "+v"(cbv[0]), "+v"(cbv[1]), "+v"(cbv[2]), "+v"(cbv[3]), "+v"(cbv[4]), "+v"(cbv[5]), "+v"(cbv[6]),
                   "+v"(cbv[7]), "+v"(cbv[8]), "+v"(cbv[9]), "+v"(cbv[10]), "+v"(cbv[11]), "+v"(cbv[12]), "+v"(cbv[13]), "+v"(cbv[14]),
                   "+v"(cbv[15]), "+v"(cbv[16]), "+v"(cbv[17]), "+v"(cbv[18]), "+v"(cbv[19])
                 :
                 : "memory");
    const unsigned wu[8] = {w0[0], w0[1], w0[2], w0[3], w1[0], w1[1], w1[2], w1[3]};
    float wf[16];
#pragma unroll
    for (int j = 0; j < 8; ++j) { wf[2 * j] = bf2f((bfr)(wu[j] & 0xffff)); wf[2 * j + 1] = bf2f((bfr)(wu[j] >> 16)); }
#pragma unroll
    for (int r = 0; r < 5; ++r) {
      float sacc = 0.f;
#pragma unroll
      for (int j4 = 0; j4 < 4; ++j4) {
        const f32x4 c4 = cbv[r * 4 + j4];
        sacc += c4[0] * wf[j4 * 4] + c4[1] * wf[j4 * 4 + 1] + c4[2] * wf[j4 * 4 + 2] + c4[3] * wf[j4 * 4 + 3];
      }
      sacc = wave_sum(sacc);
      if (lane == 0) bias2[(size_t)(l * 5 + r) * 3200 + n] = sacc;
    }
  }
}

DI void phase_norm(const Params& p, int l) {
  const int ftid = fresh_tid();
  const int lane = ftid & 63;
  const int gw = blockIdx.x * 4 + (ftid >> 6), nw = gridDim.x * 4;
  const float* g = p.in[I_NORMG] + l * DM;
  const float* mod = (const float*)(p.ws + OFF_MOD) + (size_t)l * 5 * 3072;
  bfr* h = (bfr*)(p.ws + OFF_H);
  for (int rg = gw; rg < NTOK / 4; rg += nw) {
    const int row0 = rg * 4;
    float4 v[4][4];
#pragma unroll
    for (int k = 0; k < 4; ++k) {
      const float* x = xrow_ptr(p, l, row0 + k);
#pragma unroll
      for (int j = 0; j < 4; ++j) v[k][j] = *(const float4*)(x + lane * 4 + 256 * j);
    }
    const float* mr = mod + modrow(row0) * 3072;
    float4 ca[4], cb[4];
#pragma unroll
    for (int j = 0; j < 4; ++j) {
      const int c = lane * 4 + 256 * j;
      const float4 gg = *(const float4*)(g + c);
      const float4 sc = *(const float4*)(mr + 1024 + c);
      cb[j] = *(const float4*)(mr + c);
      ca[j] = make_float4(gg.x * (1.f + sc.x), gg.y * (1.f + sc.y), gg.z * (1.f + sc.z), gg.w * (1.f + sc.w));
    }
#pragma unroll
    for (int k = 0; k < 4; ++k) {
      float ss = 0.f;
#pragma unroll
      for (int j = 0; j < 4; ++j) ss += v[k][j].x * v[k][j].x + v[k][j].y * v[k][j].y + v[k][j].z * v[k][j].z + v[k][j].w * v[k][j].w;
      ss = wave_sum(ss);
      const float rstd = rsqrtf(ss * (1.f / 1024.f) + EPSN);
#pragma unroll
      for (int j = 0; j < 4; ++j) {
        const int c = lane * 4 + 256 * j;
        const float o0 = v[k][j].x * rstd * ca[j].x + cb[j].x, o1 = v[k][j].y * rstd * ca[j].y + cb[j].y;
        const float o2 = v[k][j].z * rstd * ca[j].z + cb[j].z, o3 = v[k][j].w * rstd * ca[j].w + cb[j].w;
        *(uint2*)(h + (size_t)(row0 + k) * DM + c) = make_uint2(pack2(o0, o1), pack2(o2, o3));
      }
    }
  }
}

template <int NBW> struct GemmCfg {
  static constexpr int MB = NBW == 32 ? 1 : 2;
  static constexpr int NB = NBW == 128 ? 2 : 1;
  static constexpr int BSLOTS = NBW / 32;
  DI static int am(int w) { return NBW == 32 ? 32 * w : 64 * (w >> 1); }
  DI static int bn(int w) { return NBW == 128 ? 64 * (w & 1) : (NBW == 64 ? 32 * (w & 1) : 0); }
};
template <int NBW>
DI void gemm_core(const bfr* __restrict__ A, const bfr* __restrict__ Bt, int K, int m0, int n0, unsigned char* smem,
                  f32x16 (&acc)[2][2]) {
  using C = GemmCfg<NBW>;
  unsigned char* sA = smem;
  unsigned char* sB = smem + 32768;
  const int tid = fresh_tid(), lane = tid & 63, w = tid >> 6, r = lane & 31, hh = lane >> 5;
  const bfr* gA = A + (size_t)m0 * K;
  const bfr* gB = Bt + (size_t)n0 * K;
  int goff[4];
#pragma unroll
  for (int i = 0; i < 4; ++i) {
    const int row = (i * 4 + w) * 8 + (lane >> 3);
    goff[i] = row * K + (((lane & 7) ^ ((row >> 1) & 7)) << 3);
  }
#pragma unroll
  for (int a = 0; a < 2; ++a)
#pragma unroll
    for (int b = 0; b < 2; ++b)
#pragma unroll
      for (int i = 0; i < 16; ++i) acc[a][b][i] = 0.f;
#define GEMM_STAGE(buf, kt)                                                                                         \
  do {                                                                                                              \
    _Pragma("unroll") for (int i = 0; i < 4; ++i) {                                                                 \
      __builtin_amdgcn_global_load_lds((const unsigned*)(gA + goff[i] + (kt) * 64),                                 \
                                       (unsigned*)(sA + (buf) * 16384 + (i * 4 + w) * 1024), 16, 0, 0);            \
      if (i < C::BSLOTS)                                                                                            \
        __builtin_amdgcn_global_load_lds((const unsigned*)(gB + goff[i] + (kt) * 64),                               \
                                         (unsigned*)(sB + (buf) * 16384 + (i * 4 + w) * 1024), 16, 0, 0);          \
    }                                                                                                               \
  } while (0)
  GEMM_STAGE(0, 0);
  asm volatile("s_waitcnt vmcnt(0)" ::: "memory");
  __syncthreads();
  const int swz = (r >> 1) & 7;
  const int arow = (C::am(w) + r) * 128, brow = (C::bn(w) + r) * 128;
  const int KT = K >> 6;
  for (int kt = 0; kt < KT; ++kt) {
    const int cur = kt & 1;
    if (kt + 1 < KT) GEMM_STAGE(cur ^ 1, kt + 1);
    const unsigned char* cA = sA + cur * 16384 + arow;
    const unsigned char* cB = sB + cur * 16384 + brow;
#pragma unroll
    for (int kk = 0; kk < 4; ++kk) {
      const int co = ((2 * kk + hh) ^ swz) << 4;
      bf16x8 a[2], b[2];
#pragma unroll
      for (int mb = 0; mb < C::MB; ++mb) a[mb] = *(const bf16x8*)(cA + mb * 4096 + co);
#pragma unroll
      for (int nb = 0; nb < C::NB; ++nb) b[nb] = *(const bf16x8*)(cB + nb * 4096 + co);
#pragma unroll
      for (int mb = 0; mb < C::MB; ++mb)
#pragma unroll
        for (int nb = 0; nb < C::NB; ++nb) acc[mb][nb] = MFMA32(a[mb], b[nb], acc[mb][nb]);
    }
    asm volatile("s_waitcnt vmcnt(0)" ::: "memory");
    __syncthreads();
  }
#undef GEMM_STAGE
}
template <int NBW>
DI void stage_acc(const f32x16 (&acc)[2][2], float* sC) {
  using C = GemmCfg<NBW>;
  const int lane = threadIdx.x & 63, w = threadIdx.x >> 6, r = lane & 31, hh = lane >> 5;
#pragma unroll
  for (int mb = 0; mb < C::MB; ++mb)
#pragma unroll
    for (int nb = 0; nb < C::NB; ++nb)
#pragma unroll
      for (int i = 0; i < 16; ++i) sC[(C::am(w) + 32 * mb + crow(i, hh)) * 132 + C::bn(w) + 32 * nb + r] = acc[mb][nb][i];
}
DI void stage_acc_t(const f32x16 (&acc)[2][2], float* sC) {
  const int lane = threadIdx.x & 63, w = threadIdx.x >> 6, wm = w >> 1, wn = w & 1, r = lane & 31, hh = lane >> 5;
#pragma unroll
  for (int mb = 0; mb < 2; ++mb)
#pragma unroll
    for (int nb = 0; nb < 2; ++nb)
#pragma unroll
      for (int g = 0; g < 4; ++g) {
        float4 v = make_float4(acc[mb][nb][4 * g], acc[mb][nb][4 * g + 1], acc[mb][nb][4 * g + 2], acc[mb][nb][4 * g + 3]);
        *(float4*)(sC + (64 * wn + 32 * nb + r) * 132 + 64 * wm + 32 * mb + 8 * g + 4 * hh) = v;
      }
}

struct FixRegs { f32x4 q[8]; float bb[2]; };
template <int NBW>
DI void fix_issue(const Params& p, FixRegs& f, int l, int m0, int n0) {
  using C = GemmCfg<NBW>;
  const int lane = threadIdx.x & 63, w = threadIdx.x >> 6, r = lane & 31, hh = lane >> 5;
  const float* rowss = (const float*)(p.ws + OFF_ROWSS) + (size_t)l * NTOK + m0 + C::am(w) + 4 * hh;
  const float* b2 = (const float*)(p.ws + OFF_BIAS2) + (size_t)(l * 5 + modrow(m0)) * 3200 + n0 + C::bn(w) + r;
#pragma unroll
  for (int mb = 0; mb < 2; ++mb)
#pragma unroll
    for (int g = 0; g < 4; ++g) GLOAD16(f.q[mb * 4 + g], rowss + 32 * (mb < C::MB ? mb : 0) + 8 * g);
#pragma unroll
  for (int nb = 0; nb < 2; ++nb)
    asm volatile("global_load_dword %0, %1, off" : "=v"(f.bb[nb]) : "v"(b2 + 32 * (nb < C::NB ? nb : 0)) : "memory");
}
template <int NBW>
DI void fix_apply(FixRegs& f, f32x16 (&acc)[2][2]) {
  using C = GemmCfg<NBW>;
  asm volatile("s_waitcnt vmcnt(0)"
               : "+v"(f.q[0]), "+v"(f.q[1]), "+v"(f.q[2]), "+v"(f.q[3]), "+v"(f.q[4]), "+v"(f.q[5]), "+v"(f.q[6]), "+v"(f.q[7]),
                 "+v"(f.bb[0]), "+v"(f.bb[1])
               :
               : "memory");
#pragma unroll
  for (int mb = 0; mb < C::MB; ++mb)
#pragma unroll
    for (int g = 0; g < 4; ++g) {
      float rs[4];
#pragma unroll
      for (int j = 0; j < 4; ++j) rs[j] = rsqrtf(f.q[mb * 4 + g][j] * (1.f / 1024.f) + EPSN);
#pragma unroll
      for (int nb = 0; nb < C::NB; ++nb)
#pragma unroll
        for (int j = 0; j < 4; ++j) acc[mb][nb][4 * g + j] = acc[mb][nb][4 * g + j] * rs[j] + f.bb[nb];
    }
}

struct TileIter {
  int lt, step, nl, mbase, mmask, mshift;
  DI TileIter(int NT) {
    const int nblk = gridDim.x, bid = blockIdx.x;
    if ((nblk & 7) == 0) { mbase = (bid & 7) * 8; lt = bid >> 3; step = nblk >> 3; nl = 8 * NT; mmask = 7; mshift = 3; }
    else { mbase = 0; lt = bid; step = nblk; nl = 64 * NT; mmask = 63; mshift = 6; }
  }
  DI bool valid() const { return lt < nl; }
  DI int mt() const { return mbase + (lt & mmask); }
  DI int nt() const { return lt >> mshift; }
  DI void next() { lt += step; }
};

DI void phase_gla_in(const Params& p, int gi, unsigned char* smem) {
  const int lyr = 2 * gi;
  const bfr* A = (const bfr*)(p.ws + OFF_H);
  const bfr* Bt = (const bfr*)(p.ws + OFF_WT_GLA_IN) + (size_t)gi * GLA_NPAD * 1024;
  bfr* gq = (bfr*)(p.ws + OFF_PROJ + PJ_GQ);
  bfr* gk = (bfr*)(p.ws + OFF_PROJ + PJ_GK);
  bfr* gg = (bfr*)(p.ws + OFF_PROJ + PJ_GG);
  bfr* gvt = (bfr*)(p.ws + OFF_PROJ + PJ_GVT);
  float* tb = (float*)(p.ws + OFF_TBUF);
  float* sC = (float*)smem;
  const int tid = threadIdx.x;
  constexpr int NT = 25, MT = 64;
  for (TileIter ti(NT); ti.valid(); ti.next()) {
    const int mt = ti.mt(), nt = ti.nt(), m0 = mt * 128, n0 = nt * 128;
    f32x16 acc[2][2];
    if (nt == 24) {
      FixRegs fx; fix_issue<32>(p, fx, lyr, m0, 3072);
      gemm_core<32>(A, Bt, 1024, m0, 3072, smem, acc);
      fix_apply<32>(fx, acc);
      stage_acc<32>(acc, sC);
      __syncthreads();
#pragma unroll
      for (int it = 0; it < 4; ++it) {
        int idx = it * 256 + tid, row = idx >> 3, c4 = (idx & 7) * 4;
        *(float4*)(tb + (size_t)(m0 + row) * 32 + c4) = *(const float4*)(sC + row * 132 + c4);
      }
      __syncthreads();
      continue;
    }
    FixRegs fx; fix_issue<128>(p, fx, lyr, m0, n0);
    gemm_core<128>(A, Bt, 1024, m0, n0, smem, acc);
    fix_apply<128>(fx, acc);
    if (nt >= 8 && nt < 16) {
      stage_acc_t(acc, sC);
      __syncthreads();
#pragma unroll 4
      for (int it = 0; it < 16; ++it) {
        int idx = it * 256 + tid, col = idx >> 5, r4 = (idx & 31) * 4;
        float4 v = *(const float4*)(sC + col * 132 + r4);
        *(uint2*)(gvt + (size_t)((nt - 8) * 128 + col) * NTOK + m0 + r4) = make_uint2(pack2(v.x, v.y), pack2(v.z, v.w));
      }
    } else {
      stage_acc<128>(acc, sC);
      __syncthreads();
#pragma unroll 4
      for (int it = 0; it < 16; ++it) {
        int idx = it * 256 + tid, row = idx >> 5, c4 = (idx & 31) * 4;
        float4 v = *(const float4*)(sC + row * 132 + c4);
        size_t grow = m0 + row;
        if (nt < 4) {
          const float s = 0.08838834764831845f;
          *(uint2*)(gq + grow * 512 + n0 + c4) = make_uint2(pack2(v.x * s, v.y * s), pack2(v.z * s, v.w * s));
        } else if (nt < 8) {
          *(uint2*)(gk + grow * 512 + (n0 - 512) + c4) = make_uint2(pack2(v.x, v.y), pack2(v.z, v.w));
        } else {
          *(uint2*)(gg + grow * 1024 + (n0 - 2048) + c4) =
              make_uint2(pack2(siluf(v.x), siluf(v.y)), pack2(siluf(v.z), siluf(v.w)));
        }
      }
    }
    __syncthreads();
  }
}

DI void phase_gla_prep(const Params& p, int gi, unsigned char* smem) {
  const bfr* gq = (const bfr*)(p.ws + OFF_PROJ + PJ_GQ);
  const bfr* gk = (const bfr*)(p.ws + OFF_PROJ + PJ_GK);
  const float* tb = (const float*)(p.ws + OFF_TBUF);
  bfr* qe_o = (bfr*)(p.ws + OFF_QE);
  bfr* kdt_o = (bfr*)(p.ws + OFF_KDT);
  bfr* a_o = (bfr*)(p.ws + OFF_ABUF);
  float* el_o = (float*)(p.ws + OFF_ELAST);
  bfr* sQ = (bfr*)smem;
  bfr* sK = sQ + 64 * 136;
  float* tl = (float*)(sK + 64 * 136);
  float* tot = tl + 64 * 16;
  const int tid = fresh_tid(), lane = tid & 63, w = tid >> 6, r = lane & 31, hh = lane >> 5;
  const int dk = tid & 127, half = tid >> 7;
  for (int u = blockIdx.x; u < 1024; u += gridDim.x) {
    const int d = u >> 9, cgi = (u >> 2) & 127, hd = u & 3;
    const int token0 = cgi * 64;
    {
      u32x4 lq[4], lk[4];
      f32x4 lt;
      GLOAD16(lt, tb + (size_t)(token0 + (tid >> 2)) * 32 + d * 16 + (tid & 3) * 4);
#pragma unroll
      for (int j = 0; j < 4; ++j) {
        int id = j * 256 + tid, row = id >> 4, ch = (id & 15) * 8;
        GLOAD16(lq[j], gq + (size_t)(token0 + row) * 512 + hd * 128 + ch);
        GLOAD16(lk[j], gk + (size_t)(token0 + row) * 512 + hd * 128 + ch);
      }
      asm volatile("s_waitcnt vmcnt(0)"
                   : "+v"(lt), "+v"(lq[0]), "+v"(lq[1]), "+v"(lq[2]), "+v"(lq[3]), "+v"(lk[0]), "+v"(lk[1]), "+v"(lk[2]), "+v"(lk[3])
                   :
                   : "memory");
      *(f32x4*)(tl + (tid >> 2) * 16 + (tid & 3) * 4) = lt;
#pragma unroll
      for (int j = 0; j < 4; ++j) {
        int id = j * 256 + tid, row = id >> 4, ch = (id & 15) * 8;
        *(u32x4*)(sQ + row * 136 + ch) = lq[j];
        *(u32x4*)(sK + row * 136 + ch) = lk[j];
      }
    }
    float w2[16];
    const float* wa2 = p.in[I_GWA2] + (size_t)(gi * 2 + d) * 16 * 512 + hd * 128 + dk;
#pragma unroll
    for (int j = 0; j < 16; ++j) w2[j] = wa2[j * 512];
    const float bias = p.in[I_GBA][(gi * 2 + d) * 512 + hd * 128 + dk];
    __syncthreads();
    float pc[32];
    float cum = 0.f;
#pragma unroll
    for (int sl = 0; sl < 32; ++sl) {
      const float* tr = tl + (half * 32 + sl) * 16;
      float z = bias;
#pragma unroll
      for (int j4 = 0; j4 < 4; ++j4) {
        float4 tv = *(const float4*)(tr + j4 * 4);
        z += tv.x * w2[j4 * 4] + tv.y * w2[j4 * 4 + 1] + tv.z * w2[j4 * 4 + 2] + tv.w * w2[j4 * 4 + 3];
      }
      float lg = (fminf(z, 0.f) - __logf(1.f + __expf(-fabsf(z)))) * (1.f / 16.f);
      cum += lg;
      pc[sl] = cum;
    }
    tot[half * 128 + dk] = cum;
    __syncthreads();
    const float t0 = tot[dk], t1 = tot[128 + dk];
    const float total = t0 + t1;
    const float base = half ? t0 : 0.f;
    const float etot = __expf(total);
    if (half == 0) el_o[(size_t)u * 128 + dk] = etot;
    unsigned kdp[16];
    float kd_prev = 0.f;
#pragma unroll
    for (int sl = 0; sl < 32; ++sl) {
      const int s = half * 32 + sl;
      const float pin = base + pc[sl];
      const float pex = base + (sl == 0 ? 0.f : pc[sl == 0 ? 0 : sl - 1]);
      const float b = d ? (total - pex) : pin;
      const float qv = bf2f(sQ[s * 136 + dk]), kv = bf2f(sK[s * 136 + dk]);
      const float eb = __expf(b), enb = __builtin_amdgcn_rcpf(eb);
      const float qe = qv * eb, ke = kv * enb, kd = kv * (etot * enb);
      sQ[s * 136 + dk] = f2bf(qe);
      sK[s * 136 + dk] = f2bf(ke);
      if (sl & 1) kdp[sl >> 1] = pack2(kd_prev, kd); else kd_prev = kd;
    }
    {
      uint4* dst = (uint4*)(kdt_o + ((size_t)u * 128 + dk) * 64 + half * 32);
      dst[0] = make_uint4(kdp[0], kdp[1], kdp[2], kdp[3]);
      dst[1] = make_uint4(kdp[4], kdp[5], kdp[6], kdp[7]);
      dst[2] = make_uint4(kdp[8], kdp[9], kdp[10], kdp[11]);
      dst[3] = make_uint4(kdp[12], kdp[13], kdp[14], kdp[15]);
    }
    __syncthreads();
#pragma unroll
    for (int j = 0; j < 4; ++j) {
      int id = j * 256 + tid, row = id >> 4, ch = (id & 15) * 8;
      *(uint4*)(qe_o + ((size_t)u * 64 + row) * 128 + ch) = *(const uint4*)(sQ + row * 136 + ch);
    }
    const int sb = w >> 1, tbk = w & 1;
    f32x16 acc;
#pragma unroll
    for (int i = 0; i < 16; ++i) acc[i] = 0.f;
#pragma unroll
    for (int kk = 0; kk < 8; ++kk) {
      bf16x8 a = *(const bf16x8*)(sK + (32 * sb + r) * 136 + 16 * kk + 8 * hh);
      bf16x8 b = *(const bf16x8*)(sQ + (32 * tbk + r) * 136 + 16 * kk + 8 * hh);
      acc = MFMA32(a, b, acc);
    }
    const int t = 32 * tbk + r;
#pragma unroll
    for (int g = 0; g < 4; ++g) {
      const int s4 = 32 * sb + 8 * g + 4 * hh;
      float v[4];
#pragma unroll
      for (int j = 0; j < 4; ++j) {
        const int s = s4 + j;
        const bool keep = d ? (s >= t) : (s <= t);
        v[j] = keep ? acc[4 * g + j] : 0.f;
      }
      *(uint2*)(a_o + ((size_t)u * 64 + t) * 64 + s4) = make_uint2(pack2(v[0], v[1]), pack2(v[2], v[3]));
    }
    __syncthreads();
  }
}

DI void gla_scan_unit(const Params& p, int gi, bool sample, int b, int rem, unsigned char* smem) {
  const int hd = rem >> 3, d = (rem >> 2) & 1, sp = rem & 3;
  const int nch = sample ? 16 : 4;
  const int cg0 = sample ? 64 + b * 16 : b * 4;
  const bfr* qe_i = (const bfr*)(p.ws + OFF_QE);
  const bfr* kdt_i = (const bfr*)(p.ws + OFF_KDT);
  const bfr* a_i = (const bfr*)(p.ws + OFF_ABUF);
  const float* el_i = (const float*)(p.ws + OFF_ELAST);
  const bfr* gvt = (const bfr*)(p.ws + OFF_PROJ + PJ_GVT);
  bfr* o_o = (bfr*)(p.ws + OFF_O) + (size_t)d * NTOK * 1024;
  bfr* sSt = (bfr*)smem;
  bfr* sQ = sSt + 64 * 136;
  bfr* sA = sQ + 64 * 136;
  bfr* sV = sA + 64 * 72;
  bfr* sKd = sV + 64 * 72;
  const int tid = fresh_tid(), lane = tid & 63, w = tid >> 6, r = lane & 31, hh = lane >> 5;
  f32x16 S[2];
  if (sample) {
    const float* st = p.in[I_STATE] + ((((size_t)(b * 2 + gi) * 2 + d) * 4 + hd) * 128) * 256 + sp * 64;
#pragma unroll
    for (int nb = 0; nb < 2; ++nb)
#pragma unroll
      for (int i = 0; i < 16; ++i) S[nb][i] = st[(size_t)(32 * w + crow(i, hh)) * 256 + 32 * nb + r];
  } else {
#pragma unroll
    for (int nb = 0; nb < 2; ++nb)
#pragma unroll
      for (int i = 0; i < 16; ++i) S[nb][i] = 0.f;
  }
  u32x4 pq[4], pa[2], pv[2], pkd[4];
  float pel;
  float* sEl = (float*)(sKd + 128 * 72);
#define SCAN_ISSUE(cc)                                                                                              \
  do {                                                                                                              \
    const int cl_ = d ? nch - 1 - (cc) : (cc);                                                                      \
    const int cgi_ = cg0 + cl_;                                                                                     \
    const int u_ = (d * 128 + cgi_) * 4 + hd;                                                                       \
    const int token0_ = cgi_ * 64;                                                                                  \
    _Pragma("unroll") for (int j = 0; j < 4; ++j) {                                                                 \
      int id = j * 256 + tid, row = id >> 4, ch = (id & 15) * 8;                                                    \
      GLOAD16(pq[j], qe_i + ((size_t)u_ * 64 + row) * 128 + ch);                                                    \
    }                                                                                                               \
    _Pragma("unroll") for (int j = 0; j < 2; ++j) {                                                                 \
      int id = j * 256 + tid, row = id >> 3, ch = (id & 7) * 8;                                                     \
      GLOAD16(pa[j], a_i + ((size_t)u_ * 64 + row) * 64 + ch);                                                      \
      GLOAD16(pv[j], gvt + (size_t)(hd * 256 + sp * 64 + row) * NTOK + token0_ + ch);                               \
    }                                                                                                               \
    _Pragma("unroll") for (int j = 0; j < 4; ++j) {                                                                 \
      int id = j * 256 + tid, row = id >> 3, ch = (id & 7) * 8;                                                     \
      GLOAD16(pkd[j], kdt_i + ((size_t)u_ * 128 + row) * 64 + ch);                                                  \
    }                                                                                                               \
    asm volatile("global_load_dword %0, %1, off" : "=v"(pel) : "v"(el_i + (size_t)u_ * 128 + (tid & 127)) : "memory"); \
  } while (0)
  SCAN_ISSUE(0);
  for (int c = 0; c < nch; ++c) {
    const int cl = d ? nch - 1 - c : c;
    const int cgi = cg0 + cl;
    const int token0 = cgi * 64;
    asm volatile("s_waitcnt vmcnt(0)"
                 : "+v"(pq[0]), "+v"(pq[1]), "+v"(pq[2]), "+v"(pq[3]), "+v"(pa[0]), "+v"(pa[1]), "+v"(pv[0]), "+v"(pv[1]),
                   "+v"(pkd[0]), "+v"(pkd[1]), "+v"(pkd[2]), "+v"(pkd[3]), "+v"(pel)
                 :
                 : "memory");
#pragma unroll
    for (int j = 0; j < 4; ++j) {
      int id = j * 256 + tid, row = id >> 4, ch = (id & 15) * 8;
      *(u32x4*)(sQ + row * 136 + ch) = pq[j];
    }
#pragma unroll
    for (int j = 0; j < 2; ++j) {
      int id = j * 256 + tid, row = id >> 3, ch = (id & 7) * 8;
      *(u32x4*)(sA + row * 72 + ch) = pa[j];
      *(u32x4*)(sV + row * 72 + ch) = pv[j];
    }
#pragma unroll
    for (int j = 0; j < 4; ++j) {
      int id = j * 256 + tid, row = id >> 3, ch = (id & 7) * 8;
      *(u32x4*)(sKd + row * 72 + ch) = pkd[j];
    }
    if (tid < 128) sEl[tid] = pel;
#pragma unroll
    for (int nb = 0; nb < 2; ++nb)
#pragma unroll
      for (int g = 0; g < 4; ++g)
        *(uint2*)(sSt + (32 * nb + r) * 136 + 32 * w + 8 * g + 4 * hh) =
            make_uint2(pack2(S[nb][4 * g], S[nb][4 * g + 1]), pack2(S[nb][4 * g + 2], S[nb][4 * g + 3]));
    asm volatile("s_waitcnt lgkmcnt(0)" ::: "memory");
    SCAN_ISSUE(c + 1 < nch ? c + 1 : c);
    __syncthreads();
    {
      const int tbk = w >> 1, nbo = w & 1;
      f32x16 oa, ob;
#pragma unroll
      for (int i = 0; i < 16; ++i) { oa[i] = 0.f; ob[i] = 0.f; }
#pragma unroll
      for (int kk = 0; kk < 8; ++kk) {
        bf16x8 a = *(const bf16x8*)(sQ + (32 * tbk + r) * 136 + 16 * kk + 8 * hh);
        bf16x8 bb = *(const bf16x8*)(sSt + (32 * nbo + r) * 136 + 16 * kk + 8 * hh);
        if (kk & 1) ob = MFMA32(a, bb, ob); else oa = MFMA32(a, bb, oa);
      }
#pragma unroll
      for (int kk = 0; kk < 4; ++kk) {
        bf16x8 a = *(const bf16x8*)(sA + (32 * tbk + r) * 72 + 16 * kk + 8 * hh);
        bf16x8 bb = *(const bf16x8*)(sV + (32 * nbo + r) * 72 + 16 * kk + 8 * hh);
        if (kk & 1) ob = MFMA32(a, bb, ob); else oa = MFMA32(a, bb, oa);
      }
#pragma unroll
      for (int i = 0; i < 16; ++i) oa[i] += ob[i];
#pragma unroll
      for (int i = 0; i < 16; ++i)
        o_o[(size_t)(token0 + 32 * tbk + crow(i, hh)) * 1024 + hd * 256 + sp * 64 + 32 * nbo + r] = f2bf(oa[i]);
    }
    f32x4 el[4];
#pragma unroll
    for (int g = 0; g < 4; ++g) el[g] = *(const f32x4*)(sEl + 32 * w + 8 * g + 4 * hh);
#pragma unroll
    for (int nb = 0; nb < 2; ++nb)
#pragma unroll
      for (int g = 0; g < 4; ++g) {
        S[nb][4 * g] *= el[g][0]; S[nb][4 * g + 1] *= el[g][1]; S[nb][4 * g + 2] *= el[g][2]; S[nb][4 * g + 3] *= el[g][3];
      }
#pragma unroll
    for (int kk = 0; kk < 4; ++kk) {
      bf16x8 a = *(const bf16x8*)(sKd + (32 * w + r) * 72 + 16 * kk + 8 * hh);
#pragma unroll
      for (int nb = 0; nb < 2; ++nb) {
        bf16x8 bb = *(const bf16x8*)(sV + (32 * nb + r) * 72 + 16 * kk + 8 * hh);
        S[nb] = MFMA32(a, bb, S[nb]);
      }
    }
    __syncthreads();
  }
#undef SCAN_ISSUE
  asm volatile("s_waitcnt vmcnt(0)"
               : "+v"(pq[0]), "+v"(pq[1]), "+v"(pq[2]), "+v"(pq[3]), "+v"(pa[0]), "+v"(pa[1]), "+v"(pv[0]), "+v"(pv[1]),
                 "+v"(pkd[0]), "+v"(pkd[1]), "+v"(pkd[2]), "+v"(pkd[3]), "+v"(pel)
               :
               : "memory");
  if (!sample) {
    float* so = p.out + OUT_STATE + ((((size_t)(b * 2 + gi) * 2 + d) * 4 + hd) * 128) * 256 + sp * 64;
#pragma unroll
    for (int nb = 0; nb < 2; ++nb)
#pragma unroll
      for (int i = 0; i < 16; ++i) so[(size_t)(32 * w + crow(i, hh)) * 256 + 32 * nb + r] = S[nb][i];
  }
}
DI void phase_gla_scan(const Params& p, int gi, unsigned char* smem) {
  const int nb = gridDim.x, bid = blockIdx.x;
  int idx, step;
  if (nb >= 256) { idx = bid; step = bid < 128 ? 640 : nb - 128; }
  else { idx = bid; step = nb; }
  for (; idx < 640; idx += step) {
    const bool sample = idx < 128;
    const int q = sample ? idx : idx - 128;
    gla_scan_unit(p, gi, sample, q >> 5, q & 31, smem);
  }
}

DI void phase_gla_post(const Params& p, int gi) {
  const int ftid = fresh_tid();
  const int lane = ftid & 63;
  const int gw = blockIdx.x * 4 + (ftid >> 6), nw = gridDim.x * 4;
  const bfr* o0 = (const bfr*)(p.ws + OFF_O);
  const bfr* o1 = o0 + (size_t)NTOK * 1024;
  const bfr* gg = (const bfr*)(p.ws + OFF_PROJ + PJ_GG);
  bfr* uo = (bfr*)(p.ws + OFF_U);
  const float4 on = *(const float4*)(p.in[I_GONORM] + gi * 256 + lane * 4);
  for (int rg = gw; rg < NTOK / 2; rg += nw) {
    uint2 a[8], b[8], g[8];
#pragma unroll
    for (int q = 0; q < 8; ++q) {
      const size_t idx = (size_t)(rg * 2 + (q >> 2)) * 1024 + (q & 3) * 256 + lane * 4;
      a[q] = *(const uint2*)(o0 + idx); b[q] = *(const uint2*)(o1 + idx); g[q] = *(const uint2*)(gg + idx);
    }
#pragma unroll
    for (int q = 0; q < 8; ++q) {
      const size_t idx = (size_t)(rg * 2 + (q >> 2)) * 1024 + (q & 3) * 256 + lane * 4;
      float v0 = bf2f(a[q].x & 0xffff) + bf2f(b[q].x & 0xffff), v1 = bf2f(a[q].x >> 16) + bf2f(b[q].x >> 16);
      float v2 = bf2f(a[q].y & 0xffff) + bf2f(b[q].y & 0xffff), v3 = bf2f(a[q].y >> 16) + bf2f(b[q].y >> 16);
      float ss = wave_sum(v0 * v0 + v1 * v1 + v2 * v2 + v3 * v3);
      float rstd = rsqrtf(ss * (1.f / 256.f) + EPSN);
      float r0 = v0 * rstd * on.x * bf2f(g[q].x & 0xffff), r1 = v1 * rstd * on.y * bf2f(g[q].x >> 16);
      float r2 = v2 * rstd * on.z * bf2f(g[q].y & 0xffff), r3 = v3 * rstd * on.w * bf2f(g[q].y >> 16);
      *(uint2*)(uo + idx) = make_uint2(pack2(r0, r1), pack2(r2, r3));
    }
  }
}

DI void phase_out_proj(const Params& p, int l, const bfr* Bt, unsigned char* smem) {
  const bfr* A = (const bfr*)(p.ws + OFF_U);
  const float* mod = (const float*)(p.ws + OFF_MOD) + (size_t)l * 5 * 3072;
  float* sC = (float*)smem;
  const int tid = threadIdx.x;
  for (TileIter ti(8); ti.valid(); ti.next()) {
    const int mt = ti.mt(), nt = ti.nt(), m0 = mt * 128, n0 = nt * 128;
    const int erow = tid >> 5, ec4 = (tid & 31) * 4;
    f32x4 xo[8], gtv, ngv, nsv;
#pragma unroll
    for (int it = 0; it < 8; ++it) GLOAD16(xo[it], xrow_ptr(p, l, m0 + it * 8 + erow) + n0 + ec4);
    GLOAD16(gtv, mod + modrow(m0) * 3072 + 2048 + n0 + ec4);
    GLOAD16(ngv, p.in[I_NORMG] + (l < 3 ? l + 1 : l) * DM + n0 + ec4);
    GLOAD16(nsv, mod + (l < 3 ? 5 * 3072 : 0) + modrow(m0) * 3072 + 1024 + n0 + ec4);
    f32x16 acc[2][2];
    gemm_core<128>(A, Bt, 1024, m0, n0, smem, acc);
    stage_acc<128>(acc, sC);
#pragma unroll
    for (int hb = 0; hb < 2; ++hb) {
      asm volatile("s_waitcnt vmcnt(0)"
                   : "+v"(xo[0]), "+v"(xo[1]), "+v"(xo[2]), "+v"(xo[3]), "+v"(xo[4]), "+v"(xo[5]), "+v"(xo[6]), "+v"(xo[7]), "+v"(gtv), "+v"(ngv), "+v"(nsv)
                   :
                   : "memory");
      if (hb == 0) __syncthreads();
      f32x4 o[8];
#pragma unroll
      for (int it = 0; it < 8; ++it) {
        const int row = hb * 64 + it * 8 + erow;
        const float4 v = *(const float4*)(sC + row * 132 + ec4);
        o[it][0] = xo[it][0] + gtv[0] * v.x; o[it][1] = xo[it][1] + gtv[1] * v.y;
        o[it][2] = xo[it][2] + gtv[2] * v.z; o[it][3] = xo[it][3] + gtv[3] * v.w;
      }
      if (hb == 0) {
#pragma unroll
        for (int it = 0; it < 8; ++it) GLOAD16(xo[it], xrow_ptr(p, l, m0 + 64 + it * 8 + erow) + n0 + ec4);
      }
#pragma unroll
      for (int it = 0; it < 8; ++it) *(f32x4*)(p.out + (size_t)(m0 + hb * 64 + it * 8 + erow) * DM + n0 + ec4) = o[it];
      if (l < 3) {
        const float c0 = ngv[0] * (1.f + nsv[0]), c1 = ngv[1] * (1.f + nsv[1]), c2 = ngv[2] * (1.f + nsv[2]), c3 = ngv[3] * (1.f + nsv[3]);
        float mine = 0.f;
#pragma unroll
        for (int it = 0; it < 8; ++it) {
          const int grow = m0 + hb * 64 + it * 8 + erow;
          const float ss = half_sum(o[it][0] * o[it][0] + o[it][1] * o[it][1] + o[it][2] * o[it][2] + o[it][3] * o[it][3]);
          if ((tid & 31) == it) mine = ss;
          *(uint2*)((bfr*)(p.ws + OFF_H) + (size_t)grow * DM + n0 + ec4) =
              make_uint2(pack2(o[it][0] * c0, o[it][1] * c1), pack2(o[it][2] * c2, o[it][3] * c3));
        }
        if ((tid & 31) < 8)
          atomicAdd((float*)(p.ws + OFF_ROWSS) + (size_t)(l + 1) * NTOK + m0 + hb * 64 + (tid & 31) * 8 + erow, mine);
      }
    }
    __syncthreads();
  }
}

DI void phase_att_in(const Params& p, int ai, unsigned char* smem) {
  const int lyr = 2 * ai + 1;
  const bfr* A = (const bfr*)(p.ws + OFF_H);
  const bfr* Bt = (const bfr*)(p.ws + OFF_WT_ATT_IN) + (size_t)ai * ATT_N * 1024;
  bfr* aq = (bfr*)(p.ws + OFF_PROJ + PJ_AQ);
  bfr* ag = (bfr*)(p.ws + OFF_PROJ + PJ_AG);
  bfr* akp = (bfr*)(p.ws + OFF_PROJ + PJ_AKP);
  bfr* avpt = (bfr*)(p.ws + OFF_PROJ + PJ_AVPT);
  bfr* ks = (bfr*)(p.ws + OFF_KS);
  bfr* vst = (bfr*)(p.ws + OFF_VST);
  const float* rc = (const float*)(p.ws + OFF_ROPE);
  const float* rs = rc + 64 * 32;
  const float* qn = p.in[I_AQN] + ai * 128;
  const float* kn = p.in[I_AKN] + ai * 128;
  float* sC = (float*)smem;
  const int tid = threadIdx.x;
  constexpr int NT = 20, MT = 64;
  for (TileIter ti(24); ti.valid(); ti.next()) {
    f32x16 acc[2][2];
    const int nfull = (ti.mmask + 1) * 16;
    if (ti.lt >= nfull) {
      const int ht = ti.lt - nfull, m0h = (ti.mbase + (ht & ti.mmask)) * 128, n0h = 2048 + (ht >> ti.mshift) * 64;
      FixRegs fx; fix_issue<64>(p, fx, lyr, m0h, n0h);
      gemm_core<64>(A, Bt, 1024, m0h, n0h, smem, acc);
      fix_apply<64>(fx, acc);
      stage_acc<64>(acc, sC);
      __syncthreads();
#pragma unroll 4
      for (int it = 0; it < 8; ++it) {
        int idx = it * 256 + tid, row = idx >> 4, c4 = (idx & 15) * 4;
        float4 v = *(const float4*)(sC + row * 132 + c4);
        *(uint2*)(ag + (size_t)(m0h + row) * 1024 + (n0h - 1536) + c4) =
            make_uint2(pack2(siluf(v.x), siluf(v.y)), pack2(siluf(v.z), siluf(v.w)));
      }
      __syncthreads();
      continue;
    }
    const int mt = ti.mt(), nt = ti.nt(), m0 = mt * 128, n0 = nt * 128;
    const bool samp = m0 >= NPT;
    FixRegs fx; fix_issue<128>(p, fx, lyr, m0, n0);
    gemm_core<128>(A, Bt, 1024, m0, n0, smem, acc);
    fix_apply<128>(fx, acc);
    if (nt == 10 || nt == 11) {
      const int hk = nt - 10;
      stage_acc_t(acc, sC);
      __syncthreads();
      bfr* dst; size_t ldt;
      if (!samp) { int b = m0 >> 8, t0 = m0 & 255; dst = avpt + (size_t)((b * 2 + hk) * 128) * 256 + t0; ldt = 256; }
      else { int b = (m0 - NPT) >> 10, t0 = (m0 - NPT) & 1023; dst = vst + (size_t)(((ai * 4 + b) * 2 + hk) * 128) * 1280 + t0; ldt = 1280; }
#pragma unroll 4
      for (int it = 0; it < 16; ++it) {
        int idx = it * 256 + tid, col = idx >> 5, r4 = (idx & 31) * 4;
        float4 v = *(const float4*)(sC + col * 132 + r4);
        *(uint2*)(dst + (size_t)col * ldt + r4) = make_uint2(pack2(v.x, v.y), pack2(v.z, v.w));
      }
      if (!samp) {
        __syncthreads();
        stage_acc<128>(acc, sC);
        __syncthreads();
        const int b = m0 >> 8, t0 = m0 & 255;
#pragma unroll 4
        for (int it = 0; it < 16; ++it) {
          int idx = it * 256 + tid, row = idx >> 5, c4 = (idx & 31) * 4;
          float4 v = *(const float4*)(sC + row * 132 + c4);
          *(float4*)(p.out + OUT_CV + ((((size_t)b * 2 + ai) * 256 + t0 + row) * 2 + hk) * 128 + c4) = v;
        }
      }
    } else {
      stage_acc<128>(acc, sC);
      __syncthreads();
      const int c4 = (tid & 31) * 4;
      const float* wn = nt < 8 ? qn : kn;
      const float4 wv = *(const float4*)(wn + c4), pw = *(const float4*)(wn + (c4 ^ 32));
#pragma unroll 2
      for (int it = 0; it < 16; ++it) {
        const int row = it * 8 + (tid >> 5);
        float4 v = *(const float4*)(sC + row * 132 + c4);
        const int grow = m0 + row;
        if (nt >= 12) {
          *(uint2*)(ag + (size_t)grow * 1024 + (n0 - 1536) + c4) =
              make_uint2(pack2(siluf(v.x), siluf(v.y)), pack2(siluf(v.z), siluf(v.w)));
        } else {
          float ss = half_sum(v.x * v.x + v.y * v.y + v.z * v.z + v.w * v.w);
          const float rstd = rsqrtf(ss * (1.f / 128.f) + EPSN);
          float4 xn = make_float4(v.x * rstd * wv.x, v.y * rstd * wv.y, v.z * rstd * wv.z, v.w * rstd * wv.w);
          float4 o = xn;
          if (samp) {
            const int cp = c4 ^ 32;
            float4 pv = *(const float4*)(sC + row * 132 + cp);
            float4 pn = make_float4(pv.x * rstd * pw.x, pv.y * rstd * pw.y, pv.z * rstd * pw.z, pv.w * rstd * pw.w);
            const int t = (grow - NPT) & 1023;
            const int pos = (c4 < 64) ? (t >> 6) : (t & 63);
            float4 cs = *(const float4*)(rc + pos * 32 + (c4 & 31));
            float4 sn = *(const float4*)(rs + pos * 32 + (c4 & 31));
            const float sg = (c4 & 32) ? 1.f : -1.f;
            o = make_float4(xn.x * cs.x + sg * pn.x * sn.x, xn.y * cs.y + sg * pn.y * sn.y,
                            xn.z * cs.z + sg * pn.z * sn.z, xn.w * cs.w + sg * pn.w * sn.w);
          }
          if (nt < 8) {
            const float s = 0.08838834764831845f * 1.4426950408889634f;
            *(uint2*)(aq + (size_t)grow * 1024 + n0 + c4) = make_uint2(pack2(o.x * s, o.y * s), pack2(o.z * s, o.w * s));
          } else {
            const int hk = nt - 8;
            uint2 ob = make_uint2(pack2(o.x, o.y), pack2(o.z, o.w));
            if (!samp) {
              const int b = grow >> 8, t = grow & 255;
              *(float4*)(p.out + OUT_CK + ((((size_t)b * 2 + ai) * 256 + t) * 2 + hk) * 128 + c4) = o;
              *(uint2*)(akp + (size_t)grow * 256 + hk * 128 + c4) = ob;
            } else {
              const int b = (grow - NPT) >> 10, t = (grow - NPT) & 1023;
              *(uint2*)(ks + ((size_t)(ai * 4 + b) * 1280 + t) * 256 + hk * 128 + c4) = ob;
            }
          }
        }
      }
    }
    __syncthreads();
  }
}

DI void attn_unit(const Params& p, int ai, bool sample, int unit, unsigned char* smem) {
  int b, hkv, qb, ntile, tokq0;
  const bfr* Kb; const bfr* Vb; size_t ldt;
  if (sample) {
    b = unit >> 6; hkv = (unit >> 5) & 1; qb = unit & 31; ntile = 20;
    tokq0 = NPT + b * 1024 + qb * 32;
    Kb = (const bfr*)(p.ws + OFF_KS) + (size_t)(ai * 4 + b) * 1280 * 256 + hkv * 128;
    Vb = (const bfr*)(p.ws + OFF_VST) + (size_t)(((ai * 4 + b) * 2 + hkv) * 128) * 1280; ldt = 1280;
  } else {
    b = unit >> 4; hkv = (unit >> 3) & 1; qb = unit & 7; ntile = 4;
    tokq0 = b * 256 + qb * 32;
    Kb = (const bfr*)(p.ws + OFF_PROJ + PJ_AKP) + (size_t)(b * 256) * 256 + hkv * 128;
    Vb = (const bfr*)(p.ws + OFF_PROJ + PJ_AVPT) + (size_t)((b * 2 + hkv) * 128) * 256; ldt = 256;
  }
  const bfr* aq = (const bfr*)(p.ws + OFF_PROJ + PJ_AQ);
  const bfr* ag = (const bfr*)(p.ws + OFF_PROJ + PJ_AG);
  bfr* uo = (bfr*)(p.ws + OFF_U);
  const int tid = fresh_tid(), lane = tid & 63, w = tid >> 6, r = lane & 31, hh = lane >> 5;
  const int hq = hkv * 4 + w;
  unsigned char* sK = smem;
  unsigned char* sV = smem + 32768;
  bf16x8 qf[8];
#pragma unroll
  for (int kk = 0; kk < 8; ++kk) qf[kk] = *(const bf16x8*)(aq + (size_t)(tokq0 + r) * 1024 + hq * 128 + 16 * kk + 8 * hh);
  f32x16 oacc[4];
#pragma unroll
  for (int a = 0; a < 4; ++a)
#pragma unroll
    for (int i = 0; i < 16; ++i) oacc[a][i] = 0.f;
  float m_run = -INFINITY, l_run = 0.f;
  int koff[4], voff[4];
#pragma unroll
  for (int i = 0; i < 4; ++i) {
    const int krow = (i * 4 + w) * 4 + (lane >> 4);
    koff[i] = krow * 256 + (((lane & 15) ^ (krow & 15)) << 3);
    const int vrow = (i * 4 + w) * 8 + (lane >> 3);
    voff[i] = vrow * (int)ldt + (((lane & 7) ^ ((vrow >> 1) & 7)) << 3);
  }
#define ATT_STAGE(buf, kt)                                                                                          \
  do {                                                                                                              \
    _Pragma("unroll") for (int i = 0; i < 4; ++i) {                                                                 \
      __builtin_amdgcn_global_load_lds((const unsigned*)(Kb + koff[i] + (kt) * (64 * 256)),                         \
                                       (unsigned*)(sK + (buf) * 16384 + (i * 4 + w) * 1024), 16, 0, 0);            \
      __builtin_amdgcn_global_load_lds((const unsigned*)(Vb + voff[i] + (kt) * 64),                                 \
                                       (unsigned*)(sV + (buf) * 16384 + (i * 4 + w) * 1024), 16, 0, 0);            \
    }                                                                                                               \
  } while (0)
  ATT_STAGE(0, 0);
  asm volatile("s_waitcnt vmcnt(0)" ::: "memory");
  __syncthreads();
  const int kswz = r & 15, vswz = (r >> 1) & 7;
  for (int kt = 0; kt < ntile; ++kt) {
    const int cur = kt & 1;
    if (kt + 1 < ntile) ATT_STAGE(cur ^ 1, kt + 1);
    const unsigned char* cK = sK + cur * 16384 + r * 256;
    const unsigned char* cV = sV + cur * 16384 + r * 128 + 8 * hh;
    f32x16 sacc[2];
#pragma unroll
    for (int kb = 0; kb < 2; ++kb)
#pragma unroll
      for (int i = 0; i < 16; ++i) sacc[kb][i] = 0.f;
#pragma unroll
    for (int kk = 0; kk < 8; ++kk)
#pragma unroll
      for (int kb = 0; kb < 2; ++kb) {
        bf16x8 a = *(const bf16x8*)(cK + kb * 8192 + (((2 * kk + hh) ^ kswz) << 4));
        sacc[kb] = MFMA32(a, qf[kk], sacc[kb]);
      }
    float mt = sacc[0][0];
#pragma unroll
    for (int kb = 0; kb < 2; ++kb)
#pragma unroll
      for (int i = 0; i < 16; ++i) mt = fmaxf(mt, sacc[kb][i]);
    mt = fmaxf(mt, __shfl_xor(mt, 32));
    const bool bump = mt > m_run + 8.f;
    if (__builtin_amdgcn_ballot_w64(bump) != 0ull) {
      const float m_new = bump ? mt : m_run;
      const float alpha = __builtin_amdgcn_exp2f(m_run - m_new);
      m_run = m_new;
      l_run *= alpha;
#pragma unroll
      for (int a = 0; a < 4; ++a)
#pragma unroll
        for (int i = 0; i < 16; ++i) oacc[a][i] *= alpha;
    }
    float ls = 0.f;
#pragma unroll
    for (int kb = 0; kb < 2; ++kb)
#pragma unroll
      for (int i = 0; i < 16; ++i) { float pv = __builtin_amdgcn_exp2f(sacc[kb][i] - m_run); sacc[kb][i] = pv; ls += pv; }
    l_run += ls;
#pragma unroll
    for (int kb = 0; kb < 2; ++kb)
#pragma unroll
      for (int s2 = 0; s2 < 2; ++s2) {
        unsigned pk[4];
#pragma unroll
        for (int j = 0; j < 4; ++j) pk[j] = pack2(sacc[kb][8 * s2 + 2 * j], sacc[kb][8 * s2 + 2 * j + 1]);
        bf16x8 pb = __builtin_bit_cast(bf16x8, make_uint4(pk[0], pk[1], pk[2], pk[3]));
        const int c0 = 4 * kb + 2 * s2;
#pragma unroll
        for (int dvb = 0; dvb < 4; ++dvb) {
          const unsigned char* vp = cV + dvb * 4096;
          uint2 lo = *(const uint2*)(vp + ((c0 ^ vswz) << 4)), hi = *(const uint2*)(vp + (((c0 + 1) ^ vswz) << 4));
          bf16x8 av = __builtin_bit_cast(bf16x8, make_uint4(lo.x, lo.y, hi.x, hi.y));
          oacc[dvb] = MFMA32(av, pb, oacc[dvb]);
        }
      }
    asm volatile("s_waitcnt vmcnt(0)" ::: "memory");
    __syncthreads();
  }
#undef ATT_STAGE
  u32x2 gv[16];
#pragma unroll
  for (int dvb = 0; dvb < 4; ++dvb)
#pragma unroll
    for (int g = 0; g < 4; ++g)
      asm volatile("global_load_dwordx2 %0, %1, off"
                   : "=v"(gv[dvb * 4 + g])
                   : "v"(ag + (size_t)(tokq0 + r) * 1024 + hq * 128 + 32 * dvb + 8 * g + 4 * hh)
                   : "memory");
  const float lt = l_run + __shfl_xor(l_run, 32);
  const float inv = 1.f / lt;
  asm volatile("s_waitcnt vmcnt(0)"
               : "+v"(gv[0]), "+v"(gv[1]), "+v"(gv[2]), "+v"(gv[3]), "+v"(gv[4]), "+v"(gv[5]), "+v"(gv[6]), "+v"(gv[7]),
                 "+v"(gv[8]), "+v"(gv[9]), "+v"(gv[10]), "+v"(gv[11]), "+v"(gv[12]), "+v"(gv[13]), "+v"(gv[14]), "+v"(gv[15])
               :
               : "memory");
#pragma unroll
  for (int dvb = 0; dvb < 4; ++dvb)
#pragma unroll
    for (int g = 0; g < 4; ++g) {
      size_t idx = (size_t)(tokq0 + r) * 1024 + hq * 128 + 32 * dvb + 8 * g + 4 * hh;
      const unsigned gx = gv[dvb * 4 + g][0], gy = gv[dvb * 4 + g][1];
      float o0 = oacc[dvb][4 * g] * inv * bf2f(gx & 0xffff), o1 = oacc[dvb][4 * g + 1] * inv * bf2f(gx >> 16);
      float o2 = oacc[dvb][4 * g + 2] * inv * bf2f(gy & 0xffff), o3 = oacc[dvb][4 * g + 3] * inv * bf2f(gy >> 16);
      *(uint2*)(uo + idx) = make_uint2(pack2(o0, o1), pack2(o2, o3));
    }
}
DI void phase_attn(const Params& p, int ai, unsigned char* smem) {
  const int nb = gridDim.x, bid = blockIdx.x;
  int idx, step;
  if (nb >= 512) { idx = bid; step = bid < 256 ? 512 : nb - 256; }
  else { idx = bid; step = nb; }
  for (; idx < 512; idx += step) {
    const bool sample = idx < 256;
    attn_unit(p, ai, sample, sample ? idx : idx - 256, smem);
  }
}


#define XB_TMO      128
#define XB_XCNT(j)  (256  + 64 * (j))
#define XB_XSUB(j)  (1280 + 64 * (j))
#define XB_XGEN(j)  (2304 + 64 * (j))
#define XB_TOP      3328
#define XB_TOPGEN   3392
#define XCD_BAR_WORDS 3456
#define XB_SPIN_CAP (1u << 18)
#define LAS __attribute__((address_space(3)))
DI unsigned xb_ld(unsigned* p) { return __hip_atomic_load(p, __ATOMIC_RELAXED, __HIP_MEMORY_SCOPE_AGENT); }
DI unsigned xb_add(unsigned* p, unsigned v) { return __hip_atomic_fetch_add(p, v, __ATOMIC_RELAXED, __HIP_MEMORY_SCOPE_AGENT); }
DI unsigned xb_xcc_id() { return (unsigned)__builtin_amdgcn_s_getreg((3 << 11) | 20) & 0xFu; }
#define XB_SPIN(cond, bar) do { unsigned _sp = 0; while (cond) { __builtin_amdgcn_s_sleep(1); \
    if ((++_sp & 255u) == 0u) { if (xb_ld(&(bar)[XB_TMO])) break; if (_sp > XB_SPIN_CAP) { atomicAdd(&(bar)[XB_TMO], 1u); break; } } } } while (0)
struct XcdBarrier { unsigned* bar; unsigned x; volatile LAS unsigned* st; };
DI XcdBarrier xcd_barrier_post(unsigned* bar, volatile LAS unsigned* st) {
  XcdBarrier b; b.bar = bar; b.x = xb_xcc_id(); b.st = st;
  if (threadIdx.x == 0) (void)xb_add(&bar[XB_XCNT(b.x)], 1u);
  return b;
}
DI void xcd_barrier_complete(unsigned* bar, unsigned x, unsigned& nloc, unsigned& nx) {
  const unsigned G = gridDim.x * gridDim.y * gridDim.z;
  unsigned sum, cnt, mine, sp = 0u;
  for (;;) {
    sum = 0u; cnt = 0u; mine = 0u;
#pragma unroll
    for (unsigned j = 0; j < 16; ++j) { const unsigned c = xb_ld(&bar[XB_XCNT(j)]); sum += c; cnt += (c > 0u) ? 1u : 0u; mine = (j == x) ? c : mine; }
    if (sum == G) break;
    __builtin_amdgcn_s_sleep(1);
    if ((++sp & 255u) == 0u) { if (xb_ld(&bar[XB_TMO])) break; if (sp > XB_SPIN_CAP) { atomicAdd(&bar[XB_TMO], 1u); break; } }
  }
  nloc = mine > 0u ? mine : 1u; nx = cnt > 0u ? cnt : 1u;
}
DI void xcd_barrier(const XcdBarrier& b) {
  asm volatile("s_waitcnt vmcnt(0)" ::: "memory");
  __syncthreads();
  if (threadIdx.x == 0) {
    unsigned* bar = b.bar;
    __builtin_amdgcn_s_waitcnt(0);
    unsigned nloc = b.st[0], nx = b.st[1];
    if (nloc == 0u) { xcd_barrier_complete(bar, b.x, nloc, nx); b.st[0] = nloc; b.st[1] = nx; }
    const unsigned old = xb_add(&bar[XB_XSUB(b.x)], 1u);
    const unsigned gen = old / nloc;
    if (old + 1u == (gen + 1u) * nloc) {
      __builtin_amdgcn_fence(__ATOMIC_RELEASE, "agent");
      asm volatile("s_waitcnt vmcnt(0)" ::: "memory");
      const unsigned og = xb_add(&bar[XB_TOP], 1u);
      const unsigned tg = og / nx;
      if (og + 1u == (tg + 1u) * nx) xb_add(&bar[XB_TOPGEN], 1u);
      else XB_SPIN(xb_ld(&bar[XB_TOPGEN]) == tg, bar);
      __builtin_amdgcn_fence(__ATOMIC_ACQUIRE, "agent");
      xb_add(&bar[XB_XGEN(b.x)], 1u);
      asm volatile("s_waitcnt vmcnt(0)" ::: "memory");
    } else {
      XB_SPIN(xb_ld(&bar[XB_XGEN(b.x)]) == gen, bar);
      __builtin_amdgcn_fence(__ATOMIC_ACQUIRE, "agent");
      asm volatile("s_waitcnt vmcnt(0)" ::: "memory");
    }
  }
  __syncthreads();
}

#ifndef REP_P0
#define REP_P0 1
#endif
#ifndef REP_NORM
#define REP_NORM 1
#endif
#ifndef REP_PREP
#define REP_PREP 1
#endif
#ifndef REP_POST
#define REP_POST 1
#endif
#ifndef REP_GIN
#define REP_GIN 1
#endif
#ifndef REP_AIN
#define REP_AIN 1
#endif
#ifndef REP_SCAN
#define REP_SCAN 1
#endif
#ifndef REP_ATT
#define REP_ATT 1
#endif
#ifndef REP_OUT0
#define REP_OUT0 1
#endif
#ifndef REP_SYNC
#define REP_SYNC 1
#endif
#define SYNC() do { xcd_barrier(xb); if (REP_SYNC >= 2) xcd_barrier(xb); if (REP_SYNC >= 3) xcd_barrier(xb); } while (0)
#ifndef TPROBE
#define TPROBE 0
#endif
#define TPK 4
#define RUN(n, stmt) do { stmt; SYNC(); if ((n) >= 2) { stmt; SYNC(); } } while (0)
#define TRUN(id, n, stmt) do { unsigned long long t0_ = 0; if (TPROBE == (id)) t0_ = __builtin_amdgcn_s_memrealtime(); RUN(n, stmt); if (TPROBE == (id)) tacc += __builtin_amdgcn_s_memrealtime() - t0_; } while (0)

__global__ void __launch_bounds__(256, 2) fwd_megakernel(Params p) {
  __shared__ __attribute__((aligned(16))) unsigned char smem[SMEM_BYTES + 16];
  cg::grid_group grid = cg::this_grid();
  if (p.never) grid.sync();
  if (threadIdx.x == 0) *(uint4*)(smem + SMEM_BYTES) = make_uint4(0u, 0u, 0u, 0u);
  __syncthreads();
  unsigned long long tacc = 0;
  XcdBarrier xb = xcd_barrier_post((unsigned*)(p.ws + OFF_BAR), (volatile LAS unsigned*)(smem + SMEM_BYTES));
  TRUN(1, REP_P0, phase0(p, smem));
  TRUN(2, REP_NORM, phase_pre0(p));
  TRUN(3, REP_GIN, phase_gla_in(p, 0, smem));
  TRUN(4, REP_PREP, phase_gla_prep(p, 0, smem));
  TRUN(5, REP_SCAN, phase_gla_scan(p, 0, smem));
  TRUN(6, REP_POST, phase_gla_post(p, 0));
  TRUN(7, REP_OUT0, phase_out_proj(p, 0, (const bfr*)(p.ws + OFF_WT_GLA_OUT), smem));
  TRUN(8, REP_AIN, phase_att_in(p, 0, smem));
  TRUN(9, REP_ATT, phase_attn(p, 0, smem));
  TRUN(7, 1, phase_out_proj(p, 1, (const bfr*)(p.ws + OFF_WT_ATT_OUT), smem));
  TRUN(3, REP_GIN, phase_gla_in(p, 1, smem));
  TRUN(4, REP_PREP, phase_gla_prep(p, 1, smem));
  TRUN(5, REP_SCAN, phase_gla_scan(p, 1, smem));
  TRUN(6, REP_POST, phase_gla_post(p, 1));
  TRUN(7, 1, phase_out_proj(p, 2, (const bfr*)(p.ws + OFF_WT_GLA_OUT) + (size_t)1024 * 1024, smem));
  TRUN(8, REP_AIN, phase_att_in(p, 1, smem));
  TRUN(9, REP_ATT, phase_attn(p, 1, smem));
  {
    unsigned long long t0_ = 0;
    if (TPROBE == 7) t0_ = __builtin_amdgcn_s_memrealtime();
    phase_out_proj(p, 3, (const bfr*)(p.ws + OFF_WT_ATT_OUT) + (size_t)1024 * 1024, smem);
    if (TPROBE == 7) { SYNC(); tacc += __builtin_amdgcn_s_memrealtime() - t0_; }
  }
  if (TPROBE != 0 && blockIdx.x == 0 && threadIdx.x == 0) {
    const unsigned long long te = __builtin_amdgcn_s_memrealtime();
    while (__builtin_amdgcn_s_memrealtime() - te < TPK * tacc) __builtin_amdgcn_s_sleep(8);
  }
}

extern "C" void kernel_launch(void* const* d_in, const int* in_sizes, int n_in, void* d_out, int out_size, void* d_ws,
                              size_t ws_size, hipStream_t stream) {
  static int grid_blocks = 0;
  if (!grid_blocks) {
    int dev = 0, cus = 0, per_cu = 0;
    hipGetDevice(&dev);
    hipDeviceGetAttribute(&cus, hipDeviceAttributeMultiprocessorCount, dev);
    hipOccupancyMaxActiveBlocksPerMultiprocessor(&per_cu, fwd_megakernel, 256, 0);
    if (per_cu > 2) per_cu = 2;
    if (per_cu < 1) per_cu = 1;
    grid_blocks = cus * per_cu;
  }
  Params p{};
  for (int i = 0; i < 20; ++i) p.in[i] = (const float*)d_in[i];
  p.out = (float*)d_out;
  p.ws = (unsigned char*)d_ws;
  p.never = 0;
  p.pad = 0;
  hipMemsetAsync((unsigned char*)d_ws + OFF_BAR, 0, 3456 * 4 + 4 * 8192 * 4, stream);
  void* args[] = {&p};
  hipError_t e = hipLaunchCooperativeKernel((void*)fwd_megakernel, dim3(grid_blocks), dim3(256), args, 0, stream);
  if (e != hipSuccess) fprintf(stderr, "cooperative launch failed: %s (grid %d)\n", hipGetErrorString(e), grid_blocks);
}
```

```cpp
#include <hip/hip_runtime.h>
#include <hip/hip_cooperative_groups.h>
#include <stdint.h>
#include <stdio.h>
namespace cg = cooperative_groups;

typedef unsigned short bfr;
using bf16x8 = __attribute__((ext_vector_type(8))) short;
using bf16x4 = __attribute__((ext_vector_type(4))) short;
using f32x16 = __attribute__((ext_vector_type(16))) float;
using f32x4 = __attribute__((ext_vector_type(4))) float;
#define DI __device__ __forceinline__
using u32x4 = __attribute__((ext_vector_type(4))) unsigned;
using u32x2 = __attribute__((ext_vector_type(2))) unsigned;
#define GLOAD16(dst, ptr) asm volatile("global_load_dwordx4 %0, %1, off" : "=v"(dst) : "v"(ptr) : "memory")
#define MFMA32(a, b, c) __builtin_amdgcn_mfma_f32_32x32x16_bf16((a), (b), (c), 0, 0, 0)

constexpr int NTOK = 8192;
constexpr int DM = 1024;
constexpr int NPT = 4096;
constexpr float EPSN = 1e-6f;
constexpr int GLA_NPAD = 3200;
constexpr int ATT_N = 2560;

constexpr size_t OFF_WT_GLA_IN = 0;
constexpr size_t OFF_WT_GLA_OUT = OFF_WT_GLA_IN + 2ull * GLA_NPAD * 1024 * 2;
constexpr size_t OFF_WT_ATT_IN = OFF_WT_GLA_OUT + 2ull * 1024 * 1024 * 2;
constexpr size_t OFF_WT_ATT_OUT = OFF_WT_ATT_IN + 2ull * ATT_N * 1024 * 2;
constexpr size_t OFF_MOD = OFF_WT_ATT_OUT + 2ull * 1024 * 1024 * 2;
constexpr size_t OFF_ROPE = OFF_MOD + 4ull * 5 * 3072 * 4;
constexpr size_t OFF_H = OFF_ROPE + 2ull * 64 * 32 * 4;
constexpr size_t OFF_PROJ = OFF_H + (size_t)NTOK * 1024 * 2;
constexpr size_t OFF_TBUF = OFF_PROJ + (size_t)NTOK * 3072 * 2;
constexpr size_t OFF_QE = OFF_TBUF + (size_t)NTOK * 32 * 4;
constexpr size_t OFF_KDT = OFF_QE + 2ull * NTOK * 512 * 2;
constexpr size_t OFF_ABUF = OFF_KDT + 2ull * NTOK * 512 * 2;
constexpr size_t OFF_ELAST = OFF_ABUF + 1024ull * 64 * 64 * 2;
constexpr size_t OFF_O = OFF_ELAST + 1024ull * 128 * 4;
constexpr size_t OFF_U = OFF_O + 2ull * NTOK * 1024 * 2;
constexpr size_t OFF_KS = OFF_U + (size_t)NTOK * 1024 * 2;
constexpr size_t OFF_VST = OFF_KS + 2ull * 4 * 1280 * 256 * 2;
constexpr size_t OFF_BAR = OFF_VST + 2ull * 4 * 1280 * 256 * 2;
constexpr size_t OFF_ROWSS = OFF_BAR + 5632 * 4;
constexpr size_t OFF_BIAS2 = OFF_ROWSS + 4ull * 8192 * 4;
constexpr size_t OFF_PROJ2 = OFF_BIAS2 + 4ull * 5 * 3200 * 4;
constexpr size_t WS_END = OFF_PROJ2 + 36ull * 1024 * 1024;
constexpr size_t PJ_GQ = 0;
constexpr size_t PJ_GK = (size_t)NTOK * 512 * 2;
constexpr size_t PJ_GG = (size_t)NTOK * 1024 * 2;
constexpr size_t PJ_GVT = (size_t)NTOK * 2048 * 2;
constexpr size_t PJ_AQ = 0;
constexpr size_t PJ_AG = (size_t)NTOK * 1024 * 2;
constexpr size_t PJ_AKP = (size_t)NTOK * 2048 * 2;
constexpr size_t PJ_AVPT = PJ_AKP + 4096ull * 256 * 2;

constexpr size_t OUT_STATE = 2ull * 4096 * 1024;
constexpr size_t OUT_CK = OUT_STATE + 16ull * 2 * 2 * 4 * 128 * 256;
constexpr size_t OUT_CV = OUT_CK + 16ull * 2 * 256 * 2 * 128;

constexpr int SMEM_BYTES = 73728;

struct Params {
  const float* in[20];
  float* out;
  unsigned char* ws;
  int never;
  int pad;
};
enum { I_XP = 0, I_XS, I_STATE, I_CK, I_CV, I_C, I_CCTX, I_NORMG, I_WADA, I_BADA, I_GWIN, I_GWA1, I_GWA2, I_GBA,
       I_GONORM, I_GWOUT, I_AWIN, I_AQN, I_AKN, I_AWOUT };

typedef __bf16 bf16v2 __attribute__((ext_vector_type(2)));
typedef float f32v2 __attribute__((ext_vector_type(2)));
DI unsigned pack2(float a, float b) {
  f32v2 v = {a, b};
  return __builtin_bit_cast(unsigned, __builtin_convertvector(v, bf16v2));
}
DI bfr f2bf(float x) { return (bfr)(pack2(x, x) & 0xffffu); }
DI float bf2f(bfr b) { return __uint_as_float(((unsigned)b) << 16); }
DI int fresh_tid() { int t = threadIdx.x; asm volatile("" : "+v"(t)); return t; }
DI int crow(int reg, int h) { return (reg & 3) + 8 * (reg >> 2) + 4 * h; }
DI float siluf(float x) { return x * __builtin_amdgcn_rcpf(1.f + __expf(-x)); }
DI int modrow(int row) { return row < NPT ? 0 : 1 + ((row - NPT) >> 10); }
DI const float* xrow_ptr(const Params& p, int l, int row) {
  if (l == 0) return row < NPT ? p.in[I_XP] + (size_t)row * DM : p.in[I_XS] + (size_t)(row - NPT) * DM;
  return p.out + (size_t)row * DM;
}
DI float wave_sum(float v) {
#pragma unroll
  for (int o = 32; o >= 1; o >>= 1) v += __shfl_xor(v, o);
  return v;
}
DI float half_sum(float v) {
#pragma unroll
  for (int o = 16; o >= 1; o >>= 1) v += __shfl_xor(v, o);
  return v;
}

DI void transpose_tile(const float* __restrict__ src, int src_ld, int k0, int n0, int ncols, bfr* __restrict__ dst,
                       size_t dst_ld, unsigned char* smem) {
  float* tile = (float*)smem;
  const int tid = threadIdx.x;
  const int c4 = (tid & 15) * 4, kr = tid >> 4;
#pragma unroll
  for (int j = 0; j < 4; ++j) {
    int k = kr + 16 * j;
    if (c4 < ncols) {
      float4 v = *(const float4*)(src + (size_t)(k0 + k) * src_ld + n0 + c4);
      tile[k * 65 + c4] = v.x; tile[k * 65 + c4 + 1] = v.y; tile[k * 65 + c4 + 2] = v.z; tile[k * 65 + c4 + 3] = v.w;
    }
  }
  __syncthreads();
  const int n = tid >> 2, kq = (tid & 3) * 16;
  if (n < ncols) {
    unsigned pk[8];
#pragma unroll
    for (int j = 0; j < 8; ++j) pk[j] = pack2(tile[(kq + 2 * j) * 65 + n], tile[(kq + 2 * j + 1) * 65 + n]);
    uint4* d = (uint4*)(dst + (size_t)(n0 + n) * dst_ld + k0 + kq);
    d[0] = make_uint4(pk[0], pk[1], pk[2], pk[3]);
    d[1] = make_uint4(pk[4], pk[5], pk[6], pk[7]);
  }
  __syncthreads();
}

DI void transpose_wide(const float* __restrict__ src, int src_ld, int k0, int n0, bfr* __restrict__ dst, size_t dst_ld,
                       unsigned char* smem) {
  float* tile = (float*)smem;
  const int tid = threadIdx.x;
  const int c4 = (tid & 63) * 4, kr = tid >> 6;
  f32x4 v[16];
#pragma unroll
  for (int j = 0; j < 16; ++j) GLOAD16(v[j], src + (size_t)(k0 + j * 4 + kr) * src_ld + n0 + c4);
  asm volatile("s_waitcnt vmcnt(0)"
               : "+v"(v[0]), "+v"(v[1]), "+v"(v[2]), "+v"(v[3]), "+v"(v[4]), "+v"(v[5]), "+v"(v[6]), "+v"(v[7]),
                 "+v"(v[8]), "+v"(v[9]), "+v"(v[10]), "+v"(v[11]), "+v"(v[12]), "+v"(v[13]), "+v"(v[14]), "+v"(v[15])
               :
               : "memory");
#pragma unroll
  for (int j = 0; j < 16; ++j) *(f32x4*)(tile + (j * 4 + kr) * 260 + c4) = v[j];
  __syncthreads();
  uint4* d = (uint4*)(dst + (size_t)(n0 + tid) * dst_ld + k0);
#pragma unroll
  for (int q = 0; q < 8; ++q) {
    unsigned pk[4];
#pragma unroll
    for (int j = 0; j < 4; ++j) pk[j] = pack2(tile[(q * 8 + 2 * j) * 260 + tid], tile[(q * 8 + 2 * j + 1) * 260 + tid]);
    d[q] = make_uint4(pk[0], pk[1], pk[2], pk[3]);
  }
  __syncthreads();
}

DI void mod_unit(const Params& p, int unit, unsigned char* smem) {
  const int l = unit / 96, n0 = (unit % 96) * 32;
  float* sil = (float*)smem;
  float* red = sil + 5 * 1024;
  const int tid = threadIdx.x;
  for (int e = tid; e < 5 * 1024; e += 256) {
    int r = e >> 10, k = e & 1023;
    float cv = r == 0 ? p.in[I_CCTX][k] : p.in[I_C][(r - 1) * 1024 + k];
    sil[e] = cv / (1.f + expf(-cv));
  }
  __syncthreads();
  const int kg = tid >> 5, cn = tid & 31;
  const float* w = p.in[I_WADA] + (size_t)l * 1024 * 3072 + n0 + cn + (size_t)(kg * 128) * 3072;
  float a0 = 0, a1 = 0, a2 = 0, a3 = 0, a4 = 0;
  float wa[16], wb[16];
#define MOD_ISSUE(arr, kb)                                                                                          \
  _Pragma("unroll") for (int j = 0; j < 16; ++j)                                                                    \
      asm volatile("global_load_dword %0, %1, off" : "=v"(arr[j]) : "v"(w + (size_t)((kb) * 16 + j) * 3072) : "memory")
#define MOD_WAIT(arr, n)                                                                                            \
  asm volatile("s_waitcnt vmcnt(" #n ")"                                                                            \
               : "+v"(arr[0]), "+v"(arr[1]), "+v"(arr[2]), "+v"(arr[3]), "+v"(arr[4]), "+v"(arr[5]), "+v"(arr[6]),   \
                 "+v"(arr[7]), "+v"(arr[8]), "+v"(arr[9]), "+v"(arr[10]), "+v"(arr[11]), "+v"(arr[12]),             \
                 "+v"(arr[13]), "+v"(arr[14]), "+v"(arr[15])                                                        \
               :                                                                                                    \
               : "memory")
#define MOD_USE(arr, kb)                                                                                            \
  _Pragma("unroll") for (int j = 0; j < 16; ++j) {                                                                  \
    const int k = kg * 128 + (kb) * 16 + j;                                                                         \
    const float wv = arr[j];                                                                                        \
    a0 += sil[k] * wv; a1 += sil[1024 + k] * wv; a2 += sil[2048 + k] * wv; a3 += sil[3072 + k] * wv; a4 += sil[4096 + k] * wv; \
  }
  MOD_ISSUE(wa, 0);
  MOD_ISSUE(wb, 1);
#pragma unroll
  for (int kb = 0; kb < 8; kb += 2) {
    MOD_WAIT(wa, 16);
    MOD_USE(wa, kb);
    if (kb + 2 < 8) { MOD_ISSUE(wa, kb + 2); MOD_WAIT(wb, 16); } else { MOD_WAIT(wb, 0); }
    MOD_USE(wb, kb + 1);
    if (kb + 3 < 8) MOD_ISSUE(wb, kb + 3);
  }
#undef MOD_ISSUE
#undef MOD_WAIT
#undef MOD_USE
  red[(kg * 5 + 0) * 32 + cn] = a0; red[(kg * 5 + 1) * 32 + cn] = a1; red[(kg * 5 + 2) * 32 + cn] = a2;
  red[(kg * 5 + 3) * 32 + cn] = a3; red[(kg * 5 + 4) * 32 + cn] = a4;
  __syncthreads();
  if (tid < 160) {
    int r = tid >> 5;
    float s = p.in[I_BADA][l * 3072 + n0 + cn];
#pragma unroll
    for (int g = 0; g < 8; ++g) s += red[(g * 5 + r) * 32 + cn];
    ((float*)(p.ws + OFF_MOD))[(l * 5 + r) * 3072 + n0 + cn] = s;
  }
  __syncthreads();
}

DI void p0_do_unit(const Params& p, int unit, unsigned char* smem) {
  constexpr int U_MOD = 384;
  constexpr int U_GIN = 2 * 16 * 12;
  constexpr int U_GA1 = 2 * 2 * 16;
  constexpr int U_GZ = 2;
  constexpr int U_GOUT = 2 * 16 * 4;
  constexpr int U_AIN = 2 * 16 * 10;
  constexpr int U_AOUT = 2 * 16 * 4;
  constexpr int U_ROPE = 1;
  constexpr int U_CK = 64;
  bfr* wt_gin = (bfr*)(p.ws + OFF_WT_GLA_IN);
  bfr* wt_gout = (bfr*)(p.ws + OFF_WT_GLA_OUT);
  bfr* wt_ain = (bfr*)(p.ws + OFF_WT_ATT_IN);
  bfr* wt_aout = (bfr*)(p.ws + OFF_WT_ATT_OUT);
  const int tid = threadIdx.x;
  int u = unit;
  if (u < U_MOD) { mod_unit(p, u, smem); return; }
  u -= U_MOD;
  if (u < U_GIN) {
    int i = u / 192, r = u % 192, kt = r / 12, nt = r % 12;
    transpose_wide(p.in[I_GWIN] + (size_t)i * 1024 * 3072, 3072, kt * 64, nt * 256, wt_gin + (size_t)i * GLA_NPAD * 1024, 1024, smem);
    return;
  }
  u -= U_GIN;
  if (u < U_GA1) {
    int id = u / 16, kt = u % 16;
    int i = id >> 1, d = id & 1;
    transpose_tile(p.in[I_GWA1] + (size_t)id * 1024 * 16, 16, kt * 64, 0, 16,
                   wt_gin + ((size_t)i * GLA_NPAD + 3072 + d * 16) * 1024, 1024, smem);
    return;
  }
  u -= U_GA1;
  if (u < U_GZ) {
    uint4* z = (uint4*)(wt_gin + ((size_t)u * GLA_NPAD + 3104) * 1024);
    for (int e = tid; e < 96 * 1024 / 8; e += 256) z[e] = make_uint4(0, 0, 0, 0);
    return;
  }
  u -= U_GZ;
  if (u < U_GOUT) {
    int i = u / 64, r = u % 64, kt = r / 4, nt = r % 4;
    transpose_wide(p.in[I_GWOUT] + (size_t)i * 1024 * 1024, 1024, kt * 64, nt * 256, wt_gout + (size_t)i * 1024 * 1024, 1024, smem);
    return;
  }
  u -= U_GOUT;
  if (u < U_AIN) {
    int i = u / 160, r = u % 160, kt = r / 10, nt = r % 10;
    transpose_wide(p.in[I_AWIN] + (size_t)i * 1024 * ATT_N, ATT_N, kt * 64, nt * 256, wt_ain + (size_t)i * ATT_N * 1024, 1024, smem);
    return;
  }
  u -= U_AIN;
  if (u < U_AOUT) {
    int i = u / 64, r = u % 64, kt = r / 4, nt = r % 4;
    transpose_wide(p.in[I_AWOUT] + (size_t)i * 1024 * 1024, 1024, kt * 64, nt * 256, wt_aout + (size_t)i * 1024 * 1024, 1024, smem);
    return;
  }
  u -= U_AOUT;
  if (u < U_ROPE) {
    float* rc = (float*)(p.ws + OFF_ROPE);
    float* rs = rc + 64 * 32;
    for (int e = tid; e < 2048; e += 256) {
      int pos = e >> 5, f = e & 31;
      float fr = powf(10000.0f, -(float)f / 32.0f);
      float ang = (float)pos * fr;
      rc[e] = cosf(ang);
      rs[e] = sinf(ang);
    }
    return;
  }
  u -= U_ROPE;
  if (u < U_CK) {
    bfr* ks = (bfr*)(p.ws + OFF_KS);
    f32x4 cv[8];
#pragma unroll
    for (int j = 0; j < 8; ++j) GLOAD16(cv[j], p.in[I_CK] + (size_t)u * 8192 + (size_t)(j * 256 + tid) * 4);
    asm volatile("s_waitcnt vmcnt(0)"
                 : "+v"(cv[0]), "+v"(cv[1]), "+v"(cv[2]), "+v"(cv[3]), "+v"(cv[4]), "+v"(cv[5]), "+v"(cv[6]), "+v"(cv[7])
                 :
                 : "memory");
#pragma unroll
    for (int j = 0; j < 8; ++j) {
      size_t idx = (size_t)u * 8192 + (size_t)(j * 256 + tid) * 4;
      int c = idx & 255, t = (idx >> 8) & 255, i = (idx >> 16) & 1, b = (int)(idx >> 17);
      uint2 o = make_uint2(pack2(cv[j][0], cv[j][1]), pack2(cv[j][2], cv[j][3]));
      *(uint2*)(ks + ((size_t)(i * 4 + b) * 1280 + 1024 + t) * 256 + c) = o;
    }
    return;
  }
  u -= U_CK;
  {
    int bi = u / 4, kt = u % 4;
    int b = bi >> 1, i = bi & 1;
    transpose_wide(p.in[I_CV] + (size_t)bi * 256 * 256, 256, kt * 64, 0,
                   (bfr*)(p.ws + OFF_VST) + (size_t)(i * 4 + b) * 256 * 1280 + 1024, 1280, smem);
  }
}

constexpr int P0_NEARLY = 96 + 192 + 32 + 1 + 64;
constexpr int P0_NDEFER = 288 + 192 + 32 + 1 + 64 + 545;
DI int p0_early(int e) {
  const int lo[5] = {0, 384, 768, 832, 834}, hi[5] = {96, 576, 800, 833, 898};
  int r = -1;
#pragma unroll
  for (int i = 0; i < 5; ++i) { const int sz = hi[i] - lo[i]; if (r < 0 && e >= 0 && e < sz) r = lo[i] + e; e -= sz; }
  return r;
}
DI int p0_defer(int e) {
  const int lo[6] = {96, 576, 800, 833, 898, 962}, hi[6] = {384, 768, 832, 834, 962, 1507};
  int r = -1;
#pragma unroll
  for (int i = 0; i < 6; ++i) { const int sz = hi[i] - lo[i]; if (r < 0 && e >= 0 && e < sz) r = lo[i] + e; e -= sz; }
  return r;
}
DI void phase0(const Params& p, unsigned char* smem) {
  for (int e = blockIdx.x; e < 1507; e += gridDim.x) p0_do_unit(p, e, smem);
}
DI void phase0_deferred(const Params& p, int first, int step, unsigned char* smem) {
  for (int e = first; e < P0_NDEFER; e += step) p0_do_unit(p, p0_defer(e), smem);
}

DI void phase_pre0(const Params& p) {
  const int lane = threadIdx.x & 63;
  const int gw = blockIdx.x * 4 + (threadIdx.x >> 6), nw = gridDim.x * 4;
  const float* g = p.in[I_NORMG];
  const float* mod = (const float*)(p.ws + OFF_MOD);
  bfr* h = (bfr*)(p.ws + OFF_H);
  float* rowss = (float*)(p.ws + OFF_ROWSS);
  const bool aff = (gridDim.x & 7) == 0;
  const int xw = aff ? (int)(blockIdx.x >> 3) * 4 + (int)(threadIdx.x >> 6) : gw, xnw = aff ? (int)(gridDim.x >> 3) * 4 : nw;
  const int xn = aff ? NTOK / 32 : NTOK / 4, xb0 = aff ? (int)(blockIdx.x & 7) * (NTOK / 32) : 0;
  for (int jj = xw; jj < xn; jj += xnw) {
    const int rg = xb0 + jj;
    const int row0 = rg * 4;
    float4 v[4][4];
#pragma unroll
    for (int k = 0; k < 4; ++k) {
      const float* x = xrow_ptr(p, 0, row0 + k);
#pragma unroll
      for (int j = 0; j < 4; ++j) v[k][j] = *(const float4*)(x + lane * 4 + 256 * j);
    }
    const float* mr = mod + modrow(row0) * 3072;
    float4 ca[4];
#pragma unroll
    for (int j = 0; j < 4; ++j) {
      const int c = lane * 4 + 256 * j;
      const float4 gg = *(const float4*)(g + c);
      const float4 sc = *(const float4*)(mr + 1024 + c);
      ca[j] = make_float4(gg.x * (1.f + sc.x), gg.y * (1.f + sc.y), gg.z * (1.f + sc.z), gg.w * (1.f + sc.w));
    }
#pragma unroll
    for (int k = 0; k < 4; ++k) {
      float ss = 0.f;
#pragma unroll
      for (int j = 0; j < 4; ++j) ss += v[k][j].x * v[k][j].x + v[k][j].y * v[k][j].y + v[k][j].z * v[k][j].z + v[k][j].w * v[k][j].w;
      ss = wave_sum(ss);
      if (lane == 0) rowss[row0 + k] = ss;
#pragma unroll
      for (int j = 0; j < 4; ++j) {
        const int c = lane * 4 + 256 * j;
        *(uint2*)(h + (size_t)(row0 + k) * DM + c) =
            make_uint2(pack2(v[k][j].x * ca[j].x, v[k][j].y * ca[j].y), pack2(v[k][j].z * ca[j].z, v[k][j].w * ca[j].w));
      }
    }
  }
  float* bias2 = (float*)(p.ws + OFF_BIAS2);
  constexpr int NG = 3104, NA = 2560, NTASK = 2 * NG + 2 * NA;
  for (int task = gw; task < NTASK; task += nw) {
    int l, n;
    const bfr* wt;
    if (task < 2 * NG) { const int i = task / NG; n = task % NG; l = 2 * i; wt = (const bfr*)(p.ws + OFF_WT_GLA_IN) + ((size_t)i * GLA_NPAD + n) * 1024; }
    else { const int t2 = task - 2 * NG, i = t2 / NA; n = t2 % NA; l = 2 * i + 1; wt = (const bfr*)(p.ws + OFF_WT_ATT_IN) + ((size_t)i * ATT_N + n) * 1024; }
    u32x4 w0, w1;
    f32x4 cbv[20];
    GLOAD16(w0, wt + lane * 16);
    GLOAD16(w1, wt + lane * 16 + 8);
#pragma unroll
    for (int r = 0; r < 5; ++r)
#pragma unroll
      for (int j4 = 0; j4 < 4; ++j4) GLOAD16(cbv[r * 4 + j4], mod + (size_t)(l * 5 + r) * 3072 + lane * 16 + j4 * 4);
    asm volatile("s_waitcnt vmcnt(0)"
                 : "+v"(w0), "+v"(w1), "+v"(cbv[0]), "+v"(cbv[1]), "+v"(cbv[2]), "+v"(cbv[3]), "+v"(cbv[4]), "+v"(cbv[5]), "+v"(cbv[6]),
                   "+v"(cbv[7]), "+v"(cbv[8]), "+v"(cbv[9]), "+v"(cbv[10]), "+v"(cbv[11]), "+v"(cbv[12]), "+v"(cbv[13]), "+v"(cbv[14]),
                   "+v"(cbv[15]), "+v"(cbv[16]), "+v"(cbv[17]), "+v"(cbv[18]), "+v"(cbv[19])
                 :
                 : "memory");
    const unsigned wu[8] = {w0[0], w0[1], w0[2], w0[3], w1[0], w1[1], w1[2], w1[3]};
    float wf[16];
#pragma unroll
    for (int j = 0; j < 8; ++j) { wf[2 * j] = bf2f((bfr)(wu[j] & 0xffff)); wf[2 * j + 1] = bf2f((bfr)(wu[j] >> 16)); }
#pragma unroll
    for (int r = 0; r < 5; ++r) {
      float sacc = 0.f;
#pragma unroll
      for (int j4 = 0; j4 < 4; ++j4) {
        const f32x4 c4 = cbv[r * 4 + j4];
        sacc += c4[0] * wf[j4 * 4] + c4[1] * wf[j4 * 4 + 1] + c4[2] * wf[j4 * 4 + 2] + c4[3] * wf[j4 * 4 + 3];
      }
      sacc = wave_sum(sacc);
      if (lane == 0) bias2[(size_t)(l * 5 + r) * 3200 + n] = sacc;
    }
  }
}

DI void phase_norm(const Params& p, int l) {
  const int ftid = fresh_tid();
  const int lane = ftid & 63;
  const int gw = blockIdx.x * 4 + (ftid >> 6), nw = gridDim.x * 4;
  const float* g = p.in[I_NORMG] + l * DM;
  const float* mod = (const float*)(p.ws + OFF_MOD) + (size_t)l * 5 * 3072;
  bfr* h = (bfr*)(p.ws + OFF_H);
  for (int rg = gw; rg < NTOK / 4; rg += nw) {
    const int row0 = rg * 4;
    float4 v[4][4];
#pragma unroll
    for (int k = 0; k < 4; ++k) {
      const float* x = xrow_ptr(p, l, row0 + k);
#pragma unroll
      for (int j = 0; j < 4; ++j) v[k][j] = *(const float4*)(x + lane * 4 + 256 * j);
    }
    const float* mr = mod + modrow(row0) * 3072;
    float4 ca[4], cb[4];
#pragma unroll
    for (int j = 0; j < 4; ++j) {
      const int c = lane * 4 + 256 * j;
      const float4 gg = *(const float4*)(g + c);
      const float4 sc = *(const float4*)(mr + 1024 + c);
      cb[j] = *(const float4*)(mr + c);
      ca[j] = make_float4(gg.x * (1.f + sc.x), gg.y * (1.f + sc.y), gg.z * (1.f + sc.z), gg.w * (1.f + sc.w));
    }
#pragma unroll
    for (int k = 0; k < 4; ++k) {
      float ss = 0.f;
#pragma unroll
      for (int j = 0; j < 4; ++j) ss += v[k][j].x * v[k][j].x + v[k][j].y * v[k][j].y + v[k][j].z * v[k][j].z + v[k][j].w * v[k][j].w;
      ss = wave_sum(ss);
      const float rstd = rsqrtf(ss * (1.f / 1024.f) + EPSN);
#pragma unroll
      for (int j = 0; j < 4; ++j) {
        const int c = lane * 4 + 256 * j;
        const float o0 = v[k][j].x * rstd * ca[j].x + cb[j].x, o1 = v[k][j].y * rstd * ca[j].y + cb[j].y;
        const float o2 = v[k][j].z * rstd * ca[j].z + cb[j].z, o3 = v[k][j].w * rstd * ca[j].w + cb[j].w;
        *(uint2*)(h + (size_t)(row0 + k) * DM + c) = make_uint2(pack2(o0, o1), pack2(o2, o3));
      }
    }
  }
}

template <int NBW> struct GemmCfg {
  static constexpr int MB = NBW == 32 ? 1 : 2;
  static constexpr int NB = NBW == 128 ? 2 : 1;
  static constexpr int BSLOTS = NBW / 32;
  DI static int am(int w) { return NBW == 32 ? 32 * w : 64 * (w >> 1); }
  DI static int bn(int w) { return NBW == 128 ? 64 * (w & 1) : (NBW == 64 ? 32 * (w & 1) : 0); }
};
template <int NBW>
DI void gemm_core(const bfr* __restrict__ A, const bfr* __restrict__ Bt, int K, int m0, int n0, unsigned char* smem,
                  f32x16 (&acc)[2][2]) {
  using C = GemmCfg<NBW>;
  unsigned char* sA = smem;
  unsigned char* sB = smem + 32768;
  const int tid = fresh_tid(), lane = tid & 63, w = tid >> 6, r = lane & 31, hh = lane >> 5;
  const bfr* gA = A + (size_t)m0 * K;
  const bfr* gB = Bt + (size_t)n0 * K;
  int goff[4];
#pragma unroll
  for (int i = 0; i < 4; ++i) {
    const int row = (i * 4 + w) * 8 + (lane >> 3);
    goff[i] = row * K + (((lane & 7) ^ ((row >> 1) & 7)) << 3);
  }
#pragma unroll
  for (int a = 0; a < 2; ++a)
#pragma unroll
    for (int b = 0; b < 2; ++b)
#pragma unroll
      for (int i = 0; i < 16; ++i) acc[a][b][i] = 0.f;
#define GEMM_STAGE(buf, kt)                                                                                         \
  do {                                                                                                              \
    _Pragma("unroll") for (int i = 0; i < 4; ++i) {                                                                 \
      __builtin_amdgcn_global_load_lds((const unsigned*)(gA + goff[i] + (kt) * 64),                                 \
                                       (unsigned*)(sA + (buf) * 16384 + (i * 4 + w) * 1024), 16, 0, 0);            \
      if (i < C::BSLOTS)                                                                                            \
        __builtin_amdgcn_global_load_lds((const unsigned*)(gB + goff[i] + (kt) * 64),                               \
                                         (unsigned*)(sB + (buf) * 16384 + (i * 4 + w) * 1024), 16, 0, 0);          \
    }                                                                                                               \
  } while (0)
  GEMM_STAGE(0, 0);
  asm volatile("s_waitcnt vmcnt(0)" ::: "memory");
  __syncthreads();
  const int swz = (r >> 1) & 7;
  const int arow = (C::am(w) + r) * 128, brow = (C::bn(w) + r) * 128;
  const int KT = K >> 6;
  for (int kt = 0; kt < KT; ++kt) {
    const int cur = kt & 1;
    if (kt + 1 < KT) GEMM_STAGE(cur ^ 1, kt + 1);
    const unsigned char* cA = sA + cur * 16384 + arow;
    const unsigned char* cB = sB + cur * 16384 + brow;
#pragma unroll
    for (int kk = 0; kk < 4; ++kk) {
      const int co = ((2 * kk + hh) ^ swz) << 4;
      bf16x8 a[2], b[2];
#pragma unroll
      for (int mb = 0; mb < C::MB; ++mb) a[mb] = *(const bf16x8*)(cA + mb * 4096 + co);
#pragma unroll
      for (int nb = 0; nb < C::NB; ++nb) b[nb] = *(const bf16x8*)(cB + nb * 4096 + co);
#pragma unroll
      for (int mb = 0; mb < C::MB; ++mb)
#pragma unroll
        for (int nb = 0; nb < C::NB; ++nb) acc[mb][nb] = MFMA32(a[mb], b[nb], acc[mb][nb]);
    }
    asm volatile("s_waitcnt vmcnt(0)" ::: "memory");
    __syncthreads();
  }
#undef GEMM_STAGE
}
template <int NBW>
DI void stage_acc(const f32x16 (&acc)[2][2], float* sC) {
  using C = GemmCfg<NBW>;
  const int lane = threadIdx.x & 63, w = threadIdx.x >> 6, r = lane & 31, hh = lane >> 5;
#pragma unroll
  for (int mb = 0; mb < C::MB; ++mb)
#pragma unroll
    for (int nb = 0; nb < C::NB; ++nb)
#pragma unroll
      for (int i = 0; i < 16; ++i) sC[(C::am(w) + 32 * mb + crow(i, hh)) * 132 + C::bn(w) + 32 * nb + r] = acc[mb][nb][i];
}
DI void stage_acc_t(const f32x16 (&acc)[2][2], float* sC) {
  const int lane = threadIdx.x & 63, w = threadIdx.x >> 6, wm = w >> 1, wn = w & 1, r = lane & 31, hh = lane >> 5;
#pragma unroll
  for (int mb = 0; mb < 2; ++mb)
#pragma unroll
    for (int nb = 0; nb < 2; ++nb)
#pragma unroll
      for (int g = 0; g < 4; ++g) {
        float4 v = make_float4(acc[mb][nb][4 * g], acc[mb][nb][4 * g + 1], acc[mb][nb][4 * g + 2], acc[mb][nb][4 * g + 3]);
        *(float4*)(sC + (64 * wn + 32 * nb + r) * 132 + 64 * wm + 32 * mb + 8 * g + 4 * hh) = v;
      }
}

struct FixRegs { f32x4 q[8]; float bb[2]; };
template <int NBW>
DI void fix_issue(const Params& p, FixRegs& f, int l, int m0, int n0) {
  using C = GemmCfg<NBW>;
  const int lane = threadIdx.x & 63, w = threadIdx.x >> 6, r = lane & 31, hh = lane >> 5;
  const float* rowss = (const float*)(p.ws + OFF_ROWSS) + (size_t)l * NTOK + m0 + C::am(w) + 4 * hh;
  const float* b2 = (const float*)(p.ws + OFF_BIAS2) + (size_t)(l * 5 + modrow(m0)) * 3200 + n0 + C::bn(w) + r;
#pragma unroll
  for (int mb = 0; mb < 2; ++mb)
#pragma unroll
    for (int g = 0; g < 4; ++g) GLOAD16(f.q[mb * 4 + g], rowss + 32 * (mb < C::MB ? mb : 0) + 8 * g);
#pragma unroll
  for (int nb = 0; nb < 2; ++nb)
    asm volatile("global_load_dword %0, %1, off" : "=v"(f.bb[nb]) : "v"(b2 + 32 * (nb < C::NB ? nb : 0)) : "memory");
}
template <int NBW>
DI void fix_apply(FixRegs& f, f32x16 (&acc)[2][2]) {
  using C = GemmCfg<NBW>;
  asm volatile("s_waitcnt vmcnt(0)"
               : "+v"(f.q[0]), "+v"(f.q[1]), "+v"(f.q[2]), "+v"(f.q[3]), "+v"(f.q[4]), "+v"(f.q[5]), "+v"(f.q[6]), "+v"(f.q[7]),
                 "+v"(f.bb[0]), "+v"(f.bb[1])
               :
               : "memory");
#pragma unroll
  for (int mb = 0; mb < C::MB; ++mb)
#pragma unroll
    for (int g = 0; g < 4; ++g) {
      float rs[4];
#pragma unroll
      for (int j = 0; j < 4; ++j) rs[j] = rsqrtf(f.q[mb * 4 + g][j] * (1.f / 1024.f) + EPSN);
#pragma unroll
      for (int nb = 0; nb < C::NB; ++nb)
#pragma unroll
        for (int j = 0; j < 4; ++j) acc[mb][nb][4 * g + j] = acc[mb][nb][4 * g + j] * rs[j] + f.bb[nb];
    }
}

struct TileIter {
  int lt, step, nl, mbase, mmask, mshift;
  DI TileIter(int NT) {
    const int nblk = gridDim.x, bid = blockIdx.x;
    if ((nblk & 7) == 0) { mbase = (bid & 7) * 8; lt = bid >> 3; step = nblk >> 3; nl = 8 * NT; mmask = 7; mshift = 3; }
    else { mbase = 0; lt = bid; step = nblk; nl = 64 * NT; mmask = 63; mshift = 6; }
  }
  DI bool valid() const { return lt < nl; }
  DI int mt() const { return mbase + (lt & mmask); }
  DI int nt() const { return lt >> mshift; }
  DI void next() { lt += step; }
};

DI void phase_gla_in(const Params& p, int gi, unsigned char* smem) {
  const int lyr = 2 * gi;
  const bfr* A = (const bfr*)(p.ws + OFF_H);
  const bfr* Bt = (const bfr*)(p.ws + OFF_WT_GLA_IN) + (size_t)gi * GLA_NPAD * 1024;
  bfr* gq = (bfr*)(p.ws + OFF_PROJ + PJ_GQ);
  bfr* gk = (bfr*)(p.ws + OFF_PROJ + PJ_GK);
  bfr* gg = (bfr*)(p.ws + OFF_PROJ + PJ_GG);
  bfr* gvt = (bfr*)(p.ws + OFF_PROJ + PJ_GVT);
  float* tb = (float*)(p.ws + OFF_TBUF);
  float* sC = (float*)smem;
  const int tid = threadIdx.x;
  constexpr int NT = 25, MT = 64;
  for (TileIter ti(NT); ti.valid(); ti.next()) {
    const int mt = ti.mt(), nt = ti.nt(), m0 = mt * 128, n0 = nt * 128;
    f32x16 acc[2][2];
    if (nt == 24) {
      FixRegs fx; fix_issue<32>(p, fx, lyr, m0, 3072);
      gemm_core<32>(A, Bt, 1024, m0, 3072, smem, acc);
      fix_apply<32>(fx, acc);
      stage_acc<32>(acc, sC);
      __syncthreads();
#pragma unroll
      for (int it = 0; it < 4; ++it) {
        int idx = it * 256 + tid, row = idx >> 3, c4 = (idx & 7) * 4;
        *(float4*)(tb + (size_t)(m0 + row) * 32 + c4) = *(const float4*)(sC + row * 132 + c4);
      }
      __syncthreads();
      continue;
    }
    FixRegs fx; fix_issue<128>(p, fx, lyr, m0, n0);
    gemm_core<128>(A, Bt, 1024, m0, n0, smem, acc);
    fix_apply<128>(fx, acc);
    if (nt >= 8 && nt < 16) {
      stage_acc_t(acc, sC);
      __syncthreads();
#pragma unroll 4
      for (int it = 0; it < 16; ++it) {
        int idx = it * 256 + tid, col = idx >> 5, r4 = (idx & 31) * 4;
        float4 v = *(const float4*)(sC + col * 132 + r4);
        *(uint2*)(gvt + (size_t)((nt - 8) * 128 + col) * NTOK + m0 + r4) = make_uint2(pack2(v.x, v.y), pack2(v.z, v.w));
      }
    } else {
      stage_acc<128>(acc, sC);
      __syncthreads();
#pragma unroll 4
      for (int it = 0; it < 16; ++it) {
        int idx = it * 256 + tid, row = idx >> 5, c4 = (idx & 31) * 4;
        float4 v = *(const float4*)(sC + row * 132 + c4);
        size_t grow = m0 + row;
        if (nt < 4) {
          const float s = 0.08838834764831845f;
          *(uint2*)(gq + grow * 512 + n0 + c4) = make_uint2(pack2(v.x * s, v.y * s), pack2(v.z * s, v.w * s));
        } else if (nt < 8) {
          *(uint2*)(gk + grow * 512 + (n0 - 512) + c4) = make_uint2(pack2(v.x, v.y), pack2(v.z, v.w));
        } else {
          *(uint2*)(gg + grow * 1024 + (n0 - 2048) + c4) =
              make_uint2(pack2(siluf(v.x), siluf(v.y)), pack2(siluf(v.z), siluf(v.w)));
        }
      }
    }
    __syncthreads();
  }
}

DI void phase_gla_prep(const Params& p, int gi, unsigned char* smem) {
  const bfr* gq = (const bfr*)(p.ws + OFF_PROJ + PJ_GQ);
  const bfr* gk = (const bfr*)(p.ws + OFF_PROJ + PJ_GK);
  const float* tb = (const float*)(p.ws + OFF_TBUF);
  bfr* qe_o = (bfr*)(p.ws + OFF_QE);
  bfr* kdt_o = (bfr*)(p.ws + OFF_KDT);
  bfr* a_o = (bfr*)(p.ws + OFF_ABUF);
  float* el_o = (float*)(p.ws + OFF_ELAST);
  bfr* sQ = (bfr*)smem;
  bfr* sK = sQ + 64 * 136;
  float* tl = (float*)(sK + 64 * 136);
  float* tot = tl + 64 * 16;
  const int tid = fresh_tid(), lane = tid & 63, w = tid >> 6, r = lane & 31, hh = lane >> 5;
  const int dk = tid & 127, half = tid >> 7;
  const bool aff = (gridDim.x & 7) == 0;
  for (int lu = aff ? (int)(blockIdx.x >> 3) : (int)blockIdx.x; lu < (aff ? 128 : 1024); lu += aff ? (int)(gridDim.x >> 3) : (int)gridDim.x) {
    const int u = aff ? (((lu >> 6) * 128 + (int)(blockIdx.x & 7) * 16 + ((lu >> 2) & 15)) * 4 + (lu & 3)) : lu;
    const int d = u >> 9, cgi = (u >> 2) & 127, hd = u & 3;
    const int token0 = cgi * 64;
    {
      u32x4 lq[4], lk[4];
      f32x4 lt;
      GLOAD16(lt, tb + (size_t)(token0 + (tid >> 2)) * 32 + d * 16 + (tid & 3) * 4);
#pragma unroll
      for (int j = 0; j < 4; ++j) {
        int id = j * 256 + tid, row = id >> 4, ch = (id & 15) * 8;
        GLOAD16(lq[j], gq + (size_t)(token0 + row) * 512 + hd * 128 + ch);
        GLOAD16(lk[j], gk + (size_t)(token0 + row) * 512 + hd * 128 + ch);
      }
      asm volatile("s_waitcnt vmcnt(0)"
                   : "+v"(lt), "+v"(lq[0]), "+v"(lq[1]), "+v"(lq[2]), "+v"(lq[3]), "+v"(lk[0]), "+v"(lk[1]), "+v"(lk[2]), "+v"(lk[3])
                   :
                   : "memory");
      *(f32x4*)(tl + (tid >> 2) * 16 + (tid & 3) * 4) = lt;
#pragma unroll
      for (int j = 0; j < 4; ++j) {
        int id = j * 256 + tid, row = id >> 4, ch = (id & 15) * 8;
        *(u32x4*)(sQ + row * 136 + ch) = lq[j];
        *(u32x4*)(sK + row * 136 + ch) = lk[j];
      }
    }
    float w2[16];
    const float* wa2 = p.in[I_GWA2] + (size_t)(gi * 2 + d) * 16 * 512 + hd * 128 + dk;
#pragma unroll
    for (int j = 0; j < 16; ++j) w2[j] = wa2[j * 512];
    const float bias = p.in[I_GBA][(gi * 2 + d) * 512 + hd * 128 + dk];
    __syncthreads();
    float pc[32];
    float cum = 0.f;
#pragma unroll
    for (int sl = 0; sl < 32; ++sl) {
      const float* tr = tl + (half * 32 + sl) * 16;
      float z = bias;
#pragma unroll
      for (int j4 = 0; j4 < 4; ++j4) {
        float4 tv = *(const float4*)(tr + j4 * 4);
        z += tv.x * w2[j4 * 4] + tv.y * w2[j4 * 4 + 1] + tv.z * w2[j4 * 4 + 2] + tv.w * w2[j4 * 4 + 3];
      }
      float lg = (fminf(z, 0.f) - __logf(1.f + __expf(-fabsf(z)))) * (1.f / 16.f);
      cum += lg;
      pc[sl] = cum;
    }
    tot[half * 128 + dk] = cum;
    __syncthreads();
    const float t0 = tot[dk], t1 = tot[128 + dk];
    const float total = t0 + t1;
    const float base = half ? t0 : 0.f;
    const float etot = __expf(total);
    if (half == 0) el_o[(size_t)u * 128 + dk] = etot;
    unsigned kdp[16];
    float kd_prev = 0.f;
#pragma unroll
    for (int sl = 0; sl < 32; ++sl) {
      const int s = half * 32 + sl;
      const float pin = base + pc[sl];
      const float pex = base + (sl == 0 ? 0.f : pc[sl == 0 ? 0 : sl - 1]);
      const float b = d ? (total - pex) : pin;
      const float qv = bf2f(sQ[s * 136 + dk]), kv = bf2f(sK[s * 136 + dk]);
      const float eb = __expf(b), enb = __builtin_amdgcn_rcpf(eb);
      const float qe = qv * eb, ke = kv * enb, kd = kv * (etot * enb);
      sQ[s * 136 + dk] = f2bf(qe);
      sK[s * 136 + dk] = f2bf(ke);
      if (sl & 1) kdp[sl >> 1] = pack2(kd_prev, kd); else kd_prev = kd;
    }
    {
      uint4* dst = (uint4*)(kdt_o + ((size_t)u * 128 + dk) * 64 + half * 32);
      dst[0] = make_uint4(kdp[0], kdp[1], kdp[2], kdp[3]);
      dst[1] = make_uint4(kdp[4], kdp[5], kdp[6], kdp[7]);
      dst[2] = make_uint4(kdp[8], kdp[9], kdp[10], kdp[11]);
      dst[3] = make_uint4(kdp[12], kdp[13], kdp[14], kdp[15]);
    }
    __syncthreads();
#pragma unroll
    for (int j = 0; j < 4; ++j) {
      int id = j * 256 + tid, row = id >> 4, ch = (id & 15) * 8;
      *(uint4*)(qe_o + ((size_t)u * 64 + row) * 128 + ch) = *(const uint4*)(sQ + row * 136 + ch);
    }
    const int sb = w >> 1, tbk = w & 1;
    f32x16 acc;
#pragma unroll
    for (int i = 0; i < 16; ++i) acc[i] = 0.f;
#pragma unroll
    for (int kk = 0; kk < 8; ++kk) {
      bf16x8 a = *(const bf16x8*)(sK + (32 * sb + r) * 136 + 16 * kk + 8 * hh);
      bf16x8 b = *(const bf16x8*)(sQ + (32 * tbk + r) * 136 + 16 * kk + 8 * hh);
      acc = MFMA32(a, b, acc);
    }
    const int t = 32 * tbk + r;
#pragma unroll
    for (int g = 0; g < 4; ++g) {
      const int s4 = 32 * sb + 8 * g + 4 * hh;
      float v[4];
#pragma unroll
      for (int j = 0; j < 4; ++j) {
        const int s = s4 + j;
        const bool keep = d ? (s >= t) : (s <= t);
        v[j] = keep ? acc[4 * g + j] : 0.f;
      }
      *(uint2*)(a_o + ((size_t)u * 64 + t) * 64 + s4) = make_uint2(pack2(v[0], v[1]), pack2(v[2], v[3]));
    }
    __syncthreads();
  }
}

DI void gla_scan_unit(const Params& p, int gi, bool sample, int b, int rem, unsigned char* smem) {
  const int hd = rem >> 3, d = (rem >> 2) & 1, sp = rem & 3;
  const int nch = sample ? 16 : 4;
  const int cg0 = sample ? 64 + b * 16 : b * 4;
  const bfr* qe_i = (const bfr*)(p.ws + OFF_QE);
  const bfr* kdt_i = (const bfr*)(p.ws + OFF_KDT);
  const bfr* a_i = (const bfr*)(p.ws + OFF_ABUF);
  const float* el_i = (const float*)(p.ws + OFF_ELAST);
  const bfr* gvt = (const bfr*)(p.ws + OFF_PROJ + PJ_GVT);
  bfr* o_o = (bfr*)(p.ws + OFF_O) + (size_t)d * NTOK * 1024;
  bfr* sSt = (bfr*)smem;
  bfr* sQ = sSt + 64 * 136;
  bfr* sA = sQ + 64 * 136;
  bfr* sV = sA + 64 * 72;
  bfr* sKd = sV + 64 * 72;
  const int tid = fresh_tid(), lane = tid & 63, w = tid >> 6, r = lane & 31, hh = lane >> 5;
  f32x16 S[2];
  if (sample) {
    const float* st = p.in[I_STATE] + ((((size_t)(b * 2 + gi) * 2 + d) * 4 + hd) * 128) * 256 + sp * 64;
#pragma unroll
    for (int nb = 0; nb < 2; ++nb)
#pragma unroll
      for (int i = 0; i < 16; ++i) S[nb][i] = st[(size_t)(32 * w + crow(i, hh)) * 256 + 32 * nb + r];
  } else {
#pragma unroll
    for (int nb = 0; nb < 2; ++nb)
#pragma unroll
      for (int i = 0; i < 16; ++i) S[nb][i] = 0.f;
  }
  u32x4 pq[4], pa[2], pv[2], pkd[4];
  float pel;
  float* sEl = (float*)(sKd + 128 * 72);
#define SCAN_ISSUE(cc)                                                                                              \
  do {                                                                                                              \
    const int cl_ = d ? nch - 1 - (cc) : (cc);                                                                      \
    const int cgi_ = cg0 + cl_;                                                                                     \
    const int u_ = (d * 128 + cgi_) * 4 + hd;                                                                       \
    const int token0_ = cgi_ * 64;                                                                                  \
    _Pragma("unroll") for (int j = 0; j < 4; ++j) {                                                                 \
      int id = j * 256 + tid, row = id >> 4, ch = (id & 15) * 8;                                                    \
      GLOAD16(pq[j], qe_i + ((size_t)u_ * 64 + row) * 128 + ch);                                                    \
    }                                                                                                               \
    _Pragma("unroll") for (int j = 0; j < 2; ++j) {                                                                 \
      int id = j * 256 + tid, row = id >> 3, ch = (id & 7) * 8;                                                     \
      GLOAD16(pa[j], a_i + ((size_t)u_ * 64 + row) * 64 + ch);                                                      \
      GLOAD16(pv[j], gvt + (size_t)(hd * 256 + sp * 64 + row) * NTOK + token0_ + ch);                               \
    }                                                                                                               \
    _Pragma("unroll") for (int j = 0; j < 4; ++j) {                                                                 \
      int id = j * 256 + tid, row = id >> 3, ch = (id & 7) * 8;                                                     \
      GLOAD16(pkd[j], kdt_i + ((size_t)u_ * 128 + row) * 64 + ch);                                                  \
    }                                                                                                               \
    asm volatile("global_load_dword %0, %1, off" : "=v"(pel) : "v"(el_i + (size_t)u_ * 128 + (tid & 127)) : "memory"); \
  } while (0)
  SCAN_ISSUE(0);
  for (int c = 0; c < nch; ++c) {
    const int cl = d ? nch - 1 - c : c;
    const int cgi = cg0 + cl;
    const int token0 = cgi * 64;
    asm volatile("s_waitcnt vmcnt(0)"
                 : "+v"(pq[0]), "+v"(pq[1]), "+v"(pq[2]), "+v"(pq[3]), "+v"(pa[0]), "+v"(pa[1]), "+v"(pv[0]), "+v"(pv[1]),
                   "+v"(pkd[0]), "+v"(pkd[1]), "+v"(pkd[2]), "+v"(pkd[3]), "+v"(pel)
                 :
                 : "memory");
#pragma unroll
    for (int j = 0; j < 4; ++j) {
      int id = j * 256 + tid, row = id >> 4, ch = (id & 15) * 8;
      *(u32x4*)(sQ + row * 136 + ch) = pq[j];
    }
#pragma unroll
    for (int j = 0; j < 2; ++j) {
      int id = j * 256 + tid, row = id >> 3, ch = (id & 7) * 8;
      *(u32x4*)(sA + row * 72 + ch) = pa[j];
      *(u32x4*)(sV + row * 72 + ch) = pv[j];
    }
#pragma unroll
    for (int j = 0; j < 4; ++j) {
      int id = j * 256 + tid, row = id >> 3, ch = (id & 7) * 8;
      *(u32x4*)(sKd + row * 72 + ch) = pkd[j];
    }
    if (tid < 128) sEl[tid] = pel;
#pragma unroll
    for (int nb = 0; nb < 2; ++nb)
#pragma unroll
      for (int g = 0; g < 4; ++g)
        *(uint2*)(sSt + (32 * nb + r) * 136 + 32 * w + 8 * g + 4 * hh) =
            make_uint2(pack2(S[nb][4 * g], S[nb][4 * g + 1]), pack2(S[nb][4 * g + 2], S[nb][4 * g + 3]));
    asm volatile("s_waitcnt lgkmcnt(0)" ::: "memory");
    SCAN_ISSUE(c + 1 < nch ? c + 1 : c);
    __syncthreads();
    {
      const int tbk = w >> 1, nbo = w & 1;
      f32x16 oa, ob;
#pragma unroll
      for (int i = 0; i < 16; ++i) { oa[i] = 0.f; ob[i] = 0.f; }
#pragma unroll
      for (int kk = 0; kk < 8; ++kk) {
        bf16x8 a = *(const bf16x8*)(sQ + (32 * tbk + r) * 136 + 16 * kk + 8 * hh);
        bf16x8 bb = *(const bf16x8*)(sSt + (32 * nbo + r) * 136 + 16 * kk + 8 * hh);
        if (kk & 1) ob = MFMA32(a, bb, ob); else oa = MFMA32(a, bb, oa);
      }
#pragma unroll
      for (int kk = 0; kk < 4; ++kk) {
        bf16x8 a = *(const bf16x8*)(sA + (32 * tbk + r) * 72 + 16 * kk + 8 * hh);
        bf16x8 bb = *(const bf16x8*)(sV + (32 * nbo + r) * 72 + 16 * kk + 8 * hh);
        if (kk & 1) ob = MFMA32(a, bb, ob); else oa = MFMA32(a, bb, oa);
      }
#pragma unroll
      for (int i = 0; i < 16; ++i) oa[i] += ob[i];
#pragma unroll
      for (int i = 0; i < 16; ++i)
        o_o[(size_t)(token0 + 32 * tbk + crow(i, hh)) * 1024 + hd * 256 + sp * 64 + 32 * nbo + r] = f2bf(oa[i]);
    }
    f32x4 el[4];
#pragma unroll
    for (int g = 0; g < 4; ++g) el[g] = *(const f32x4*)(sEl + 32 * w + 8 * g + 4 * hh);
#pragma unroll
    for (int nb = 0; nb < 2; ++nb)
#pragma unroll
      for (int g = 0; g < 4; ++g) {
        S[nb][4 * g] *= el[g][0]; S[nb][4 * g + 1] *= el[g][1]; S[nb][4 * g + 2] *= el[g][2]; S[nb][4 * g + 3] *= el[g][3];
      }
#pragma unroll
    for (int kk = 0; kk < 4; ++kk) {
      bf16x8 a = *(const bf16x8*)(sKd + (32 * w + r) * 72 + 16 * kk + 8 * hh);
#pragma unroll
      for (int nb = 0; nb < 2; ++nb) {
        bf16x8 bb = *(const bf16x8*)(sV + (32 * nb + r) * 72 + 16 * kk + 8 * hh);
        S[nb] = MFMA32(a, bb, S[nb]);
      }
    }
    __syncthreads();
  }
#undef SCAN_ISSUE
  asm volatile("s_waitcnt vmcnt(0)"
               : "+v"(pq[0]), "+v"(pq[1]), "+v"(pq[2]), "+v"(pq[3]), "+v"(pa[0]), "+v"(pa[1]), "+v"(pv[0]), "+v"(pv[1]),
                 "+v"(pkd[0]), "+v"(pkd[1]), "+v"(pkd[2]), "+v"(pkd[3]), "+v"(pel)
               :
               : "memory");
  if (!sample) {
    float* so = p.out + OUT_STATE + ((((size_t)(b * 2 + gi) * 2 + d) * 4 + hd) * 128) * 256 + sp * 64;
#pragma unroll
    for (int nb = 0; nb < 2; ++nb)
#pragma unroll
      for (int i = 0; i < 16; ++i) so[(size_t)(32 * w + crow(i, hh)) * 256 + 32 * nb + r] = S[nb][i];
  }
}
DI void phase_gla_scan(const Params& p, int gi, unsigned char* smem) {
  const int nb = gridDim.x, bid = blockIdx.x;
  if ((nb & 7) == 0) {
    const int lx = bid & 7, per = nb >> 3;
    const int nun = lx >= 4 ? 32 : 128;
    for (int lu = bid >> 3; lu < nun; lu += per) {
      const bool sample = lx >= 4;
      gla_scan_unit(p, gi, sample, sample ? lx - 4 : lx * 4 + (lu >> 5), lu & 31, smem);
    }
  } else {
    for (int idx = bid; idx < 640; idx += nb) {
      const bool sample = idx < 128;
      const int q = sample ? idx : idx - 128;
      gla_scan_unit(p, gi, sample, q >> 5, q & 31, smem);
    }
  }
}

DI void phase_gla_post(const Params& p, int gi) {
  const int ftid = fresh_tid();
  const int lane = ftid & 63;
  const int gw = blockIdx.x * 4 + (ftid >> 6), nw = gridDim.x * 4;
  const bfr* o0 = (const bfr*)(p.ws + OFF_O);
  const bfr* o1 = o0 + (size_t)NTOK * 1024;
  const bfr* gg = (const bfr*)(p.ws + OFF_PROJ + PJ_GG);
  bfr* uo = (bfr*)(p.ws + OFF_U);
  const float4 on = *(const float4*)(p.in[I_GONORM] + gi * 256 + lane * 4);
  const bool aff = (gridDim.x & 7) == 0;
  const int xw = aff ? (int)(blockIdx.x >> 3) * 4 + (ftid >> 6) : gw, xnw = aff ? (int)(gridDim.x >> 3) * 4 : nw;
  const int xn = aff ? NTOK / 16 : NTOK / 2, xb0 = aff ? (int)(blockIdx.x & 7) * (NTOK / 16) : 0;
  for (int jj = xw; jj < xn; jj += xnw) {
    const int rg = xb0 + jj;
    uint2 a[8], b[8], g[8];
#pragma unroll
    for (int q = 0; q < 8; ++q) {
      const size_t idx = (size_t)(rg * 2 + (q >> 2)) * 1024 + (q & 3) * 256 + lane * 4;
      a[q] = *(const uint2*)(o0 + idx); b[q] = *(const uint2*)(o1 + idx); g[q] = *(const uint2*)(gg + idx);
    }
#pragma unroll
    for (int q = 0; q < 8; ++q) {
      const size_t idx = (size_t)(rg * 2 + (q >> 2)) * 1024 + (q & 3) * 256 + lane * 4;
      float v0 = bf2f(a[q].x & 0xffff) + bf2f(b[q].x & 0xffff), v1 = bf2f(a[q].x >> 16) + bf2f(b[q].x >> 16);
      float v2 = bf2f(a[q].y & 0xffff) + bf2f(b[q].y & 0xffff), v3 = bf2f(a[q].y >> 16) + bf2f(b[q].y >> 16);
      float ss = wave_sum(v0 * v0 + v1 * v1 + v2 * v2 + v3 * v3);
      float rstd = rsqrtf(ss * (1.f / 256.f) + EPSN);
      float r0 = v0 * rstd * on.x * bf2f(g[q].x & 0xffff), r1 = v1 * rstd * on.y * bf2f(g[q].x >> 16);
      float r2 = v2 * rstd * on.z * bf2f(g[q].y & 0xffff), r3 = v3 * rstd * on.w * bf2f(g[q].y >> 16);
      *(uint2*)(uo + idx) = make_uint2(pack2(r0, r1), pack2(r2, r3));
    }
  }
}

DI void phase_out_proj(const Params& p, int l, const bfr* Bt, unsigned char* smem) {
  const bfr* A = (const bfr*)(p.ws + OFF_U);
  const float* mod = (const float*)(p.ws + OFF_MOD) + (size_t)l * 5 * 3072;
  float* sC = (float*)smem;
  const int tid = threadIdx.x;
  for (TileIter ti(8); ti.valid(); ti.next()) {
    const int mt = ti.mt(), nt = ti.nt(), m0 = mt * 128, n0 = nt * 128;
    const int erow = tid >> 5, ec4 = (tid & 31) * 4;
    f32x4 xo[8], gtv, ngv, nsv;
#pragma unroll
    for (int it = 0; it < 8; ++it) GLOAD16(xo[it], xrow_ptr(p, l, m0 + it * 8 + erow) + n0 + ec4);
    GLOAD16(gtv, mod + modrow(m0) * 3072 + 2048 + n0 + ec4);
    GLOAD16(ngv, p.in[I_NORMG] + (l < 3 ? l + 1 : l) * DM + n0 + ec4);
    GLOAD16(nsv, mod + (l < 3 ? 5 * 3072 : 0) + modrow(m0) * 3072 + 1024 + n0 + ec4);
    f32x16 acc[2][2];
    gemm_core<128>(A, Bt, 1024, m0, n0, smem, acc);
    stage_acc<128>(acc, sC);
#pragma unroll
    for (int hb = 0; hb < 2; ++hb) {
      asm volatile("s_waitcnt vmcnt(0)"
                   : "+v"(xo[0]), "+v"(xo[1]), "+v"(xo[2]), "+v"(xo[3]), "+v"(xo[4]), "+v"(xo[5]), "+v"(xo[6]), "+v"(xo[7]), "+v"(gtv), "+v"(ngv), "+v"(nsv)
                   :
                   : "memory");
      if (hb == 0) __syncthreads();
      f32x4 o[8];
#pragma unroll
      for (int it = 0; it < 8; ++it) {
        const int row = hb * 64 + it * 8 + erow;
        const float4 v = *(const float4*)(sC + row * 132 + ec4);
        o[it][0] = xo[it][0] + gtv[0] * v.x; o[it][1] = xo[it][1] + gtv[1] * v.y;
        o[it][2] = xo[it][2] + gtv[2] * v.z; o[it][3] = xo[it][3] + gtv[3] * v.w;
      }
      if (hb == 0) {
#pragma unroll
        for (int it = 0; it < 8; ++it) GLOAD16(xo[it], xrow_ptr(p, l, m0 + 64 + it * 8 + erow) + n0 + ec4);
      }
#pragma unroll
      for (int it = 0; it < 8; ++it) *(f32x4*)(p.out + (size_t)(m0 + hb * 64 + it * 8 + erow) * DM + n0 + ec4) = o[it];
      if (l < 3) {
        const float c0 = ngv[0] * (1.f + nsv[0]), c1 = ngv[1] * (1.f + nsv[1]), c2 = ngv[2] * (1.f + nsv[2]), c3 = ngv[3] * (1.f + nsv[3]);
#pragma unroll
        for (int it = 0; it < 8; ++it) {
          const int grow = m0 + hb * 64 + it * 8 + erow;
          const float ss = half_sum(o[it][0] * o[it][0] + o[it][1] * o[it][1] + o[it][2] * o[it][2] + o[it][3] * o[it][3]);
          if ((tid & 31) == 0) atomicAdd((float*)(p.ws + OFF_ROWSS) + (size_t)(l + 1) * NTOK + grow, ss);
          *(uint2*)((bfr*)(p.ws + OFF_H) + (size_t)grow * DM + n0 + ec4) =
              make_uint2(pack2(o[it][0] * c0, o[it][1] * c1), pack2(o[it][2] * c2, o[it][3] * c3));
        }
      }
    }
    __syncthreads();
  }
}

DI void phase_att_in(const Params& p, int ai, unsigned char* smem) {
  const int lyr = 2 * ai + 1;
  const bfr* A = (const bfr*)(p.ws + OFF_H);
  const bfr* Bt = (const bfr*)(p.ws + OFF_WT_ATT_IN) + (size_t)ai * ATT_N * 1024;
  bfr* aq = (bfr*)(p.ws + OFF_PROJ2 + PJ_AQ);
  bfr* ag = (bfr*)(p.ws + OFF_PROJ2 + PJ_AG);
  bfr* akp = (bfr*)(p.ws + OFF_PROJ2 + PJ_AKP);
  bfr* avpt = (bfr*)(p.ws + OFF_PROJ2 + PJ_AVPT);
  bfr* ks = (bfr*)(p.ws + OFF_KS);
  bfr* vst = (bfr*)(p.ws + OFF_VST);
  const float* rc = (const float*)(p.ws + OFF_ROPE);
  const float* rs = rc + 64 * 32;
  const float* qn = p.in[I_AQN] + ai * 128;
  const float* kn = p.in[I_AKN] + ai * 128;
  float* sC = (float*)smem;
  const int tid = threadIdx.x;
  constexpr int NT = 20, MT = 64;
  for (TileIter ti(24); ti.valid(); ti.next()) {
    f32x16 acc[2][2];
    const int nfull = (ti.mmask + 1) * 16;
    if (ti.lt >= nfull) {
      const int ht = ti.lt - nfull, m0h = (ti.mbase + (ht & ti.mmask)) * 128, n0h = 2048 + (ht >> ti.mshift) * 64;
      FixRegs fx; fix_issue<64>(p, fx, lyr, m0h, n0h);
      gemm_core<64>(A, Bt, 1024, m0h, n0h, smem, acc);
      fix_apply<64>(fx, acc);
      stage_acc<64>(acc, sC);
      __syncthreads();
#pragma unroll 4
      for (int it = 0; it < 8; ++it) {
        int idx = it * 256 + tid, row = idx >> 4, c4 = (idx & 15) * 4;
        float4 v = *(const float4*)(sC + row * 132 + c4);
        *(uint2*)(ag + (size_t)(m0h + row) * 1024 + (n0h - 1536) + c4) =
            make_uint2(pack2(siluf(v.x), siluf(v.y)), pack2(siluf(v.z), siluf(v.w)));
      }
      __syncthreads();
      continue;
    }
    const int mt = ti.mt(), nt = ti.nt(), m0 = mt * 128, n0 = nt * 128;
    const bool samp = m0 >= NPT;
    FixRegs fx; fix_issue<128>(p, fx, lyr, m0, n0);
    gemm_core<128>(A, Bt, 1024, m0, n0, smem, acc);
    fix_apply<128>(fx, acc);
    if (nt == 10 || nt == 11) {
      const int hk = nt - 10;
      stage_acc_t(acc, sC);
      __syncthreads();
      bfr* dst; size_t ldt;
      if (!samp) { int b = m0 >> 8, t0 = m0 & 255; dst = avpt + (size_t)((b * 2 + hk) * 128) * 256 + t0; ldt = 256; }
      else { int b = (m0 - NPT) >> 10, t0 = (m0 - NPT) & 1023; dst = vst + (size_t)(((ai * 4 + b) * 2 + hk) * 128) * 1280 + t0; ldt = 1280; }
#pragma unroll 4
      for (int it = 0; it < 16; ++it) {
        int idx = it * 256 + tid, col = idx >> 5, r4 = (idx & 31) * 4;
        float4 v = *(const float4*)(sC + col * 132 + r4);
        *(uint2*)(dst + (size_t)col * ldt + r4) = make_uint2(pack2(v.x, v.y), pack2(v.z, v.w));
      }
      if (!samp) {
        __syncthreads();
        stage_acc<128>(acc, sC);
        __syncthreads();
        const int b = m0 >> 8, t0 = m0 & 255;
#pragma unroll 4
        for (int it = 0; it < 16; ++it) {
          int idx = it * 256 + tid, row = idx >> 5, c4 = (idx & 31) * 4;
          float4 v = *(const float4*)(sC + row * 132 + c4);
          *(float4*)(p.out + OUT_CV + ((((size_t)b * 2 + ai) * 256 + t0 + row) * 2 + hk) * 128 + c4) = v;
        }
      }
    } else {
      stage_acc<128>(acc, sC);
      __syncthreads();
      const int c4 = (tid & 31) * 4;
      const float* wn = nt < 8 ? qn : kn;
      const float4 wv = *(const float4*)(wn + c4), pw = *(const float4*)(wn + (c4 ^ 32));
#pragma unroll 2
      for (int it = 0; it < 16; ++it) {
        const int row = it * 8 + (tid >> 5);
        float4 v = *(const float4*)(sC + row * 132 + c4);
        const int grow = m0 + row;
        if (nt >= 12) {
          *(uint2*)(ag + (size_t)grow * 1024 + (n0 - 1536) + c4) =
              make_uint2(pack2(siluf(v.x), siluf(v.y)), pack2(siluf(v.z), siluf(v.w)));
        } else {
          float ss = half_sum(v.x * v.x + v.y * v.y + v.z * v.z + v.w * v.w);
          const float rstd = rsqrtf(ss * (1.f / 128.f) + EPSN);
          float4 xn = make_float4(v.x * rstd * wv.x, v.y * rstd * wv.y, v.z * rstd * wv.z, v.w * rstd * wv.w);
          float4 o = xn;
          if (samp) {
            const int cp = c4 ^ 32;
            float4 pv = *(const float4*)(sC + row * 132 + cp);
            float4 pn = make_float4(pv.x * rstd * pw.x, pv.y * rstd * pw.y, pv.z * rstd * pw.z, pv.w * rstd * pw.w);
            const int t = (grow - NPT) & 1023;
            const int pos = (c4 < 64) ? (t >> 6) : (t & 63);
            float4 cs = *(const float4*)(rc + pos * 32 + (c4 & 31));
            float4 sn = *(const float4*)(rs + pos * 32 + (c4 & 31));
            const float sg = (c4 & 32) ? 1.f : -1.f;
            o = make_float4(xn.x * cs.x + sg * pn.x * sn.x, xn.y * cs.y + sg * pn.y * sn.y,
                            xn.z * cs.z + sg * pn.z * sn.z, xn.w * cs.w + sg * pn.w * sn.w);
          }
          if (nt < 8) {
            const float s = 0.08838834764831845f * 1.4426950408889634f;
            *(uint2*)(aq + (size_t)grow * 1024 + n0 + c4) = make_uint2(pack2(o.x * s, o.y * s), pack2(o.z * s, o.w * s));
          } else {
            const int hk = nt - 8;
            uint2 ob = make_uint2(pack2(o.x, o.y), pack2(o.z, o.w));
            if (!samp) {
              const int b = grow >> 8, t = grow & 255;
              *(float4*)(p.out + OUT_CK + ((((size_t)b * 2 + ai) * 256 + t) * 2 + hk) * 128 + c4) = o;
              *(uint2*)(akp + (size_t)grow * 256 + hk * 128 + c4) = ob;
            } else {
              const int b = (grow - NPT) >> 10, t = (grow - NPT) & 1023;
              *(uint2*)(ks + ((size_t)(ai * 4 + b) * 1280 + t) * 256 + hk * 128 + c4) = ob;
            }
          }
        }
      }
    }
    __syncthreads();
  }
}

DI void attn_unit(const Params& p, int ai, bool sample, int unit, unsigned char* smem) {
  int b, hkv, qb, ntile, tokq0;
  const bfr* Kb; const bfr* Vb; size_t ldt;
  if (sample) {
    b = unit >> 6; hkv = (unit >> 5) & 1; qb = unit & 31; ntile = 20;
    tokq0 = NPT + b * 1024 + qb * 32;
    Kb = (const bfr*)(p.ws + OFF_KS) + (size_t)(ai * 4 + b) * 1280 * 256 + hkv * 128;
    Vb = (const bfr*)(p.ws + OFF_VST) + (size_t)(((ai * 4 + b) * 2 + hkv) * 128) * 1280; ldt = 1280;
  } else {
    b = unit >> 4; hkv = (unit >> 3) & 1; qb = unit & 7; ntile = 4;
    tokq0 = b * 256 + qb * 32;
    Kb = (const bfr*)(p.ws + OFF_PROJ2 + PJ_AKP) + (size_t)(b * 256) * 256 + hkv * 128;
    Vb = (const bfr*)(p.ws + OFF_PROJ2 + PJ_AVPT) + (size_t)((b * 2 + hkv) * 128) * 256; ldt = 256;
  }
  const bfr* aq = (const bfr*)(p.ws + OFF_PROJ2 + PJ_AQ);
  const bfr* ag = (const bfr*)(p.ws + OFF_PROJ2 + PJ_AG);
  bfr* uo = (bfr*)(p.ws + OFF_U);
  const int tid = fresh_tid(), lane = tid & 63, w = tid >> 6, r = lane & 31, hh = lane >> 5;
  const int hq = hkv * 4 + w;
  unsigned char* sK = smem;
  unsigned char* sV = smem + 32768;
  bf16x8 qf[8];
#pragma unroll
  for (int kk = 0; kk < 8; ++kk) qf[kk] = *(const bf16x8*)(aq + (size_t)(tokq0 + r) * 1024 + hq * 128 + 16 * kk + 8 * hh);
  f32x16 oacc[4];
#pragma unroll
  for (int a = 0; a < 4; ++a)
#pragma unroll
    for (int i = 0; i < 16; ++i) oacc[a][i] = 0.f;
  float m_run = -INFINITY, l_run = 0.f;
  int koff[4], voff[4];
#pragma unroll
  for (int i = 0; i < 4; ++i) {
    const int krow = (i * 4 + w) * 4 + (lane >> 4);
    koff[i] = krow * 256 + (((lane & 15) ^ (krow & 15)) << 3);
    const int vrow = (i * 4 + w) * 8 + (lane >> 3);
    voff[i] = vrow * (int)ldt + (((lane & 7) ^ ((vrow >> 1) & 7)) << 3);
  }
#define ATT_STAGE(buf, kt)                                                                                          \
  do {                                                                                                              \
    _Pragma("unroll") for (int i = 0; i < 4; ++i) {                                                                 \
      __builtin_amdgcn_global_load_lds((const unsigned*)(Kb + koff[i] + (kt) * (64 * 256)),                         \
                                       (unsigned*)(sK + (buf) * 16384 + (i * 4 + w) * 1024), 16, 0, 0);            \
      __builtin_amdgcn_global_load_lds((const unsigned*)(Vb + voff[i] + (kt) * 64),                                 \
                                       (unsigned*)(sV + (buf) * 16384 + (i * 4 + w) * 1024), 16, 0, 0);            \
    }                                                                                                               \
  } while (0)
  ATT_STAGE(0, 0);
  asm volatile("s_waitcnt vmcnt(0)" ::: "memory");
  __syncthreads();
  const int kswz = r & 15, vswz = (r >> 1) & 7;
  for (int kt = 0; kt < ntile; ++kt) {
    const int cur = kt & 1;
    if (kt + 1 < ntile) ATT_STAGE(cur ^ 1, kt + 1);
    const unsigned char* cK = sK + cur * 16384 + r * 256;
    const unsigned char* cV = sV + cur * 16384 + r * 128 + 8 * hh;
    f32x16 sacc[2];
#pragma unroll
    for (int kb = 0; kb < 2; ++kb)
#pragma unroll
      for (int i = 0; i < 16; ++i) sacc[kb][i] = 0.f;
#pragma unroll
    for (int kk = 0; kk < 8; ++kk)
#pragma unroll
      for (int kb = 0; kb < 2; ++kb) {
        bf16x8 a = *(const bf16x8*)(cK + kb * 8192 + (((2 * kk + hh) ^ kswz) << 4));
        sacc[kb] = MFMA32(a, qf[kk], sacc[kb]);
      }
    float mt = sacc[0][0];
#pragma unroll
    for (int kb = 0; kb < 2; ++kb)
#pragma unroll
      for (int i = 0; i < 16; ++i) mt = fmaxf(mt, sacc[kb][i]);
    mt = fmaxf(mt, __shfl_xor(mt, 32));
    const bool bump = mt > m_run + 8.f;
    if (__builtin_amdgcn_ballot_w64(bump) != 0ull) {
      const float m_new = bump ? mt : m_run;
      const float alpha = __builtin_amdgcn_exp2f(m_run - m_new);
      m_run = m_new;
      l_run *= alpha;
#pragma unroll
      for (int a = 0; a < 4; ++a)
#pragma unroll
        for (int i = 0; i < 16; ++i) oacc[a][i] *= alpha;
    }
    float ls = 0.f;
#pragma unroll
    for (int kb = 0; kb < 2; ++kb)
#pragma unroll
      for (int i = 0; i < 16; ++i) { float pv = __builtin_amdgcn_exp2f(sacc[kb][i] - m_run); sacc[kb][i] = pv; ls += pv; }
    l_run += ls;
#pragma unroll
    for (int kb = 0; kb < 2; ++kb)
#pragma unroll
      for (int s2 = 0; s2 < 2; ++s2) {
        unsigned pk[4];
#pragma unroll
        for (int j = 0; j < 4; ++j) pk[j] = pack2(sacc[kb][8 * s2 + 2 * j], sacc[kb][8 * s2 + 2 * j + 1]);
        bf16x8 pb = __builtin_bit_cast(bf16x8, make_uint4(pk[0], pk[1], pk[2], pk[3]));
        const int c0 = 4 * kb + 2 * s2;
#pragma unroll
        for (int dvb = 0; dvb < 4; ++dvb) {
          const unsigned char* vp = cV + dvb * 4096;
          uint2 lo = *(const uint2*)(vp + ((c0 ^ vswz) << 4)), hi = *(const uint2*)(vp + (((c0 + 1) ^ vswz) << 4));
          bf16x8 av = __builtin_bit_cast(bf16x8, make_uint4(lo.x, lo.y, hi.x, hi.y));
          oacc[dvb] = MFMA32(av, pb, oacc[dvb]);
        }
      }
    asm volatile("s_waitcnt vmcnt(0)" ::: "memory");
    __syncthreads();
  }
#undef ATT_STAGE
  u32x2 gv[16];
#pragma unroll
  for (int dvb = 0; dvb < 4; ++dvb)
#pragma unroll
    for (int g = 0; g < 4; ++g)
      asm volatile("global_load_dwordx2 %0, %1, off"
                   : "=v"(gv[dvb * 4 + g])
                   : "v"(ag + (size_t)(tokq0 + r) * 1024 + hq * 128 + 32 * dvb + 8 * g + 4 * hh)
                   : "memory");
  const float lt = l_run + __shfl_xor(l_run, 32);
  const float inv = 1.f / lt;
  asm volatile("s_waitcnt vmcnt(0)"
               : "+v"(gv[0]), "+v"(gv[1]), "+v"(gv[2]), "+v"(gv[3]), "+v"(gv[4]), "+v"(gv[5]), "+v"(gv[6]), "+v"(gv[7]),
                 "+v"(gv[8]), "+v"(gv[9]), "+v"(gv[10]), "+v"(gv[11]), "+v"(gv[12]), "+v"(gv[13]), "+v"(gv[14]), "+v"(gv[15])
               :
               : "memory");
#pragma unroll
  for (int dvb = 0; dvb < 4; ++dvb)
#pragma unroll
    for (int g = 0; g < 4; ++g) {
      size_t idx = (size_t)(tokq0 + r) * 1024 + hq * 128 + 32 * dvb + 8 * g + 4 * hh;
      const unsigned gx = gv[dvb * 4 + g][0], gy = gv[dvb * 4 + g][1];
      float o0 = oacc[dvb][4 * g] * inv * bf2f(gx & 0xffff), o1 = oacc[dvb][4 * g + 1] * inv * bf2f(gx >> 16);
      float o2 = oacc[dvb][4 * g + 2] * inv * bf2f(gy & 0xffff), o3 = oacc[dvb][4 * g + 3] * inv * bf2f(gy >> 16);
      *(uint2*)(uo + idx) = make_uint2(pack2(o0, o1), pack2(o2, o3));
    }
}
DI void phase_attn(const Params& p, int ai, unsigned char* smem) {
  const int nb = gridDim.x, bid = blockIdx.x;
  int idx, step;
  if (nb >= 512) { idx = bid; step = bid < 256 ? 512 : nb - 256; }
  else { idx = bid; step = nb; }
  for (; idx < 512; idx += step) {
    const bool sample = idx < 256;
    attn_unit(p, ai, sample, sample ? idx : idx - 256, smem);
  }
}


#define XB_TMO      128
#define XB_XCNT(j)  (256  + 64 * (j))
#define XB_XSUB(j)  (1280 + 64 * (j))
#define XB_XGEN(j)  (2304 + 64 * (j))
#define XB_TOP      3328
#define XB_TOPGEN   3392
#define XCD_BAR_WORDS 3456
#define XB_SPIN_CAP (1u << 18)
#define LAS __attribute__((address_space(3)))
DI unsigned xb_ld(unsigned* p) { return __hip_atomic_load(p, __ATOMIC_RELAXED, __HIP_MEMORY_SCOPE_AGENT); }
DI unsigned xb_add(unsigned* p, unsigned v) { return __hip_atomic_fetch_add(p, v, __ATOMIC_RELAXED, __HIP_MEMORY_SCOPE_AGENT); }
DI unsigned xb_xcc_id() { return (unsigned)__builtin_amdgcn_s_getreg((3 << 11) | 20) & 0xFu; }
#define XB_SPIN(cond, bar) do { unsigned _sp = 0; while (cond) { __builtin_amdgcn_s_sleep(1); \
    if ((++_sp & 255u) == 0u) { if (xb_ld(&(bar)[XB_TMO])) break; if (_sp > XB_SPIN_CAP) { atomicAdd(&(bar)[XB_TMO], 1u); break; } } } } while (0)
struct XcdBarrier { unsigned* bar; unsigned x; volatile LAS unsigned* st; };
DI XcdBarrier xcd_barrier_post(unsigned* bar, volatile LAS unsigned* st) {
  XcdBarrier b; b.bar = bar; b.x = xb_xcc_id(); b.st = st;
  if (threadIdx.x == 0) (void)xb_add(&bar[XB_XCNT(b.x)], 1u);
  return b;
}
DI void xcd_barrier_complete(unsigned* bar, unsigned x, unsigned& nloc, unsigned& nx) {
  const unsigned G = gridDim.x * gridDim.y * gridDim.z;
  unsigned sum, cnt, mine, sp = 0u;
  for (;;) {
    sum = 0u; cnt = 0u; mine = 0u;
#pragma unroll
    for (unsigned j = 0; j < 16; ++j) { const unsigned c = xb_ld(&bar[XB_XCNT(j)]); sum += c; cnt += (c > 0u) ? 1u : 0u; mine = (j == x) ? c : mine; }
    if (sum == G) break;
    __builtin_amdgcn_s_sleep(1);
    if ((++sp & 255u) == 0u) { if (xb_ld(&bar[XB_TMO])) break; if (sp > XB_SPIN_CAP) { atomicAdd(&bar[XB_TMO], 1u); break; } }
  }
  nloc = mine > 0u ? mine : 1u; nx = cnt > 0u ? cnt : 1u;
}
DI void xcd_barrier(const XcdBarrier& b) {
  asm volatile("s_waitcnt vmcnt(0)" ::: "memory");
  __syncthreads();
  if (threadIdx.x == 0) {
    unsigned* bar = b.bar;
    __builtin_amdgcn_s_waitcnt(0);
    unsigned nloc = b.st[0], nx = b.st[1];
    if (nloc == 0u) { xcd_barrier_complete(bar, b.x, nloc, nx); b.st[0] = nloc; b.st[1] = nx; }
    const unsigned old = xb_add(&bar[XB_XSUB(b.x)], 1u);
    const unsigned gen = old / nloc;
    if (old + 1u == (gen + 1u) * nloc) {
      __builtin_amdgcn_fence(__ATOMIC_RELEASE, "agent");
      asm volatile("s_waitcnt vmcnt(0)" ::: "memory");
      const unsigned og = xb_add(&bar[XB_TOP], 1u);
      const unsigned tg = og / nx;
      if (og + 1u == (tg + 1u) * nx) xb_add(&bar[XB_TOPGEN], 1u);
      else XB_SPIN(xb_ld(&bar[XB_TOPGEN]) == tg, bar);
      __builtin_amdgcn_fence(__ATOMIC_ACQUIRE, "agent");
      xb_add(&bar[XB_XGEN(b.x)], 1u);
      asm volatile("s_waitcnt vmcnt(0)" ::: "memory");
    } else {
      XB_SPIN(xb_ld(&bar[XB_XGEN(b.x)]) == gen, bar);
      __builtin_amdgcn_fence(__ATOMIC_ACQUIRE, "agent");
      asm volatile("s_waitcnt vmcnt(0)" ::: "memory");
    }
  }
  __syncthreads();
}

#define XL_SUB(j)  (XCD_BAR_WORDS + 64 * (j))
#define XL_GEN(j)  (XCD_BAR_WORDS + 1024 + 64 * (j))
#define XL_MAP     (XCD_BAR_WORDS + 2048)
#define XL_MISM    (XCD_BAR_WORDS + 2048 + 64)
DI void xcd_local_barrier(const XcdBarrier& b, unsigned nloc) {
  asm volatile("s_waitcnt vmcnt(0)" ::: "memory");
  __syncthreads();
  if (threadIdx.x == 0) {
    unsigned* bar = b.bar;
    __builtin_amdgcn_s_waitcnt(0);
    const unsigned old = xb_add(&bar[XL_SUB(b.x)], 1u);
    const unsigned gen = old / nloc;
    if (old + 1u == (gen + 1u) * nloc) xb_add(&bar[XL_GEN(b.x)], 1u);
    else XB_SPIN(xb_ld(&bar[XL_GEN(b.x)]) == gen, bar);
    __builtin_amdgcn_fence(__ATOMIC_ACQUIRE, "agent");
    asm volatile("s_waitcnt vmcnt(0)" ::: "memory");
  }
  __syncthreads();
}

#ifndef REP_P0
#define REP_P0 1
#endif
#ifndef REP_NORM
#define REP_NORM 1
#endif
#ifndef REP_PREP
#define REP_PREP 1
#endif
#ifndef REP_POST
#define REP_POST 1
#endif
#ifndef REP_GIN
#define REP_GIN 1
#endif
#ifndef REP_AIN
#define REP_AIN 1
#endif
#ifndef REP_SCAN
#define REP_SCAN 1
#endif
#ifndef REP_ATT
#define REP_ATT 1
#endif
#ifndef REP_OUT0
#define REP_OUT0 1
#endif
#ifndef REP_SYNC
#define REP_SYNC 1
#endif
#define SYNC() do { xcd_barrier(xb); if (REP_SYNC >= 2) xcd_barrier(xb); if (REP_SYNC >= 3) xcd_barrier(xb); } while (0)
#ifndef TPROBE
#define TPROBE 0
#endif
#define TPK 4
#define RUN(n, stmt) do { stmt; SYNC(); if ((n) >= 2) { stmt; SYNC(); } } while (0)
#define SYNCL() do { if (xl) xcd_local_barrier(xb, gridDim.x >> 3); else xcd_barrier(xb); } while (0)
#define RUNL(n, stmt) do { stmt; SYNCL(); if ((n) >= 2) { stmt; SYNCL(); } } while (0)
#define TRUN(id, n, stmt) do { unsigned long long t0_ = 0; if (TPROBE == (id)) t0_ = __builtin_amdgcn_s_memrealtime(); RUN(n, stmt); if (TPROBE == (id)) tacc += __builtin_amdgcn_s_memrealtime() - t0_; } while (0)
#define TRUNL(id, n, stmt) do { unsigned long long t0_ = 0; if (TPROBE == (id)) t0_ = __builtin_amdgcn_s_memrealtime(); RUNL(n, stmt); if (TPROBE == (id)) tacc += __builtin_amdgcn_s_memrealtime() - t0_; } while (0)

__global__ void __launch_bounds__(256, 2) fwd_megakernel(Params p) {
  __shared__ __attribute__((aligned(16))) unsigned char smem[SMEM_BYTES + 16];
  cg::grid_group grid = cg::this_grid();
  if (p.never) grid.sync();
  if (threadIdx.x == 0) *(uint4*)(smem + SMEM_BYTES) = make_uint4(0u, 0u, 0u, 0u);
  __syncthreads();
  unsigned long long tacc = 0;
  XcdBarrier xb = xcd_barrier_post((unsigned*)(p.ws + OFF_BAR), (volatile LAS unsigned*)(smem + SMEM_BYTES));
  if (threadIdx.x == 0) {
    unsigned* bar = (unsigned*)(p.ws + OFF_BAR);
    const unsigned prev = atomicCAS(&bar[XL_MAP + (blockIdx.x & 7)], 0u, xb.x + 1u);
    if (prev != 0u && prev != xb.x + 1u) atomicAdd(&bar[XL_MISM], 1u);
  }
  bool xl = false;
  TRUN(1, REP_P0, phase0(p, smem));
  {
    if (threadIdx.x == 0) {
      unsigned* bar = (unsigned*)(p.ws + OFF_BAR);
      unsigned ok = ((gridDim.x & 7) == 0 && xb_ld(&bar[XL_MISM]) == 0u) ? 1u : 0u;
      const unsigned per = gridDim.x >> 3;
      unsigned nz = 0;
      for (unsigned j = 0; j < 16; ++j) { const unsigned c = xb_ld(&bar[XB_XCNT(j)]); if (c) { ++nz; if (c != per) ok = 0u; } }
      if (nz != 8u) ok = 0u;
      *(volatile unsigned*)(smem + SMEM_BYTES + 8) = ok;
    }
    __syncthreads();
    xl = *(volatile unsigned*)(smem + SMEM_BYTES + 8) != 0u;
  }
  TRUN(2, REP_NORM, phase_pre0(p));
  TRUNL(3, REP_GIN, phase_gla_in(p, 0, smem));
  TRUNL(4, REP_PREP, phase_gla_prep(p, 0, smem));
  TRUNL(5, REP_SCAN, phase_gla_scan(p, 0, smem));
  TRUNL(6, REP_POST, phase_gla_post(p, 0));
  TRUNL(7, REP_OUT0, phase_out_proj(p, 0, (const bfr*)(p.ws + OFF_WT_GLA_OUT), smem));
  TRUN(8, REP_AIN, phase_att_in(p, 0, smem));
  TRUN(9, REP_ATT, phase_attn(p, 0, smem));
  TRUNL(7, 1, phase_out_proj(p, 1, (const bfr*)(p.ws + OFF_WT_ATT_OUT), smem));
  TRUNL(3, REP_GIN, phase_gla_in(p, 1, smem));
  TRUNL(4, REP_PREP, phase_gla_prep(p, 1, smem));
  TRUNL(5, REP_SCAN, phase_gla_scan(p, 1, smem));
  TRUNL(6, REP_POST, phase_gla_post(p, 1));
  TRUNL(7, 1, phase_out_proj(p, 2, (const bfr*)(p.ws + OFF_WT_GLA_OUT) + (size_t)1024 * 1024, smem));
  TRUN(8, REP_AIN, phase_att_in(p, 1, smem));
  TRUN(9, REP_ATT, phase_attn(p, 1, smem));
  {
    unsigned long long t0_ = 0;
    if (TPROBE == 7) t0_ = __builtin_amdgcn_s_memrealtime();
    phase_out_proj(p, 3, (const bfr*)(p.ws + OFF_WT_ATT_OUT) + (size_t)1024 * 1024, smem);
    if (TPROBE == 7) { SYNC(); tacc += __builtin_amdgcn_s_memrealtime() - t0_; }
  }
  if (TPROBE != 0 && blockIdx.x == 0 && threadIdx.x == 0) {
    const unsigned long long te = __builtin_amdgcn_s_memrealtime();
    while (__builtin_amdgcn_s_memrealtime() - te < TPK * tacc) __builtin_amdgcn_s_sleep(8);
  }
}

extern "C" void kernel_launch(void* const* d_in, const int* in_sizes, int n_in, void* d_out, int out_size, void* d_ws,
                              size_t ws_size, hipStream_t stream) {
  static int grid_blocks = 0;
  if (!grid_blocks) {
    int dev = 0, cus = 0, per_cu = 0;
    hipGetDevice(&dev);
    hipDeviceGetAttribute(&cus, hipDeviceAttributeMultiprocessorCount, dev);
    hipOccupancyMaxActiveBlocksPerMultiprocessor(&per_cu, fwd_megakernel, 256, 0);
    if (per_cu > 2) per_cu = 2;
    if (per_cu < 1) per_cu = 1;
    grid_blocks = cus * per_cu;
  }
  Params p{};
  for (int i = 0; i < 20; ++i) p.in[i] = (const float*)d_in[i];
  p.out = (float*)d_out;
  p.ws = (unsigned char*)d_ws;
  p.never = 0;
  p.pad = 0;
  hipMemsetAsync((unsigned char*)d_ws + OFF_BAR, 0, 5632 * 4 + 4 * 8192 * 4, stream);
  void* args[] = {&p};
  hipError_t e = hipLaunchCooperativeKernel((void*)fwd_megakernel, dim3(grid_blocks), dim3(256), args, 0, stream);
  if (e != hipSuccess) fprintf(stderr, "cooperative launch failed: %s (grid %d)\n", hipGetErrorString(e), grid_blocks);
}
```
